# Optimizing an MI355X kernel written in HIP

```python
import math
import jax, jax.numpy as jnp
from jax import lax
import numpy as np

D_MODEL = 1024
BATCH = 2
SEQ = 16384
DEPTH = 4

MEM_LEN = 256
HEAD_DIM = 64
EPS = 1e-6
A_WIDTH = D_MODEL // 2
A_HEADS = A_WIDTH // HEAD_DIM
MOBA_BLOCK = 256
MOBA_TOPK = 3
MOBA_QCHUNK = 64
B_HEADS = 4
B_VW = D_MODEL // 4
B_DV = B_VW // B_HEADS
B_DK = B_DV // 2
B_KW = B_HEADS * B_DK
GATE_RANK = 16
GATE_TEMP = 16.0
GLA_CHUNK = 64
M_WIDTH = D_MODEL // 4
M_HEADS = 4
M_DH = M_WIDTH // M_HEADS

IN_SPLITS = (A_WIDTH, A_WIDTH, A_WIDTH, A_WIDTH,
             B_KW, B_KW, B_VW, B_VW, GATE_RANK,
             M_WIDTH, M_WIDTH)
IN_PROJ = sum(IN_SPLITS)

kernel_name = "hymba_moba_gla_mem_hybrid"


def rms_norm(t, g):
    tf = t.astype(jnp.float32)
    y = tf * lax.rsqrt(jnp.mean(tf * tf, axis=-1, keepdims=True) + EPS)
    return (y * g.astype(jnp.float32)).astype(t.dtype)


def split_heads(t, n):
    b, s, w = t.shape
    return t.reshape(b, s, n, w // n).transpose(0, 2, 1, 3)


def merge_heads(t):
    b, h, s, d = t.shape
    return t.transpose(0, 2, 1, 3).reshape(b, s, h * d)


def alibi_slopes(n_heads):
    return jnp.asarray([2.0 ** (-8.0 * (i + 1) / n_heads) for i in range(n_heads)], jnp.float32)


def moba_attention(q, k, v):
    bsz, nh, s, d = q.shape
    nb = -(-s // MOBA_BLOCK)
    sp = nb * MOBA_BLOCK
    pad = ((0, 0), (0, 0), (0, sp - s), (0, 0))
    q, k, v = jnp.pad(q, pad), jnp.pad(k, pad), jnp.pad(v, pad)
    kb = k.reshape(bsz, nh, nb, MOBA_BLOCK, d)
    vb = v.reshape(bsz, nh, nb, MOBA_BLOCK, d)
    kmean = jnp.mean(kb.astype(jnp.float32), axis=3)
    slopes = alibi_slopes(nh)
    scale = d ** -0.5
    nsel = min(MOBA_TOPK, nb)
    n_qc = sp // MOBA_QCHUNK
    qc = q.reshape(bsz, nh, n_qc, MOBA_QCHUNK, d).transpose(2, 0, 1, 3, 4)
    blk_ar = jnp.arange(MOBA_BLOCK, dtype=jnp.int32)
    gather = jax.vmap(jax.vmap(lambda tb, ib: tb[ib]))

    def one_chunk(args):
        qi, c = args
        t0 = c * MOBA_QCHUNK
        qblk = t0 // MOBA_BLOCK
        pos_q = t0 + jnp.arange(MOBA_QCHUNK, dtype=jnp.int32)
        gate = jnp.einsum('bhqd,bhnd->bhqn', qi.astype(jnp.float32), kmean)
        past = jnp.arange(nb, dtype=jnp.int32) < qblk
        gate = jnp.where(past, gate, -jnp.inf)
        _, idx = lax.top_k(gate, nsel)
        valid = idx < qblk
        k_sel = gather(kb, idx)
        v_sel = gather(vb, idx)
        s_past = jnp.einsum('bhqd,bhqjsd->bhqjs', qi, k_sel,
                            preferred_element_type=jnp.float32) * scale
        pos_k_past = idx[..., None] * MOBA_BLOCK + blk_ar
        dist_past = (pos_q[None, None, :, None, None] - pos_k_past).astype(jnp.float32)
        s_past = s_past - slopes[None, :, None, None, None] * dist_past
        s_past = jnp.where(valid[..., None], s_past, -jnp.inf)
        k_own = lax.dynamic_slice_in_dim(kb, qblk, 1, axis=2)[:, :, 0]
        v_own = lax.dynamic_slice_in_dim(vb, qblk, 1, axis=2)[:, :, 0]
        pos_k_own = qblk * MOBA_BLOCK + blk_ar
        dist_own = (pos_q[:, None] - pos_k_own[None, :]).astype(jnp.float32)
        s_own = jnp.einsum('bhqd,bhsd->bhqs', qi, k_own,
                           preferred_element_type=jnp.float32) * scale
        s_own = s_own - slopes[None, :, None, None] * dist_own
        s_own = jnp.where(dist_own >= 0, s_own, -jnp.inf)
        logits = jnp.concatenate([s_past.reshape(bsz, nh, MOBA_QCHUNK, nsel * MOBA_BLOCK), s_own], -1)
        p = jax.nn.softmax(logits, axis=-1).astype(v.dtype)
        p_past = p[..., :nsel * MOBA_BLOCK].reshape(bsz, nh, MOBA_QCHUNK, nsel, MOBA_BLOCK)
        p_own = p[..., nsel * MOBA_BLOCK:]
        return (jnp.einsum('bhqjs,bhqjsd->bhqd', p_past, v_sel)
                + jnp.einsum('bhqs,bhsd->bhqd', p_own, v_own))

    out = lax.map(one_chunk, (qc, jnp.arange(n_qc, dtype=jnp.int32)))
    out = out.transpose(1, 2, 0, 3, 4).reshape(bsz, nh, sp, d)
    return out[:, :, :s]


def gla_attention(q, k, v, log_a):
    bsz, nh, s, dk = q.shape
    dv = v.shape[-1]
    nc = s // GLA_CHUNK

    def to_chunks(t):
        return t.astype(jnp.float32).reshape(bsz, nh, nc, GLA_CHUNK, t.shape[-1]).transpose(2, 0, 1, 3, 4)

    mask = jnp.tril(jnp.ones((GLA_CHUNK, GLA_CHUNK), dtype=bool))

    def step(state, inp):
        qc, kc, vc, gc = inp
        b = jnp.cumsum(gc, axis=-2)
        o_inter = jnp.einsum('bhcd,bhde->bhce', qc * jnp.exp(b), state)
        diff = b[:, :, :, None, :] - b[:, :, None, :, :]
        decay = jnp.exp(jnp.where(mask[None, None, :, :, None], diff, -jnp.inf))
        att = jnp.einsum('bhid,bhjd,bhijd->bhij', qc, kc, decay)
        o_intra = jnp.einsum('bhij,bhje->bhie', att, vc)
        b_last = b[:, :, -1:, :]
        new_state = (jnp.exp(b_last[:, :, 0, :, None]) * state
                     + jnp.einsum('bhcd,bhce->bhde', kc * jnp.exp(b_last - b), vc))
        return new_state, o_inter + o_intra

    state0 = jnp.zeros((bsz, nh, dk, dv), jnp.float32)
    _, out = lax.scan(step, state0, (to_chunks(q), to_chunks(k), to_chunks(v), to_chunks(log_a)))
    out = out.transpose(1, 2, 0, 3, 4).reshape(bsz, nh, s, dv)
    return out.astype(v.dtype)


def mem_attention(q, mk, mv):
    scale = q.shape[-1] ** -0.5
    logits = jnp.einsum('bhqd,bhmd->bhqm', q, mk, preferred_element_type=jnp.float32) * scale
    p = jax.nn.softmax(logits, axis=-1).astype(mv.dtype)
    return jnp.einsum('bhqm,bhmd->bhqd', p, mv)


def setup_inputs(seed: int = 0) -> dict:
    key = jax.random.key(seed)
    ks = jax.random.split(key, 16)
    f32 = jnp.float32

    def gain(k, shape):
        return 1.0 + 0.02 * jax.random.normal(k, shape, f32)

    return {
        "x": jax.random.normal(ks[0], (BATCH, SEQ, D_MODEL), f32),
        "mem": jax.random.normal(ks[1], (BATCH, MEM_LEN, D_MODEL), f32),
        "g_pre": gain(ks[2], (DEPTH, D_MODEL)),
        "w_in": jax.random.normal(ks[3], (DEPTH, D_MODEL, IN_PROJ), f32) * D_MODEL ** -0.5,
        "g_q_moba": gain(ks[4], (DEPTH, HEAD_DIM)),
        "g_k_moba": gain(ks[5], (DEPTH, HEAD_DIM)),
        "w_gate_up": jax.random.normal(ks[6], (DEPTH, GATE_RANK, B_KW), f32) * GATE_RANK ** -0.5,
        "b_gate_up": 0.1 * jax.random.normal(ks[7], (DEPTH, B_KW), f32),
        "g_gla_out": gain(ks[8], (DEPTH, B_DV)),
        "g_mem": gain(ks[9], (DEPTH, D_MODEL)),
        "w_mem_kv": jax.random.normal(ks[10], (DEPTH, D_MODEL, 2 * M_WIDTH), f32) * D_MODEL ** -0.5,
        "g_q_mem": gain(ks[11], (DEPTH, M_DH)),
        "g_k_mem": gain(ks[12], (DEPTH, M_DH)),
        "w_out": jax.random.normal(ks[13], (DEPTH, D_MODEL, D_MODEL), f32) * (D_MODEL * 2 * DEPTH) ** -0.5,
    }


def reference(x, mem, g_pre, w_in, g_q_moba, g_k_moba, w_gate_up, b_gate_up, g_gla_out,
              g_mem, w_mem_kv, g_q_mem, g_k_mem, w_out):
    split_idx = [int(i) for i in np.cumsum(IN_SPLITS)[:-1]]
    for l in range(DEPTH):
        h = rms_norm(x, g_pre[l])
        u = h @ w_in[l]
        (qa, ka, va, ga, qb, kb, vb, gb, rb, qm, gm) = jnp.split(u, split_idx, axis=-1)

        qa_h = rms_norm(split_heads(qa, A_HEADS), g_q_moba[l])
        ka_h = rms_norm(split_heads(ka, A_HEADS), g_k_moba[l])
        oa = merge_heads(moba_attention(qa_h, ka_h, split_heads(va, A_HEADS))) * jax.nn.silu(ga)

        z = rb @ w_gate_up[l] + b_gate_up[l]
        log_a = jax.nn.log_sigmoid(z.astype(jnp.float32)) / GATE_TEMP
        qb_h = split_heads(qb, B_HEADS) * (B_DK ** -0.5)
        ob = gla_attention(qb_h, split_heads(kb, B_HEADS), split_heads(vb, B_HEADS),
                           split_heads(log_a, B_HEADS))
        ob = merge_heads(rms_norm(ob, g_gla_out[l])) * jax.nn.silu(gb)

        mkv = rms_norm(mem, g_mem[l]) @ w_mem_kv[l]
        mk, mv = jnp.split(mkv, 2, axis=-1)
        qm_h = rms_norm(split_heads(qm, M_HEADS), g_q_mem[l])
        mk_h = rms_norm(split_heads(mk, M_HEADS), g_k_mem[l])
        om = merge_heads(mem_attention(qm_h, mk_h, split_heads(mv, M_HEADS))) * jax.nn.silu(gm)

        x = x + jnp.concatenate([oa, ob, om], axis=-1) @ w_out[l]
    return x
```

```cpp
#include <hip/hip_runtime.h>
#include <cstdio>
#include <cstdint>
#include <cstddef>

constexpr int BATCH = 2, SEQ = 16384, DM = 1024, DEPTH = 4, T = BATCH * SEQ;
constexpr int MEM_LEN = 256, TM = BATCH * MEM_LEN;
constexpr int NIN = 3344;
constexpr int C_QA = 0, C_KA = 512, C_VA = 1024, C_GA = 1536, C_QB = 2048, C_KB = 2176, C_VB = 2304, C_GB = 2560, C_RB = 2816, C_QM = 2832, C_GM = 3088;
constexpr int NB = SEQ / 256;
constexpr int NCH = SEQ / 64;
constexpr float EPS = 1e-6f;
constexpr int NINP = 14 * 256;
constexpr float LOG2E = 1.4426950408889634f;
constexpr float QSCALE = 0.125f * LOG2E;

__device__ __forceinline__ int lane_id_opaque() { int l; asm volatile("v_mbcnt_lo_u32_b32 %0, -1, 0\n\tv_mbcnt_hi_u32_b32 %0, -1, %0" : "=v"(l)); return l; }
__device__ __forceinline__ float red16(float v) { const auto r = __builtin_amdgcn_permlane16_swap(__float_as_uint(v), __float_as_uint(v), false, false); return __uint_as_float(r[0]) + __uint_as_float(r[1]); }
__device__ __forceinline__ float red32(float v) { const auto r = __builtin_amdgcn_permlane32_swap(__float_as_uint(v), __float_as_uint(v), false, false); return __uint_as_float(r[0]) + __uint_as_float(r[1]); }
template <int CTRL> __device__ __forceinline__ float dppmov(float v) { return __int_as_float(__builtin_amdgcn_update_dpp(0, __float_as_int(v), CTRL, 0xF, 0xF, false)); }
__device__ __forceinline__ float row16_sum(float v) { v += dppmov<0x128>(v); v += dppmov<0x124>(v); v += dppmov<0x4E>(v); v += dppmov<0xB1>(v); return v; }
__device__ __forceinline__ float shx(float v, int mask, int lane) { return __int_as_float(__builtin_amdgcn_ds_bpermute((lane ^ mask) << 2, __float_as_int(v))); }
__device__ __forceinline__ int shx_i(int v, int mask, int lane) { return __builtin_amdgcn_ds_bpermute((lane ^ mask) << 2, v); }
__device__ __forceinline__ float shup(float v, int o, int lane) { return __int_as_float(__builtin_amdgcn_ds_bpermute((lane >= o ? lane - o : lane) << 2, __float_as_int(v))); }
__device__ __forceinline__ int shup_i(int v, int o, int lane) { return __builtin_amdgcn_ds_bpermute((lane >= o ? lane - o : lane) << 2, v); }

namespace pg8 {
#define PG8_LAS __attribute__((address_space(3)))
typedef unsigned short bf16_t;
typedef short bf16x8 __attribute__((ext_vector_type(8)));
typedef float f32x4 __attribute__((ext_vector_type(4)));
typedef unsigned u32x4 __attribute__((ext_vector_type(4)));
constexpr int BM = 256, BK = 64, HALF = 128, HTB = HALF * BK * 2  , STAGE_BYTES = 8 * HTB, NXCD = 8, WGM = 8;

__host__ __device__ __forceinline__ int lds_byte(int r, int c) { const int st = (r >> 4) * 2 + (c >> 5), rr = r & 15, cc = c & 31, ob = rr * 64 + cc * 2; return st * 1024 + (ob ^ (((ob >> 9) & 1) << 5)); }
__host__ __device__ __forceinline__ void stage_rc(int b, int& R, int& C) { const int st = b / 1024, sb = b % 1024, swz = sb ^ (((sb >> 9) & 1) << 5); R = (st >> 1) * 16 + swz / 64; C = (st & 1) * 32 + (swz % 64) / 2; }
__host__ __device__ __forceinline__ int perm32(int rho) { const int n = rho >> 4, i = rho & 15; return 8 * (i >> 2) + 4 * n + (i & 3); }

struct Unit { int pm, pn; };
struct Gemm { const bf16_t* A; const bf16_t* Bt; int M, N, K; };

struct StaticOrder {
    int nM, nN, nwg, G, c;
    __host__ __device__ void init(int M, int N, int G_, int c_) { nM = M / BM; nN = N / BM; nwg = nM * nN; G = G_; c = c_; }
    __host__ __device__ bool next(int i, Unit& u) const {
        const long L = (long)i * G + c; if (L >= nwg) return false;
        int wgid = (int)L; { const int q = nwg / NXCD, r = nwg % NXCD, xcd = wgid % NXCD, off = wgid / NXCD; wgid = (xcd < r ? xcd * (q + 1) : r * (q + 1) + (xcd - r) * q) + off; }
        const int nig = WGM * nN, gid = wgid / nig, fm = gid * WGM, gsz = (nM - fm) < WGM ? (nM - fm) : WGM;
        u.pm = fm + ((wgid % nig) % gsz); u.pn = (wgid % nig) / gsz; return true;
    }
    __device__ __forceinline__ void a_ready(const Unit&) const {}
    __device__ __forceinline__ void done(const Unit&) const {}
};

__device__ __forceinline__ unsigned cvt_pk_bf16(float lo, float hi) { unsigned r; asm volatile("v_cvt_pk_bf16_f32 %0, %1, %2" : "=v"(r) : "v"(lo), "v"(hi)); return r; }
__device__ __forceinline__ float silu_f(float g) { return g * __builtin_amdgcn_rcpf(1.f + __builtin_amdgcn_exp2f(-1.4426950408889634f * g)); }
__device__ __forceinline__ float rsq_f(float x) { return __builtin_amdgcn_rsqf(x); }
typedef unsigned u32x2 __attribute__((ext_vector_type(2)));

struct EpiIn {
    static constexpr bool PERM = true, AFTER_DRAIN = false;
    bf16_t *qa, *ka, *va, *cb, *qbkb, *vb, *qm; float *la, *kmp; const float *ssq, *gq, *gk, *gqm, *bgu;
    __device__ __forceinline__ void operator()(const f32x4 (&acc)[2][2][4][2], const Unit& u, int wr, int wc, int fr, int fq) const {
        const int row0 = u.pm * BM + wr * 64 + fr, lane = fq * 16 + fr;
        float rs[2][4];
        {
            f32x4 pp[2][4];
#pragma unroll
            for (int ai = 0; ai < 2; ++ai)
#pragma unroll
                for (int m = 0; m < 4; ++m) pp[ai][m] = *(const f32x4*)(ssq + (size_t)(row0 + ai * HALF + m * 16) * 16 + fq * 4);
            asm volatile("" : "+v"(pp[0][0]), "+v"(pp[0][1]), "+v"(pp[0][2]), "+v"(pp[0][3]), "+v"(pp[1][0]), "+v"(pp[1][1]), "+v"(pp[1][2]), "+v"(pp[1][3]));
#pragma unroll
            for (int ai = 0; ai < 2; ++ai)
#pragma unroll
                for (int m = 0; m < 4; ++m) {
                    const f32x4 p = pp[ai][m];
                    float s = (p[0] + p[1]) + (p[2] + p[3]);
                    s = red16(s); s = red32(s);
                    rs[ai][m] = rsq_f(s * (1.f / 1024.f) + EPS);
                }
        }
        const int pn = u.pn;
        if (pn <= 3 || pn == 11) {
            bf16_t* dst; const float* g; float qs; int head, ld;
            if (pn <= 1) { dst = qa; g = gq; qs = QSCALE; head = 4 * pn + wc; ld = 512; }
            else if (pn <= 3) { dst = ka; g = gk; qs = 1.f; head = 4 * (pn - 2) + wc; ld = 512; }
            else { dst = qm; g = gqm; qs = QSCALE; head = wc; ld = 256; }
            f32x4 gv[2][2];
#pragma unroll
            for (int bj = 0; bj < 2; ++bj)
#pragma unroll
                for (int n = 0; n < 2; ++n) gv[bj][n] = *(const f32x4*)(g + 32 * bj + 8 * fq + 4 * n);
            f32x4 ksum[2][2];
#pragma unroll
            for (int bj = 0; bj < 2; ++bj)
#pragma unroll
                for (int n = 0; n < 2; ++n) ksum[bj][n] = (f32x4){0.f, 0.f, 0.f, 0.f};
#pragma unroll
            for (int ai = 0; ai < 2; ++ai)
#pragma unroll
                for (int m = 0; m < 4; ++m) {
                    f32x4 v[2][2]; float ss = 0.f;
#pragma unroll
                    for (int bj = 0; bj < 2; ++bj)
#pragma unroll
                        for (int n = 0; n < 2; ++n) { v[bj][n] = acc[ai][bj][m][n] * rs[ai][m]; const f32x4 t = v[bj][n]; ss += (t[0] * t[0] + t[1] * t[1]) + (t[2] * t[2] + t[3] * t[3]); }
                    ss = red16(ss); ss = red32(ss);
                    const float inv = rsq_f(ss * (1.f / 64.f) + EPS);
                    const int grow = row0 + ai * HALF + m * 16;
                    bf16_t* rowp = (pn <= 3) ? dst + (((size_t)((u.pm >> 6) * 8 + head)) * SEQ + (grow & (SEQ - 1))) * 64 + 8 * fq : dst + (size_t)grow * ld + head * 64 + 8 * fq;
#pragma unroll
                    for (int bj = 0; bj < 2; ++bj) {
                        const f32x4 a = v[bj][0] * inv * gv[bj][0], b = v[bj][1] * inv * gv[bj][1];
                        ksum[bj][0] += a; ksum[bj][1] += b;
                        u32x4 w; w.x = cvt_pk_bf16(a[0] * qs, a[1] * qs); w.y = cvt_pk_bf16(a[2] * qs, a[3] * qs); w.z = cvt_pk_bf16(b[0] * qs, b[1] * qs); w.w = cvt_pk_bf16(b[2] * qs, b[3] * qs);
                        *(u32x4*)(rowp + 32 * bj) = w;
                    }
                }
            if (pn == 2 || pn == 3) {
#pragma unroll
                for (int bj = 0; bj < 2; ++bj)
#pragma unroll
                    for (int n = 0; n < 2; ++n)
#pragma unroll
                        for (int e = 0; e < 4; ++e) ksum[bj][n][e] = row16_sum(ksum[bj][n][e]);
                if (fr == 0) {
                    const int b = u.pm >> 6, blk = u.pm & 63;
                    float* kp = kmp + ((((size_t)(b * 8 + head) * 64 + blk) * 2 + wr) * 64) + 8 * fq;
#pragma unroll
                    for (int bj = 0; bj < 2; ++bj)
#pragma unroll
                        for (int n = 0; n < 2; ++n) *(f32x4*)(kp + 32 * bj + 4 * n) = ksum[bj][n];
                }
            }
        } else if (pn == 13) {
            f32x4 bv[2];
#pragma unroll
            for (int n = 0; n < 2; ++n) bv[n] = *(const f32x4*)(bgu + 32 * wc + 8 * fq + 4 * n);
#pragma unroll
            for (int ai = 0; ai < 2; ++ai)
#pragma unroll
                for (int m = 0; m < 4; ++m) {
                    float* rowp = la + (size_t)(row0 + ai * HALF + m * 16) * 128 + 32 * wc + 8 * fq;
#pragma unroll
                    for (int n = 0; n < 2; ++n) {
                        const f32x4 z = acc[ai][0][m][n] * rs[ai][m] + bv[n]; f32x4 o;
#pragma unroll
                        for (int e = 0; e < 4; ++e) o[e] = (fminf(z[e], 0.f) - 0.6931471805599453f * __builtin_amdgcn_logf(1.f + __builtin_amdgcn_exp2f(-1.4426950408889634f * fabsf(z[e])))) * (1.f / 16.f);
                        *(f32x4*)(rowp + 4 * n) = o;
                    }
                }
        } else {
            const int b = u.pm >> 6;
            if (pn == 4 || pn == 5) {
                bf16_t* base = va + (((size_t)(b * 8 + 4 * (pn - 4) + (wc >> 1))) * SEQ + (row0 & (SEQ - 1))) * 64 + 32 * (wc & 1) + 8 * fq;
                plain_rows<64, (long)2 * SEQ * 64, false>(acc, rs, base, 1.f);
            } else if (pn == 6 || pn == 7) plain_rows<1024, HALF, true>(acc, rs, cb + (size_t)row0 * 1024 + 256 * (pn - 6) + 32 * wc + 8 * fq, 1.f);
            else if (pn == 8) plain_rows<256, HALF, false>(acc, rs, qbkb + (size_t)row0 * 256 + 32 * wc + 8 * fq, 0.17677669529663687f);
            else if (pn == 9) plain_rows<256, HALF, false>(acc, rs, vb + (size_t)row0 * 256 + 32 * wc + 8 * fq, 1.f);
            else if (pn == 10) plain_rows<1024, HALF, true>(acc, rs, cb + (size_t)row0 * 1024 + 512 + 32 * wc + 8 * fq, 1.f);
            else plain_rows<1024, HALF, true>(acc, rs, cb + (size_t)row0 * 1024 + 768 + 32 * wc + 8 * fq, 1.f);
        }
    }
    template <int LD, long BJ, bool GATE> static __device__ __forceinline__ void plain_rows(const f32x4 (&acc)[2][2][4][2], const float (&rs)[2][4], bf16_t* base, float sc0) {
#pragma unroll
        for (int ai = 0; ai < 2; ++ai)
#pragma unroll
            for (int m = 0; m < 4; ++m) {
                bf16_t* rowp = base + (size_t)(ai * HALF + m * 16) * LD;
#pragma unroll
                for (int bj = 0; bj < 2; ++bj) {
                    const float sc = rs[ai][m] * (bj == 0 ? sc0 : 1.f);
                    f32x4 a = acc[ai][bj][m][0] * sc, b = acc[ai][bj][m][1] * sc;
                    if (GATE) {
#pragma unroll
                        for (int e = 0; e < 4; ++e) { a[e] = silu_f(a[e]); b[e] = silu_f(b[e]); }
                    }
                    u32x4 w; w.x = cvt_pk_bf16(a[0], a[1]); w.y = cvt_pk_bf16(a[2], a[3]); w.z = cvt_pk_bf16(b[0], b[1]); w.w = cvt_pk_bf16(b[2], b[3]);
                    *(u32x4*)(rowp + BJ * bj) = w;
                }
            }
    }
};
struct EpiDry {
    static constexpr bool PERM = true, AFTER_DRAIN = false;
    __device__ __forceinline__ void operator()(const f32x4 (&acc)[2][2][4][2], const Unit& u, int wr, int wc, int fr, int fq) const {
        f32x4 t = {0.f, 0.f, 0.f, 0.f};
#pragma unroll
        for (int ai = 0; ai < 2; ++ai)
#pragma unroll
            for (int bj = 0; bj < 2; ++bj)
#pragma unroll
                for (int m = 0; m < 4; ++m) t += acc[ai][bj][m][0] + acc[ai][bj][m][1];
        asm volatile("" :: "v"(t));
    }
};
template <int FIRST, int LAST> struct EpiOut {
    static constexpr bool PERM = false, AFTER_DRAIN = false;
    const float* xin; float* xout; bf16_t* xb; float* ssq;
    __device__ __forceinline__ void operator()(const f32x4 (&acc)[2][2][4][2], const Unit& u, int wr, int wc, int fr, int fq) const {
        const int row0 = u.pm * BM + wr * 64 + fr, col0 = u.pn * BM + wc * 32 + 4 * fq;
#pragma unroll
        for (int ai = 0; ai < 2; ++ai)
#pragma unroll
            for (int mh = 0; mh < 2; ++mh) {
                f32x4 xr[2][2][2];
                if (FIRST) {
#pragma unroll
                    for (int mm = 0; mm < 2; ++mm)
#pragma unroll
                        for (int bj = 0; bj < 2; ++bj)
#pragma unroll
                            for (int n = 0; n < 2; ++n) xr[mm][bj][n] = *(const f32x4*)(xin + (size_t)(row0 + ai * HALF + (2 * mh + mm) * 16) * DM + col0 + bj * HALF + n * 16);
                } else {
                    u32x2 xw[2][2][2];
#pragma unroll
                    for (int mm = 0; mm < 2; ++mm)
#pragma unroll
                        for (int bj = 0; bj < 2; ++bj)
#pragma unroll
                            for (int n = 0; n < 2; ++n) xw[mm][bj][n] = *(const u32x2*)(xb + (size_t)(row0 + ai * HALF + (2 * mh + mm) * 16) * DM + col0 + bj * HALF + n * 16);
                    asm volatile("" : "+v"(xw[0][0][0]), "+v"(xw[0][0][1]), "+v"(xw[0][1][0]), "+v"(xw[0][1][1]), "+v"(xw[1][0][0]), "+v"(xw[1][0][1]), "+v"(xw[1][1][0]), "+v"(xw[1][1][1]));
#pragma unroll
                    for (int mm = 0; mm < 2; ++mm)
#pragma unroll
                        for (int bj = 0; bj < 2; ++bj)
#pragma unroll
                            for (int n = 0; n < 2; ++n) { const u32x2 w = xw[mm][bj][n]; xr[mm][bj][n] = (f32x4){__uint_as_float(w.x << 16), __uint_as_float(w.x & 0xffff0000u), __uint_as_float(w.y << 16), __uint_as_float(w.y & 0xffff0000u)}; }
                }
#pragma unroll
                for (int mm = 0; mm < 2; ++mm) {
                    const int m = 2 * mh + mm, row = row0 + ai * HALF + m * 16; float ss = 0.f;
#pragma unroll
                    for (int bj = 0; bj < 2; ++bj)
#pragma unroll
                        for (int n = 0; n < 2; ++n) {
                            const size_t off = (size_t)row * DM + col0 + bj * HALF + n * 16;
                            const f32x4 v = xr[mm][bj][n] + acc[ai][bj][m][n];
                            if (LAST) *(f32x4*)(xout + off) = v;
                            else { u32x2 w; w.x = cvt_pk_bf16(v[0], v[1]); w.y = cvt_pk_bf16(v[2], v[3]); *(u32x2*)(xb + off) = w;
                                   const float r0 = __uint_as_float(w.x << 16), r1 = __uint_as_float(w.x & 0xffff0000u), r2 = __uint_as_float(w.y << 16), r3 = __uint_as_float(w.y & 0xffff0000u);
                                   ss += (r0 * r0 + r1 * r1) + (r2 * r2 + r3 * r3); }
                        }
                    if (!LAST) { ss = red16(ss); ss = red32(ss); if (fq == 0) ssq[(size_t)row * 16 + 4 * u.pn + wc] = ss; }
                }
                asm volatile("" ::: "memory");
            }
    }
};

struct EpiMem {
    static constexpr bool PERM = true, AFTER_DRAIN = false;
    bf16_t *memk, *memv; const float *ssqm, *gkm; int tm;
    __device__ __forceinline__ void operator()(const f32x4 (&acc)[2][2][4][2], const Unit& u, int wr, int wc, int fr, int fq) const {
        const int row0 = u.pm * BM + wr * 64 + fr, lane = fq * 16 + fr;
        float rs[2][4];
#pragma unroll
        for (int ai = 0; ai < 2; ++ai)
#pragma unroll
            for (int m = 0; m < 4; ++m) {
                const int row = row0 + ai * HALF + m * 16;
                const f32x4 p = *(const f32x4*)(ssqm + (size_t)row * 16 + fq * 4);
                float s = (p[0] + p[1]) + (p[2] + p[3]);
                s = red16(s); s = red32(s);
                rs[ai][m] = rsq_f(s * (1.f / 1024.f) + EPS);
            }
        const int layer = u.pn >> 1;
        if ((u.pn & 1) == 0) {
            bf16_t* dst = memk + (size_t)layer * tm * 256; const float* g = gkm + layer * 64;
            f32x4 gv[2][2];
#pragma unroll
            for (int bj = 0; bj < 2; ++bj)
#pragma unroll
                for (int n = 0; n < 2; ++n) gv[bj][n] = *(const f32x4*)(g + 32 * bj + 8 * fq + 4 * n);
#pragma unroll
            for (int ai = 0; ai < 2; ++ai)
#pragma unroll
                for (int m = 0; m < 4; ++m) {
                    f32x4 v[2][2]; float ss = 0.f;
#pragma unroll
                    for (int bj = 0; bj < 2; ++bj)
#pragma unroll
                        for (int n = 0; n < 2; ++n) { v[bj][n] = acc[ai][bj][m][n] * rs[ai][m]; const f32x4 t = v[bj][n]; ss += (t[0] * t[0] + t[1] * t[1]) + (t[2] * t[2] + t[3] * t[3]); }
                    ss = red16(ss); ss = red32(ss);
                    const float inv = rsq_f(ss * (1.f / 64.f) + EPS);
                    bf16_t* rowp = dst + (size_t)(row0 + ai * HALF + m * 16) * 256 + wc * 64 + 8 * fq;
#pragma unroll
                    for (int bj = 0; bj < 2; ++bj) {
                        const f32x4 a = v[bj][0] * inv * gv[bj][0], b = v[bj][1] * inv * gv[bj][1];
                        u32x4 w; w.x = cvt_pk_bf16(a[0], a[1]); w.y = cvt_pk_bf16(a[2], a[3]); w.z = cvt_pk_bf16(b[0], b[1]); w.w = cvt_pk_bf16(b[2], b[3]);
                        *(u32x4*)(rowp + 32 * bj) = w;
                    }
                }
        } else {
            bf16_t* dst = memv + (size_t)layer * tm * 256;
#pragma unroll
            for (int ai = 0; ai < 2; ++ai)
#pragma unroll
                for (int m = 0; m < 4; ++m) {
                    bf16_t* rowp = dst + (size_t)(row0 + ai * HALF + m * 16) * 256 + 32 * wc + 8 * fq;
#pragma unroll
                    for (int bj = 0; bj < 2; ++bj) {
                        const f32x4 a = acc[ai][bj][m][0] * rs[ai][m], b = acc[ai][bj][m][1] * rs[ai][m];
                        u32x4 w; w.x = cvt_pk_bf16(a[0], a[1]); w.y = cvt_pk_bf16(a[2], a[3]); w.z = cvt_pk_bf16(b[0], b[1]); w.w = cvt_pk_bf16(b[2], b[3]);
                        *(u32x4*)(rowp + HALF * bj) = w;
                    }
                }
        }
    }
};
template <class Epi, class Sched, bool ALIGN_EPI = false, bool SP2 = false>
__device__ __forceinline__ void gemm_phase(PG8_LAS unsigned char* lds, const Gemm g, const Sched& S, const Epi& E, int wv) {
    const int tid_l = wv * 64 + lane_id_opaque();
    const int tid = tid_l, wid = __builtin_amdgcn_readfirstlane(tid >> 6), lane = tid & 63, wr = wid >> 2, wc = wid & 3, fr = lane & 15, fq = lane >> 4;
    const int K = g.K, nt = K / BK;
    unsigned voffA[2], voffB[2];
#pragma unroll
    for (int i = 0; i < 2; ++i) { int R, C; stage_rc(tid * 16 + i * 8192, R, C); const int Rb = Epi::PERM ? ((R & ~31) + perm32(R & 31)) : R;
        voffA[i] = (unsigned)(R * K + C) * 2u; voffB[i] = (unsigned)(Rb * K + C) * 2u; }
    const size_t kstep = (size_t)(BK * 2);
    const size_t hstep = (size_t)HALF * K * 2;
    const size_t tstep = 2 * hstep;
    const unsigned ldsw = (unsigned)wid * 1024u;
    const int aoff = lds_byte(wr * 64 + fr, fq * 8), boff = lds_byte(wc * 32 + fr, fq * 8);
#define PG8_SA(b, h) (((b) * 2 + (h)) * HTB)
#define PG8_SB(b, h) ((4 + (b) * 2 + (h)) * HTB)
#define PG8_STAGE(bufoff, gbase, voff) do { _Pragma("unroll") for (int _i = 0; _i < 2; ++_i) \
        __builtin_amdgcn_global_load_lds((const unsigned*)((const char*)(gbase) + (voff)[_i]), (PG8_LAS unsigned*)(lds + (bufoff) + ldsw + _i * 8192), 16, 0, 0); } while (0)
#define PG8_LDA(dst, b, h) do { _Pragma("unroll") for (int m = 0; m < 4; ++m) _Pragma("unroll") for (int k = 0; k < 2; ++k) dst[m][k] = *(const PG8_LAS bf16x8*)(lds + PG8_SA(b, h) + aoff + m * 2048 + k * 1024); } while (0)
#define PG8_LDB(dst, b, h) do { _Pragma("unroll") for (int n = 0; n < 2; ++n) _Pragma("unroll") for (int k = 0; k < 2; ++k) dst[n][k] = *(const PG8_LAS bf16x8*)(lds + PG8_SB(b, h) + boff + n * 2048 + k * 1024); } while (0)
#define PG8_MMA(ai, bj, At, Bt) do { __builtin_amdgcn_s_setprio(1); _Pragma("unroll") for (int m = 0; m < 4; ++m) _Pragma("unroll") for (int n = 0; n < 2; ++n) _Pragma("unroll") for (int k = 0; k < 2; ++k) \
        acc[ai][bj][m][n] = __builtin_amdgcn_mfma_f32_16x16x32_bf16(Bt[n][k], At[m][k], acc[ai][bj][m][n], 0, 0, 0); __builtin_amdgcn_s_setprio(0); } while (0)
#define PG8_WAIT_V(n) asm volatile("s_waitcnt vmcnt(" #n ")" ::: "memory")
#define PG8_WAIT_L(n) asm volatile("s_waitcnt lgkmcnt(" #n ")" ::: "memory")
#define PG8_BAR __builtin_amdgcn_s_barrier()
#define PG8_SCHED __builtin_amdgcn_sched_barrier(0)
    Unit cur, nxt; int ui = 0;
    if (!S.next(0, cur)) return;
    f32x4 acc[2][2][4][2];
#pragma unroll
    for (int a = 0; a < 2; ++a)
#pragma unroll
        for (int b = 0; b < 2; ++b)
#pragma unroll
            for (int m = 0; m < 4; ++m)
#pragma unroll
                for (int n = 0; n < 2; ++n) acc[a][b][m][n] = (f32x4){0.f, 0.f, 0.f, 0.f};
    bf16x8 At[4][2], B0[2][2], B1[2][2];
    const char* cA = (const char*)g.A + (size_t)cur.pm * tstep; const char* cB = (const char*)g.Bt + (size_t)cur.pn * tstep;
    S.a_ready(cur);
    if constexpr (SP2) {
        PG8_STAGE(PG8_SB(0, 0), cB, voffB); PG8_STAGE(PG8_SB(0, 1), cB + hstep, voffB); PG8_STAGE(PG8_SA(0, 0), cA, voffA); PG8_STAGE(PG8_SA(0, 1), cA + hstep, voffA);
        if (wr == 1) PG8_BAR;
        PG8_WAIT_V(2); PG8_BAR;
        PG8_STAGE(PG8_SB(1, 0), cB + kstep, voffB); PG8_STAGE(PG8_SA(1, 0), cA + kstep, voffA); PG8_STAGE(PG8_SB(1, 1), cB + hstep + kstep, voffB);
        PG8_WAIT_V(6); PG8_BAR;
    } else {
        PG8_STAGE(PG8_SB(0, 0), cB, voffB); PG8_STAGE(PG8_SA(0, 0), cA, voffA); PG8_STAGE(PG8_SB(0, 1), cB + hstep, voffB); PG8_STAGE(PG8_SA(0, 1), cA + hstep, voffA);
        if (wr == 1) PG8_BAR;
        PG8_WAIT_V(4); PG8_BAR;
        PG8_STAGE(PG8_SB(1, 0), cB + kstep, voffB); PG8_STAGE(PG8_SA(1, 0), cA + kstep, voffA); PG8_STAGE(PG8_SB(1, 1), cB + hstep + kstep, voffB);
        PG8_WAIT_V(6); PG8_BAR;
    }
    for (;;) {
        const bool has_next = S.next(ui + 1, nxt);
        const char* nA = has_next ? (const char*)g.A + (size_t)nxt.pm * tstep : cA; const char* nB = has_next ? (const char*)g.Bt + (size_t)nxt.pn * tstep : cB;
        for (int t = 0; t < nt; t += 2) {
            const bool last = (t == nt - 2);
            const char* a1 = cA + (size_t)(t + 1) * kstep;
            const char* a2 = last ? nA : cA + (size_t)(t + 2) * kstep; const char* b2 = last ? nB : cB + (size_t)(t + 2) * kstep;
            const char* a3 = a2 + kstep; const char* b3 = b2 + kstep;
            if (last && has_next) S.a_ready(nxt);
            if constexpr (SP2) {
            PG8_LDB(B0, 0, 0); PG8_LDB(B1, 0, 1); PG8_SCHED; PG8_LDA(At, 0, 0); PG8_STAGE(PG8_SA(1, 1), a1 + hstep, voffA);
            PG8_WAIT_V(8); PG8_WAIT_L(0); PG8_BAR; PG8_MMA(0, 0, At, B0); PG8_MMA(0, 1, At, B1); PG8_BAR; PG8_SCHED;
            PG8_LDA(At, 0, 1); PG8_STAGE(PG8_SB(0, 0), b2, voffB); PG8_STAGE(PG8_SB(0, 1), b2 + hstep, voffB); PG8_STAGE(PG8_SA(0, 0), a2, voffA);
            PG8_WAIT_V(8); PG8_WAIT_L(0); PG8_BAR; PG8_MMA(1, 0, At, B0); PG8_MMA(1, 1, At, B1); PG8_BAR; PG8_SCHED;
            PG8_LDB(B0, 1, 0); PG8_LDB(B1, 1, 1); PG8_SCHED; PG8_LDA(At, 1, 0); PG8_STAGE(PG8_SA(0, 1), a2 + hstep, voffA);
            PG8_WAIT_V(8); PG8_WAIT_L(0); PG8_BAR; PG8_MMA(0, 0, At, B0); PG8_MMA(0, 1, At, B1); PG8_BAR; PG8_SCHED;
            PG8_LDA(At, 1, 1); PG8_STAGE(PG8_SB(1, 0), b3, voffB); PG8_STAGE(PG8_SB(1, 1), b3 + hstep, voffB); PG8_STAGE(PG8_SA(1, 0), a3, voffA);
            PG8_WAIT_V(8); PG8_WAIT_L(0); PG8_BAR; PG8_MMA(1, 0, At, B0); PG8_MMA(1, 1, At, B1); PG8_BAR; PG8_SCHED;
            } else {
            PG8_LDB(B0, 0, 0); PG8_SCHED; PG8_LDA(At, 0, 0); PG8_STAGE(PG8_SA(1, 1), a1 + hstep, voffA);
            PG8_WAIT_L(8); PG8_BAR; PG8_WAIT_L(0); PG8_MMA(0, 0, At, B0); PG8_BAR; PG8_SCHED;
            PG8_LDB(B1, 0, 1); PG8_STAGE(PG8_SB(0, 0), b2, voffB);
            PG8_BAR; PG8_WAIT_L(0); PG8_MMA(0, 1, At, B1); PG8_BAR;
            PG8_LDA(At, 0, 1); PG8_STAGE(PG8_SA(0, 0), a2, voffA);
            PG8_BAR; PG8_WAIT_L(0); PG8_MMA(1, 0, At, B0); PG8_BAR; PG8_SCHED;
            PG8_STAGE(PG8_SB(0, 1), b2 + hstep, voffB);
            PG8_WAIT_V(6); PG8_BAR; PG8_MMA(1, 1, At, B1); PG8_BAR;
            PG8_LDB(B0, 1, 0); PG8_SCHED; PG8_LDA(At, 1, 0); PG8_STAGE(PG8_SA(0, 1), a2 + hstep, voffA);
            PG8_WAIT_L(8); PG8_BAR; PG8_WAIT_L(0); PG8_MMA(0, 0, At, B0); PG8_BAR; PG8_SCHED;
            PG8_LDB(B1, 1, 1); PG8_STAGE(PG8_SB(1, 0), b3, voffB);
            PG8_BAR; PG8_WAIT_L(0); PG8_MMA(0, 1, At, B1); PG8_BAR;
            PG8_LDA(At, 1, 1); PG8_STAGE(PG8_SA(1, 0), a3, voffA);
            PG8_BAR; PG8_WAIT_L(0); PG8_MMA(1, 0, At, B0); PG8_BAR; PG8_SCHED;
            PG8_STAGE(PG8_SB(1, 1), b3 + hstep, voffB);
            PG8_WAIT_V(6); PG8_BAR; PG8_MMA(1, 1, At, B1); PG8_BAR;
            }
        }
        if constexpr (ALIGN_EPI) { if (wr == 0) PG8_BAR; }
        if constexpr (!Epi::AFTER_DRAIN) { E(acc, cur, wr, wc, fr, fq); S.done(cur); }
        if (!has_next) break;
#pragma unroll
        for (int a = 0; a < 2; ++a)
#pragma unroll
            for (int b = 0; b < 2; ++b)
#pragma unroll
                for (int m = 0; m < 4; ++m)
#pragma unroll
                    for (int n = 0; n < 2; ++n) acc[a][b][m][n] = (f32x4){0.f, 0.f, 0.f, 0.f};
        cur = nxt; cA = nA; cB = nB; ++ui;
        if constexpr (ALIGN_EPI) { if (wr == 1) PG8_BAR; }
    }
    PG8_WAIT_V(0);
    if constexpr (!ALIGN_EPI) { if (wr == 0) PG8_BAR; }
    PG8_BAR;
    if constexpr (Epi::AFTER_DRAIN) { E.fused(acc, cur, wr, wc, fr, fq, lds, wid, lane); S.done(cur); }
#undef PG8_SA
#undef PG8_SB
#undef PG8_STAGE
#undef PG8_LDA
#undef PG8_LDB
#undef PG8_MMA
#undef PG8_WAIT_V
#undef PG8_WAIT_L
#undef PG8_BAR
#undef PG8_SCHED
}
}

#define LAS __attribute__((address_space(3)))
typedef unsigned short bf16;
#define XB_TMO      128
#define XB_XCNT(j)  (256  + 64 * (j))
#define XB_XSUB(j)  (1280 + 64 * (j))
#define XB_XGEN(j)  (2304 + 64 * (j))
#define XB_TOP      3328
#define XB_TOPGEN   3392
#define XCD_BAR_WORDS 3456
#define XB_SPIN_CAP (1u << 18)

__device__ __forceinline__ unsigned xb_ld(unsigned* p)              { return __hip_atomic_load(p, __ATOMIC_RELAXED, __HIP_MEMORY_SCOPE_AGENT); }
__device__ __forceinline__ unsigned xb_add(unsigned* p, unsigned v) { return __hip_atomic_fetch_add(p, v, __ATOMIC_RELAXED, __HIP_MEMORY_SCOPE_AGENT); }
__device__ __forceinline__ unsigned xb_xcc_id() { return (unsigned)__builtin_amdgcn_s_getreg((3 << 11) | 20) & 0xFu; }
#define XB_SPIN(cond, bar) do { unsigned _sp = 0; while (cond) { __builtin_amdgcn_s_sleep(1); \
    if ((++_sp & 255u) == 0u) { if (xb_ld(&(bar)[XB_TMO])) break; if (_sp > XB_SPIN_CAP) { atomicAdd(&(bar)[XB_TMO], 1u); break; } } } } while (0)

struct XcdBarrier {
    unsigned* bar; unsigned x;
    volatile LAS unsigned* st;
};

__device__ __forceinline__ XcdBarrier xcd_barrier_post(unsigned* bar, volatile LAS unsigned* st, int tid) {
    XcdBarrier b; b.bar = bar; b.x = xb_xcc_id(); b.st = st;
    if (tid == 0) (void)xb_add(&bar[XB_XCNT(b.x)], 1u);
    return b;
}
__device__ __forceinline__ void xcd_barrier_complete(unsigned* bar, unsigned x, unsigned& nloc, unsigned& nx) {
    const unsigned G = gridDim.x * gridDim.y * gridDim.z;
    unsigned sum, cnt, mine, sp = 0u;
    for (;;) {
        sum = 0u; cnt = 0u; mine = 0u;
#pragma unroll
        for (unsigned j = 0; j < 16; ++j) { const unsigned c = xb_ld(&bar[XB_XCNT(j)]); sum += c; cnt += (c > 0u) ? 1u : 0u; mine = (j == x) ? c : mine; }
        if (sum == G) break;
        __builtin_amdgcn_s_sleep(1);
        if ((++sp & 255u) == 0u) { if (xb_ld(&bar[XB_TMO])) break; if (sp > XB_SPIN_CAP) { atomicAdd(&bar[XB_TMO], 1u); break; } }
    }
    nloc = mine > 0u ? mine : 1u; nx = cnt > 0u ? cnt : 1u;
}

__device__ __forceinline__ void xcd_barrier(const XcdBarrier& b, int wv) {
    const int tid = wv * 64 + lane_id_opaque();
    asm volatile("s_waitcnt vmcnt(0)" ::: "memory");
    __syncthreads();
    if (tid == 0) {
        unsigned* bar = b.bar;
        __builtin_amdgcn_s_waitcnt(0);
        unsigned nloc = b.st[0], nx = b.st[1];
        if (nloc == 0u) { xcd_barrier_complete(bar, b.x, nloc, nx); b.st[0] = nloc; b.st[1] = nx; }
        const unsigned old = xb_add(&bar[XB_XSUB(b.x)], 1u);
        const unsigned gen = old / nloc;
        if (old + 1u == (gen + 1u) * nloc) {
            __builtin_amdgcn_fence(__ATOMIC_RELEASE, "agent");
            asm volatile("s_waitcnt vmcnt(0)" ::: "memory");
            const unsigned og = xb_add(&bar[XB_TOP], 1u);
            const unsigned tg = og / nx;
            if (og + 1u == (tg + 1u) * nx) xb_add(&bar[XB_TOPGEN], 1u);
            else XB_SPIN(xb_ld(&bar[XB_TOPGEN]) == tg, bar);
            __builtin_amdgcn_fence(__ATOMIC_ACQUIRE, "agent");
            xb_add(&bar[XB_XGEN(b.x)], 1u);
            asm volatile("s_waitcnt vmcnt(0)" ::: "memory");
        } else {
            XB_SPIN(xb_ld(&bar[XB_XGEN(b.x)]) == gen, bar);
            __builtin_amdgcn_fence(__ATOMIC_ACQUIRE, "agent");
            asm volatile("s_waitcnt vmcnt(0)" ::: "memory");
        }
    }
    __syncthreads();
}


#define GAS __attribute__((address_space(1)))
constexpr int NWAVES = 8, NTHREADS = 512;
constexpr int RING_BYTES = 131072, LDS_BYTES = 163840, MISC_OFF = LDS_BYTES - 512;

__device__ __forceinline__ float bf2f(unsigned short b) { return __uint_as_float((unsigned)b << 16); }
__device__ __forceinline__ unsigned f2bf(float f) { unsigned u = __float_as_uint(f); return (u + 0x7fffu + ((u >> 16) & 1u)) >> 16; }
__device__ __forceinline__ unsigned pk2(float lo, float hi) { return f2bf(lo) | (f2bf(hi) << 16); }
__device__ __forceinline__ float wave_sum(float v, int lane) {
#pragma unroll
    for (int o = 1; o < 64; o <<= 1) v += shx(v, o, lane);
    return v;
}
__device__ __forceinline__ float wave_max(float v, int lane) {
#pragma unroll
    for (int o = 1; o < 64; o <<= 1) v = fmaxf(v, shx(v, o, lane));
    return v;
}

constexpr size_t al256(size_t x) { return (x + 255) & ~(size_t)255; }
constexpr size_t O_CTL = 0;
constexpr size_t O_WT_IN = O_CTL + (1 << 16);
constexpr size_t O_WT_OUT = O_WT_IN + al256((size_t)DEPTH * NINP * DM * 2);
constexpr size_t O_WT_MEM = O_WT_OUT + al256((size_t)DEPTH * DM * DM * 2);
constexpr size_t O_XB = O_WT_MEM + al256((size_t)DEPTH * 512 * DM * 2);
constexpr size_t O_QA = O_XB + al256((size_t)T * DM * 2);
constexpr size_t O_KA = O_QA + al256((size_t)T * 512 * 2);
constexpr size_t O_VA = O_KA + al256((size_t)T * 512 * 2);
constexpr size_t O_CB = O_VA + al256((size_t)T * 512 * 2);
constexpr size_t O_QBKB = O_CB + al256((size_t)T * 1024 * 2);
constexpr size_t O_VB = O_QBKB + al256((size_t)T * 256 * 2);
constexpr size_t O_QM = O_VB + al256((size_t)T * 256 * 2);
constexpr size_t O_SSQ = O_QM + al256((size_t)T * 256 * 2);
constexpr size_t O_LA = O_SSQ + al256((size_t)T * 16 * 4);
constexpr size_t O_KMP = O_LA + al256((size_t)T * 128 * 4);
constexpr size_t O_LISTS = O_KMP + al256((size_t)BATCH * 8 * NB * 2 * 64 * 4);
constexpr size_t O_GCNT = O_LISTS + al256((size_t)BATCH * 8 * 256 * 2016 * 2);
constexpr size_t O_PARTO = O_GCNT + al256(1024 * 4);
constexpr size_t O_PARTL = O_PARTO + al256((size_t)T * 8 * 3 * 64 * 2);
constexpr size_t O_MEMK = O_PARTL + al256((size_t)T * 8 * 4 * 4);
constexpr size_t O_MEMV = O_MEMK + al256((size_t)DEPTH * TM * 256 * 2);
constexpr size_t O_MEMBF = O_MEMV + al256((size_t)DEPTH * TM * 256 * 2);
constexpr size_t O_SSQM = O_MEMBF + al256((size_t)TM * DM * 2);
constexpr size_t O_U = O_SSQM + al256((size_t)TM * 16 * 4);
constexpr size_t O_SST = O_U + al256((size_t)BATCH * 4 * NCH * 2048 * 4);
constexpr size_t O_DC = O_SST + al256((size_t)BATCH * 4 * NCH * 2048 * 4);
constexpr size_t O_PMASK = O_DC + al256((size_t)BATCH * 4 * NCH * 32 * 4);
constexpr size_t WS_END = O_PMASK + al256((size_t)T * 8);
static_assert(WS_END <= (size_t)536870912, "workspace map exceeds 4 x largest tensor");

struct KArgs {
    const float *x, *mem, *g_pre, *w_in, *g_q_moba, *g_k_moba, *w_gate_up, *b_gate_up, *g_gla_out, *g_mem, *w_mem_kv, *g_q_mem, *g_k_mem, *w_out;
    float* out;
    unsigned char* ws;
    int ph_lo, ph_hi;
};
struct Args {
    const __attribute__((address_space(4))) KArgs* kp;
    __device__ __forceinline__ const float* x() const { return kp->x; }
    __device__ __forceinline__ const float* mem() const { return kp->mem; }
    __device__ __forceinline__ const float* g_pre() const { return kp->g_pre; }
    __device__ __forceinline__ const float* w_in() const { return kp->w_in; }
    __device__ __forceinline__ const float* g_q_moba() const { return kp->g_q_moba; }
    __device__ __forceinline__ const float* g_k_moba() const { return kp->g_k_moba; }
    __device__ __forceinline__ const float* w_gate_up() const { return kp->w_gate_up; }
    __device__ __forceinline__ const float* b_gate_up() const { return kp->b_gate_up; }
    __device__ __forceinline__ const float* g_gla_out() const { return kp->g_gla_out; }
    __device__ __forceinline__ const float* g_mem() const { return kp->g_mem; }
    __device__ __forceinline__ const float* w_mem_kv() const { return kp->w_mem_kv; }
    __device__ __forceinline__ const float* g_q_mem() const { return kp->g_q_mem; }
    __device__ __forceinline__ const float* g_k_mem() const { return kp->g_k_mem; }
    __device__ __forceinline__ const float* w_out() const { return kp->w_out; }
    __device__ __forceinline__ float* out() const { return kp->out; }
    __device__ __forceinline__ unsigned char* ws() const { return kp->ws; }
    __device__ __forceinline__ unsigned* ctl() const { return (unsigned*)(kp->ws + O_CTL); }
    __device__ __forceinline__ bf16* wt_in() const { return (bf16*)(kp->ws + O_WT_IN); }
    __device__ __forceinline__ bf16* wt_out() const { return (bf16*)(kp->ws + O_WT_OUT); }
    __device__ __forceinline__ bf16* wt_mem() const { return (bf16*)(kp->ws + O_WT_MEM); }
    __device__ __forceinline__ bf16* xb() const { return (bf16*)(kp->ws + O_XB); }
    __device__ __forceinline__ bf16* qa() const { return (bf16*)(kp->ws + O_QA); }
    __device__ __forceinline__ bf16* ka() const { return (bf16*)(kp->ws + O_KA); }
    __device__ __forceinline__ bf16* va() const { return (bf16*)(kp->ws + O_VA); }
    __device__ __forceinline__ bf16* cb() const { return (bf16*)(kp->ws + O_CB); }
    __device__ __forceinline__ bf16* qbkb() const { return (bf16*)(kp->ws + O_QBKB); }
    __device__ __forceinline__ bf16* vb() const { return (bf16*)(kp->ws + O_VB); }
    __device__ __forceinline__ bf16* qm() const { return (bf16*)(kp->ws + O_QM); }
    __device__ __forceinline__ float* ssq() const { return (float*)(kp->ws + O_SSQ); }
    __device__ __forceinline__ float* la() const { return (float*)(kp->ws + O_LA); }
    __device__ __forceinline__ float* kmp() const { return (float*)(kp->ws + O_KMP); }
    __device__ __forceinline__ unsigned short* lists() const { return (unsigned short*)(kp->ws + O_LISTS); }
    __device__ __forceinline__ unsigned* gcnt() const { return (unsigned*)(kp->ws + O_GCNT); }
    __device__ __forceinline__ bf16* partO() const { return (bf16*)(kp->ws + O_PARTO); }
    __device__ __forceinline__ float* partL() const { return (float*)(kp->ws + O_PARTL); }
    __device__ __forceinline__ bf16* memk() const { return (bf16*)(kp->ws + O_MEMK); }
    __device__ __forceinline__ bf16* memv() const { return (bf16*)(kp->ws + O_MEMV); }
    __device__ __forceinline__ bf16* membf() const { return (bf16*)(kp->ws + O_MEMBF); }
    __device__ __forceinline__ float* ssqm() const { return (float*)(kp->ws + O_SSQM); }
    __device__ __forceinline__ float* U() const { return (float*)(kp->ws + O_U); }
    __device__ __forceinline__ float* Sst() const { return (float*)(kp->ws + O_SST); }
    __device__ __forceinline__ float* Dc() const { return (float*)(kp->ws + O_DC); }
    __device__ __forceinline__ unsigned char* pmask() const { return (unsigned char*)(kp->ws + O_PMASK); }
};


typedef short s16x8 __attribute__((ext_vector_type(8)));
typedef short s16x4 __attribute__((ext_vector_type(4)));
typedef float f32x16 __attribute__((ext_vector_type(16)));
typedef float f32x2_t __attribute__((ext_vector_type(2)));
typedef __bf16 bf16x2_t __attribute__((ext_vector_type(2)));
constexpr int KIMG_CH = 4112;
constexpr int VIMG_DH = 16448;
constexpr int KIMG_OFF = 0, VIMG_OFF = 8 * KIMG_CH, ATT_LDS_END = VIMG_OFF + 2 * VIMG_DH;
constexpr int LIST_PER_BH = 256 * 2016;
__device__ __forceinline__ int list_off(int j) { return 256 * (63 * j - (j * (j - 1)) / 2); }
__device__ __forceinline__ int crow(int r, int hi) { return (r & 3) + 8 * (r >> 2) + 4 * hi; }
__device__ __forceinline__ unsigned cvtpk(float lo, float hi) { f32x2_t v = {lo, hi}; bf16x2_t b = __builtin_convertvector(v, bf16x2_t); return __builtin_bit_cast(unsigned, b); }
__device__ __forceinline__ s16x4 vtr(const LAS unsigned char* p) { typedef short v4i16_t __attribute__((ext_vector_type(4))); return __builtin_bit_cast(s16x4, __builtin_amdgcn_ds_read_tr16_b64_v4i16((LAS v4i16_t*)p)); }

struct KVRegs { uint4 k[4], v[4]; };
__device__ __forceinline__ void kv_issue(KVRegs& r, const bf16* kg, const bf16* vg, int stride, int tid) {
    const int c = tid & 7, k0 = tid >> 3;
#pragma unroll
    for (int i = 0; i < 4; ++i) { const size_t o = (size_t)(k0 + 64 * i) * stride + c * 8; r.k[i] = *(const uint4*)(kg + o); r.v[i] = *(const uint4*)(vg + o); }
}
__device__ __forceinline__ void kv_commit(LAS unsigned char* L, const KVRegs& r, int tid) {
    const int c = tid & 7, k0 = tid >> 3;
#pragma unroll
    for (int i = 0; i < 4; ++i) { const int key = k0 + 64 * i;
        *(LAS pg8::u32x4*)(L + KIMG_OFF + c * KIMG_CH + key * 16) = (pg8::u32x4){r.k[i].x, r.k[i].y, r.k[i].z, r.k[i].w};
        *(LAS pg8::u32x4*)(L + VIMG_OFF + (c >> 2) * VIMG_DH + key * 64 + (c & 3) * 16) = (pg8::u32x4){r.v[i].x, r.v[i].y, r.v[i].z, r.v[i].w}; }
}
__device__ __forceinline__ void load_kv_tiles(LAS unsigned char* L, const bf16* kg, const bf16* vg, int stride, int tid) { KVRegs r; kv_issue(r, kg, vg, stride, tid); kv_commit(L, r, tid); }
__device__ __forceinline__ void attn_tiles(const LAS unsigned char* L, const s16x8 (&qf)[4], f32x16& cin, float cstep, int kt0, int kt1, int mask_kt, int r32, int hi, int lane, f32x16 (&o)[2], float& lsum) {
    const LAS unsigned char* kp = L + KIMG_OFF + hi * KIMG_CH + r32 * 16;
    const LAS unsigned char* vp = L + VIMG_OFF + ((lane >> 4) & 1) * 32 + (lane & 3) * 8 + (4 * hi + ((lane & 15) >> 2)) * 64;
    for (int kt = kt0; kt < kt1; ++kt) {
        f32x16 s = cin;
#pragma unroll
        for (int d0 = 0; d0 < 4; ++d0) { const s16x8 kf = *(const LAS s16x8*)(kp + 2 * d0 * KIMG_CH + kt * 512); s = __builtin_amdgcn_mfma_f32_32x32x16_bf16(kf, qf[d0], s, 0, 0, 0); }
        if (kt == mask_kt) {
#pragma unroll
            for (int r = 0; r < 16; ++r) if (crow(r, hi) > r32) s[r] = -INFINITY;
        }
        float ps = 0.f;
#pragma unroll
        for (int r = 0; r < 16; ++r) { s[r] = __builtin_amdgcn_exp2f(s[r]); ps += s[r]; }
        lsum += ps;
        union { unsigned w[4]; s16x8 v; } p0, p1;
#pragma unroll
        for (int e = 0; e < 4; ++e) { p0.w[e] = cvtpk(s[2 * e], s[2 * e + 1]); p1.w[e] = cvtpk(s[8 + 2 * e], s[8 + 2 * e + 1]); }
#pragma unroll
        for (int dh = 0; dh < 2; ++dh) {
            const LAS unsigned char* vq = vp + dh * VIMG_DH + kt * 2048;
            const s16x4 a0 = vtr(vq), a1 = vtr(vq + 512), a2 = vtr(vq + 1024), a3 = vtr(vq + 1536);
            const s16x8 f0 = {a0[0], a0[1], a0[2], a0[3], a1[0], a1[1], a1[2], a1[3]}, f1 = {a2[0], a2[1], a2[2], a2[3], a3[0], a3[1], a3[2], a3[3]};
            o[dh] = __builtin_amdgcn_mfma_f32_32x32x16_bf16(f0, p0.v, o[dh], 0, 0, 0);
            o[dh] = __builtin_amdgcn_mfma_f32_32x32x16_bf16(f1, p1.v, o[dh], 0, 0, 0);
        }
#pragma unroll
        for (int r = 0; r < 16; ++r) cin[r] += cstep;
    }
}
__device__ __forceinline__ void load_qfrag(s16x8 (&qf)[4], const bf16* qrow, int hi) {
#pragma unroll
    for (int d0 = 0; d0 < 4; ++d0) qf[d0] = *(const s16x8*)(qrow + 16 * d0 + 8 * hi);
}
__device__ __forceinline__ float softmax_ref(const float* gq, const float* gk) {
    const int lane = lane_id_opaque();
    const float a = wave_max(fabsf(gq[lane]), lane), b = wave_max(fabsf(gk[lane]), lane);
    return 64.f * QSCALE * a * b * 1.01f;
}

__device__ __forceinline__ float zero_thr(float Mref) { return 104.f + 2.f * Mref * 0.6931471805599453f + 1.f; }

__device__ __forceinline__ size_t hm_off(int b, int h, int t) { return (((size_t)(b * 8 + h)) * SEQ + t) * 64; }
struct RouteRaw { uint4 q[8]; float km[16]; };
__device__ __forceinline__ void route_decode(int p, int& bh, int& i) { i = 63 - (p >> 4); bh = p & 15; }
__device__ __forceinline__ void route_raw_issue(const Args& a, RouteRaw& r, int unit, int tid) {
    int bh, i; route_decode(unit, bh, i); const int b = bh >> 3, h = bh & 7;
    const uint4* qr = (const uint4*)(a.qa() + hm_off(b, h, i * 256 + (tid >> 6) * 32 + (tid & 31)));
#pragma unroll
    for (int c = 0; c < 8; ++c) r.q[c] = qr[c];
#pragma unroll
    for (int k = 0; k < 8; ++k) { const int e = tid + NTHREADS * k;
        if (e < i * 64) { const float* p = a.kmp() + (((size_t)bh * 64 + (e >> 6)) * 2) * 64 + (e & 63); r.km[2 * k] = p[0]; r.km[2 * k + 1] = p[64]; } }
}
__device__ __forceinline__ void top3_insert(float s, int j, float& v0, float& v1, float& v2, int& i0, int& i1, int& i2) {
    const bool g0 = s > v0, g1 = s > v1, g2 = s > v2;
    v2 = g1 ? v1 : (g2 ? s : v2); i2 = g1 ? i1 : (g2 ? j : i2);
    v1 = g0 ? v0 : (g1 ? s : v1); i1 = g0 ? i0 : (g1 ? j : i1);
    v0 = g0 ? s : v0; i0 = g0 ? j : i0;
}
__device__ __forceinline__ void moba_route_phase(const Args& a, LAS unsigned char* L, int wv, int bid, int G, float zthr, int dry) {
    LAS float* km = (LAS float*)L;
    LAS int* cnt = (LAS int*)(L + 64 * 65 * 4);
    LAS int* basep = cnt + 64;
    const int NU = BATCH * 8 * 63;
    int rnd = 0;
    int unit = bid;
    RouteRaw R;
    if (unit < NU) route_raw_issue(a, R, unit, wv * 64 + lane_id_opaque());
    while (unit < NU) {
        const int tid = wv * 64 + lane_id_opaque(), lane = tid & 63, r32 = lane & 31, hi = lane >> 5;
        int bh, i; route_decode(unit, bh, i); const int b = bh >> 3, h = bh & 7;
#pragma unroll
        for (int k = 0; k < 8; ++k) { const int e = tid + NTHREADS * k; if (e < i * 64) km[(e >> 6) * 65 + (e & 63)] = R.km[2 * k] + R.km[2 * k + 1]; }
        if (tid < 64) cnt[tid] = 0;
        const int t = i * 256 + wv * 32 + r32;
        float qv[32];
#pragma unroll
        for (int c = 0; c < 8; ++c) { const unsigned ww[4] = {R.q[c].x, R.q[c].y, R.q[c].z, R.q[c].w};
#pragma unroll
            for (int e = 0; e < 4; ++e) qv[4 * c + e] = hi ? __uint_as_float(ww[e] & 0xffff0000u) : __uint_as_float(ww[e] << 16); }
        ++rnd;
        const int nunit = rnd * G + ((rnd & 1) ? (G - 1 - bid) : bid);
        if (nunit < NU) route_raw_issue(a, R, nunit, tid);
        __syncthreads();
        float v0 = -INFINITY, v1 = -INFINITY, v2 = -INFINITY; int i0 = 1 << 20, i1 = 1 << 20, i2 = 1 << 20;
        const int njt = i > 32 ? 2 : 1;
        for (int jt = 0; jt < njt; ++jt) {
            f32x16 g;
#pragma unroll
            for (int r = 0; r < 16; ++r) g[r] = 0.f;
            const LAS float* kr = km + (32 * jt + r32) * 65 + hi;
#pragma unroll
            for (int ks = 0; ks < 32; ++ks) g = __builtin_amdgcn_mfma_f32_32x32x2f32(kr[2 * ks], qv[ks], g, 0, 0, 0);
#pragma unroll
            for (int r = 0; r < 16; ++r) { const int j = 32 * jt + crow(r, hi); const float sv = (j < i) ? g[r] : -INFINITY; top3_insert(sv, j, v0, v1, v2, i0, i1, i2); }
        }
        {
            const auto x0 = __builtin_amdgcn_permlane32_swap(__float_as_uint(v0), __float_as_uint(v0), false, false), x1 = __builtin_amdgcn_permlane32_swap(__float_as_uint(v1), __float_as_uint(v1), false, false), x2 = __builtin_amdgcn_permlane32_swap(__float_as_uint(v2), __float_as_uint(v2), false, false);
            const auto y0 = __builtin_amdgcn_permlane32_swap((unsigned)i0, (unsigned)i0, false, false), y1 = __builtin_amdgcn_permlane32_swap((unsigned)i1, (unsigned)i1, false, false), y2 = __builtin_amdgcn_permlane32_swap((unsigned)i2, (unsigned)i2, false, false);
            const float pv[3] = {__uint_as_float(hi ? x0[0] : x0[1]), __uint_as_float(hi ? x1[0] : x1[1]), __uint_as_float(hi ? x2[0] : x2[1])};
            const int pi[3] = {(int)(hi ? y0[0] : y0[1]), (int)(hi ? y1[0] : y1[1]), (int)(hi ? y2[0] : y2[1])};
#pragma unroll
            for (int c = 0; c < 3; ++c) {
                const float sv = pv[c]; const int j = pi[c];
                const bool g0 = sv > v0 || (sv == v0 && j < i0), g1 = sv > v1 || (sv == v1 && j < i1), g2 = sv > v2 || (sv == v2 && j < i2);
                v2 = g1 ? v1 : (g2 ? sv : v2); i2 = g1 ? i1 : (g2 ? j : i2);
                v1 = g0 ? v0 : (g1 ? sv : v1); i1 = g0 ? i0 : (g1 ? j : i1);
                v0 = g0 ? sv : v0; i0 = g0 ? j : i0;
            }
        }
        int rk0 = 0, rk1 = 0, rk2 = 0; const int nsel = i < 3 ? i : 3; bool k0 = false, k1 = false, k2 = false;
        if (hi == 0) {
            if (dry) asm volatile("" :: "v"(i0), "v"(i1), "v"(i2));
            const float slope = exp2f(-(float)(h + 1));
            k0 = nsel > 0 && !(slope * (float)(t - 256 * i0 - 255) > zthr);
            k1 = nsel > 1 && !(slope * (float)(t - 256 * i1 - 255) > zthr);
            k2 = nsel > 2 && !(slope * (float)(t - 256 * i2 - 255) > zthr);
            if (!dry) a.pmask()[((size_t)(b * SEQ + t)) * 8 + h] = (unsigned char)((k0 ? 1 : 0) | (k1 ? 2 : 0) | (k2 ? 4 : 0));
            if (!dry && k0) rk0 = __hip_atomic_fetch_add(cnt + i0, 1, __ATOMIC_RELAXED, __HIP_MEMORY_SCOPE_WORKGROUP);
            if (!dry && k1) rk1 = __hip_atomic_fetch_add(cnt + i1, 1, __ATOMIC_RELAXED, __HIP_MEMORY_SCOPE_WORKGROUP);
            if (!dry && k2) rk2 = __hip_atomic_fetch_add(cnt + i2, 1, __ATOMIC_RELAXED, __HIP_MEMORY_SCOPE_WORKGROUP);
        }
        __syncthreads();
        if (!dry && tid < i) { const int c = cnt[tid]; basep[tid] = c > 0 ? (int)atomicAdd(a.gcnt() + bh * 64 + tid, (unsigned)c) : 0; }
        __syncthreads();
        if (!dry && hi == 0) {
            unsigned short* lst = a.lists() + (size_t)bh * LIST_PER_BH;
            if (k0) lst[list_off(i0) + basep[i0] + rk0] = (unsigned short)(t | (0 << 14));
            if (k1) lst[list_off(i1) + basep[i1] + rk1] = (unsigned short)(t | (1 << 14));
            if (k2) lst[list_off(i2) + basep[i2] + rk2] = (unsigned short)(t | (2 << 14));
        }
        unit = nunit;
        __syncthreads();
    }
}

__device__ __forceinline__ void moba_pairs_phase(const Args& a, int l, LAS unsigned char* L, int wv, int bid, int G, int dry = 0) {
    const int tid = wv * 64 + lane_id_opaque(), lane = tid & 63, wid = wv;
    LAS int* pre = (LAS int*)(L + ATT_LDS_END);
    LAS int* cntl = pre + 1028;
    LAS int* wtot = cntl + 1024;
    {
        const int c0 = (int)a.gcnt()[2 * tid], c1 = (int)a.gcnt()[2 * tid + 1];
        cntl[2 * tid] = c0; cntl[2 * tid + 1] = c1;
        const int n0 = (c0 + 255) >> 8, n1 = (c1 + 255) >> 8;
        int s = n0 + n1;
#pragma unroll
        for (int o = 1; o < 64; o <<= 1) { const int v = shup_i(s, o, lane); if (lane >= o) s += v; }
        if (lane == 63) wtot[wid] = s;
        __syncthreads();
        int wb = 0;
        for (int w = 0; w < wid; ++w) wb += wtot[w];
        const int excl = wb + s - (n0 + n1);
        pre[2 * tid] = excl; pre[2 * tid + 1] = excl + n0;
        if (tid == NTHREADS - 1) pre[1024] = excl + n0 + n1;
        __syncthreads();
    }
    const int total = pre[1024];
    LAS int* itab = wtot + 8;
    if (tid < 64) { const int it = bid + tid * G; int lo = 0, hh = 1023;
        if (it < total) { while (lo < hh) { const int mid = (lo + hh + 1) >> 1; if (pre[mid] <= it) lo = mid; else hh = mid - 1; } }
        itab[tid] = lo; }
    __syncthreads();
    const float Mref = softmax_ref(a.g_q_moba() + l * 64, a.g_k_moba() + l * 64);
    KVRegs kvr; s16x8 qf[4], qfn[4]; int tq = 0, slot = 0, cb_ = 0, ch_ = 0, cj_ = 0; bool valid = false;
    int ntq = 0, nslot = 0, nb_ = 0, nh_ = 0, nj_ = 0; bool nvalid = false; unsigned ne = 0;
    int item = bid;
#define PAIR_META(IT, B_, H_, J_, VALID_, E_) do { \
        const int tid2 = wv * 64 + lane_id_opaque(), lane2 = tid2 & 63; \
        const int bhj = itab[((IT) - bid) / G], chunk = (IT) - pre[bhj], n = cntl[bhj], bh = bhj >> 6; \
        J_ = bhj & 63; B_ = bh >> 3; H_ = bh & 7; \
        kv_issue(kvr, a.ka() + hm_off(B_, H_, J_ * 256), a.va() + hm_off(B_, H_, J_ * 256), 64, tid2); \
        int idx = chunk * 256 + wv * 32 + (lane2 & 31); VALID_ = idx < n; if (!VALID_) idx = n - 1; \
        E_ = a.lists()[(size_t)bh * LIST_PER_BH + list_off(J_) + idx]; } while (0)
    if (item < total) {
        unsigned e0; PAIR_META(item, cb_, ch_, cj_, valid, e0);
        tq = e0 & 0x3fff; slot = e0 >> 14;
        load_qfrag(qf, a.qa() + hm_off(cb_, ch_, tq), (lane_id_opaque() >> 5));
    }
    while (item < total) {
        const int tid2 = wv * 64 + lane_id_opaque(), lane = tid2 & 63, r32 = lane & 31, hi = lane >> 5;
        const int nitem = item + G; const bool has_next = nitem < total;
        __syncthreads();
        kv_commit(L, kvr, tid2);
        if (has_next) PAIR_META(nitem, nb_, nh_, nj_, nvalid, ne);
        __syncthreads();
        const size_t tok = (size_t)cb_ * SEQ + tq;
        const float slope2 = exp2f(-(float)(ch_ + 1)) * LOG2E;
        f32x16 cin;
#pragma unroll
        for (int r = 0; r < 16; ++r) cin[r] = fmaf(-slope2, (float)(tq - 256 * cj_ - crow(r, hi)), -Mref);
        f32x16 o[2]; float lsum = 0.f;
#pragma unroll
        for (int r = 0; r < 16; ++r) { o[0][r] = 0.f; o[1][r] = 0.f; }
        attn_tiles(L, qf, cin, 32.f * slope2, 0, 4, -1, r32, hi, lane, o, lsum);
        if (has_next) { ntq = ne & 0x3fff; nslot = ne >> 14; load_qfrag(qfn, a.qa() + hm_off(nb_, nh_, ntq), hi); }
        attn_tiles(L, qf, cin, 32.f * slope2, 4, 8, -1, r32, hi, lane, o, lsum);
        lsum = red32(lsum);
        if (dry) asm volatile("" :: "v"(o[0]), "v"(o[1]), "v"(lsum));
        if (valid && !dry) {
            const size_t pidx = (tok * 8 + ch_) * 3 + slot;
            bf16* po = a.partO() + pidx * 64;
#pragma unroll
            for (int dh = 0; dh < 2; ++dh)
#pragma unroll
                for (int g2 = 0; g2 < 2; ++g2) { uint4 w;
                    w.x = cvtpk(o[dh][8 * g2], o[dh][8 * g2 + 1]); w.y = cvtpk(o[dh][8 * g2 + 2], o[dh][8 * g2 + 3]); w.z = cvtpk(o[dh][8 * g2 + 4], o[dh][8 * g2 + 5]); w.w = cvtpk(o[dh][8 * g2 + 6], o[dh][8 * g2 + 7]);
                    *(uint4*)(po + 32 * hi + 16 * dh + 8 * g2) = w; }
            if (hi == 0) a.partL()[(tok * 8 + ch_) * 4 + slot] = lsum;
        }
#pragma unroll
        for (int d0 = 0; d0 < 4; ++d0) qf[d0] = qfn[d0];
        tq = ntq; slot = nslot; cb_ = nb_; ch_ = nh_; cj_ = nj_; valid = nvalid;
        item = nitem;
    }
#undef PAIR_META
    __syncthreads();
}

__device__ __forceinline__ void row_load_pieces(const bf16* row, int hi, uint2 (&pc)[8]) {
#pragma unroll
    for (int k = 0; k < 4; ++k) {
        const uint4 w = *(const uint4*)(row + 8 * (2 * k + hi));
        const auto s0 = __builtin_amdgcn_permlane32_swap(w.x, w.z, false, false), s1 = __builtin_amdgcn_permlane32_swap(w.y, w.w, false, false);
        pc[2 * k] = make_uint2(s0[0], s1[0]); pc[2 * k + 1] = make_uint2(s0[1], s1[1]);
    }
}
__device__ __forceinline__ void row_store_pieces(bf16* row, int hi, const uint2 (&pc)[8]) {
#pragma unroll
    for (int k = 0; k < 4; ++k) {
        const auto s0 = __builtin_amdgcn_permlane32_swap(pc[2 * k].x, pc[2 * k + 1].x, false, false), s1 = __builtin_amdgcn_permlane32_swap(pc[2 * k].y, pc[2 * k + 1].y, false, false);
        *(uint4*)(row + 8 * (2 * k + hi)) = make_uint4(s0[0], s1[0], s0[1], s1[1]);
    }
}
__device__ __forceinline__ void own_tile(const Args& a, const LAS unsigned char* Lt, const s16x8 (&qf)[4], unsigned pm, int b, int h, int i, int qt, int lane, float Mref, int dry) {
    const int r32 = lane & 31, hi = lane >> 5;
    const size_t tok = (size_t)b * SEQ + i * 256 + qt * 32 + r32;
    const float slope2 = exp2f(-(float)(h + 1)) * LOG2E;
    f32x16 cin;
#pragma unroll
    for (int r = 0; r < 16; ++r) cin[r] = fmaf(-slope2, (float)(32 * qt + r32 - crow(r, hi)), -Mref);
    f32x16 o[2]; float lsum = 0.f;
#pragma unroll
    for (int r = 0; r < 16; ++r) { o[0][r] = 0.f; o[1][r] = 0.f; }
    attn_tiles(Lt, qf, cin, 32.f * slope2, 0, qt + 1, qt, r32, hi, lane, o, lsum);
    lsum = red32(lsum);
    bf16* cp = a.cb() + tok * 1024 + h * 64;
    uint4 gw[4];
#pragma unroll
    for (int k = 0; k < 4; ++k) gw[k] = *(const uint4*)(cp + 8 * (2 * k + hi));
    if (pm) { const pg8::f32x4 pl = *(const pg8::f32x4*)(a.partL() + (tok * 8 + h) * 4);
        lsum += ((pm & 1u) ? pl[0] : 0.f) + ((pm & 2u) ? pl[1] : 0.f) + ((pm & 4u) ? pl[2] : 0.f); }
    for (int s = 0; s < 3; ++s) {
        if (!((pm >> s) & 1u)) continue;
        const size_t pidx = (tok * 8 + h) * 3 + s;
        const bf16* po = a.partO() + pidx * 64;
#pragma unroll
        for (int dh = 0; dh < 2; ++dh)
#pragma unroll
            for (int g2 = 0; g2 < 2; ++g2) { const uint4 w = *(const uint4*)(po + 32 * hi + 16 * dh + 8 * g2); const unsigned ww[4] = {w.x, w.y, w.z, w.w};
#pragma unroll
                for (int e = 0; e < 4; ++e) { o[dh][8 * g2 + 2 * e] += __uint_as_float(ww[e] << 16); o[dh][8 * g2 + 2 * e + 1] += __uint_as_float(ww[e] & 0xffff0000u); } }
    }
    const float inv = __builtin_amdgcn_rcpf(lsum);
    uint2 gt[8];
#pragma unroll
    for (int k = 0; k < 4; ++k) {
        const auto s0 = __builtin_amdgcn_permlane32_swap(gw[k].x, gw[k].z, false, false), s1 = __builtin_amdgcn_permlane32_swap(gw[k].y, gw[k].w, false, false);
        gt[2 * k] = make_uint2(s0[0], s1[0]); gt[2 * k + 1] = make_uint2(s0[1], s1[1]); }
#pragma unroll
    for (int c = 0; c < 8; ++c) { const int dh = c >> 2, g4 = c & 3; uint2 w;
        w.x = cvtpk(o[dh][4 * g4] * inv * __uint_as_float(gt[c].x << 16), o[dh][4 * g4 + 1] * inv * __uint_as_float(gt[c].x & 0xffff0000u));
        w.y = cvtpk(o[dh][4 * g4 + 2] * inv * __uint_as_float(gt[c].y << 16), o[dh][4 * g4 + 3] * inv * __uint_as_float(gt[c].y & 0xffff0000u));
        gt[c] = w; }
    if (!dry) row_store_pieces(cp, hi, gt); else asm volatile("" :: "v"(gt[0].x), "v"(gt[3].y), "v"(gt[7].x));
}
__device__ __forceinline__ void moba_own_pair(const Args& a, int uA, int uB, LAS unsigned char* L, int wv, float Mref, int dry = 0) {
    const int tid = wv * 64 + lane_id_opaque(), lane = tid & 63, wid = wv, hi = lane >> 5;
    const int bhA = uA >> 6, iA = uA & 63, bA = bhA >> 3, hA = bhA & 7, bhB = uB >> 6, iB = uB & 63, bB = bhB >> 3, hB = bhB & 7;
    __syncthreads();
    load_kv_tiles(L, a.ka() + hm_off(bA, hA, iA * 256), a.va() + hm_off(bA, hA, iA * 256), 64, tid);
    const bool single = (uA == uB);
    if (!single) load_kv_tiles(L + ATT_LDS_END, a.ka() + hm_off(bB, hB, iB * 256), a.va() + hm_off(bB, hB, iB * 256), 64, tid);
    s16x8 qfA[4], qfB[4];
    load_qfrag(qfA, a.qa() + hm_off(bA, hA, iA * 256 + wid * 32 + (lane & 31)), hi);
    load_qfrag(qfB, a.qa() + hm_off(bB, hB, iB * 256 + (7 - wid) * 32 + (lane & 31)), hi);
    const unsigned pmA = iA > 0 ? (unsigned)a.pmask()[((size_t)bA * SEQ + iA * 256 + wid * 32 + (lane & 31)) * 8 + hA] : 0u;
    const unsigned pmB = iB > 0 ? (unsigned)a.pmask()[((size_t)bB * SEQ + iB * 256 + (7 - wid) * 32 + (lane & 31)) * 8 + hB] : 0u;
    __syncthreads();
    own_tile(a, L, qfA, pmA, bA, hA, iA, wid, lane, Mref, dry);
    own_tile(a, single ? L : L + ATT_LDS_END, qfB, pmB, bB, hB, iB, 7 - wid, lane, Mref, dry);
}

__device__ __forceinline__ void mem_attn_phase(const Args& a, int l, LAS unsigned char* L, int wv, int bid, int G, float Mref, int dry) {
    const int NU = BATCH * 4 * 64;
    int unit = bid;
    KVRegs kvr; s16x8 qf[4], qfn[4];
    if (unit < NU) {
        const int tid = wv * 64 + lane_id_opaque(), lane = tid & 63;
        const int bhm = unit >> 6, qt = unit & 63, b = bhm >> 2, hm = bhm & 3;
        const size_t kvoff = ((size_t)l * TM + b * MEM_LEN) * 256 + hm * 64;
        kv_issue(kvr, a.memk() + kvoff, a.memv() + kvoff, 256, tid);
        load_qfrag(qf, a.qm() + ((size_t)b * SEQ + qt * 256 + wv * 32 + (lane & 31)) * 256 + hm * 64, lane >> 5);
    }
    while (unit < NU) {
        const int tid = wv * 64 + lane_id_opaque(), lane = tid & 63, r32 = lane & 31, hi = lane >> 5;
        const int bhm = unit >> 6, qt = unit & 63, b = bhm >> 2, hm = bhm & 3;
        const int nunit = unit + G;
        __syncthreads();
        kv_commit(L, kvr, tid);
        if (nunit < NU) {
            const int nbhm = nunit >> 6, nqt = nunit & 63, nb = nbhm >> 2, nhm = nbhm & 3;
            const size_t kvoff = ((size_t)l * TM + nb * MEM_LEN) * 256 + nhm * 64;
            kv_issue(kvr, a.memk() + kvoff, a.memv() + kvoff, 256, tid);
            load_qfrag(qfn, a.qm() + ((size_t)nb * SEQ + nqt * 256 + wv * 32 + r32) * 256 + nhm * 64, hi);
        }
        const size_t tok = (size_t)b * SEQ + qt * 256 + wv * 32 + r32;
        bf16* cp = a.cb() + tok * 1024 + 768 + hm * 64;
        uint2 gt[8]; row_load_pieces(cp, hi, gt);
        __syncthreads();
        f32x16 cin;
#pragma unroll
        for (int r = 0; r < 16; ++r) cin[r] = -Mref;
        f32x16 o[2]; float lsum = 0.f;
#pragma unroll
        for (int r = 0; r < 16; ++r) { o[0][r] = 0.f; o[1][r] = 0.f; }
        attn_tiles(L, qf, cin, 0.f, 0, 8, -1, r32, hi, lane, o, lsum);
        lsum = red32(lsum);
        const float inv = __builtin_amdgcn_rcpf(lsum);
#pragma unroll
        for (int c = 0; c < 8; ++c) { const int dh = c >> 2, g4 = c & 3; const uint2 g2 = gt[c]; uint2 w;
            w.x = cvtpk(o[dh][4 * g4] * inv * __uint_as_float(g2.x << 16), o[dh][4 * g4 + 1] * inv * __uint_as_float(g2.x & 0xffff0000u));
            w.y = cvtpk(o[dh][4 * g4 + 2] * inv * __uint_as_float(g2.y << 16), o[dh][4 * g4 + 3] * inv * __uint_as_float(g2.y & 0xffff0000u));
            gt[c] = w; }
        if (!dry) row_store_pieces(cp, hi, gt); else asm volatile("" :: "v"(gt[0].x), "v"(gt[3].y), "v"(gt[7].x));
#pragma unroll
        for (int d0 = 0; d0 < 4; ++d0) qf[d0] = qfn[d0];
        unit = nunit;
    }
    __syncthreads();
}

__device__ __forceinline__ void gla_load_cumsum(const Args& a, LAS float* sb, size_t tok0, int h, int tid, int lane, int wid) {
    for (int e = tid; e < 64 * 32; e += NTHREADS) { const int t = e >> 5, d = e & 31; sb[t * 33 + d] = a.la()[(tok0 + t) * 128 + h * 32 + d]; }
    __syncthreads();
#pragma unroll
    for (int cc = 0; cc < 4; ++cc) { const int d = wid * 4 + cc; float v = sb[lane * 33 + d];
#pragma unroll
        for (int o = 1; o < 64; o <<= 1) { const float t = shup(v, o, lane); if (lane >= o) v += t; }
        sb[lane * 33 + d] = v; }
    __syncthreads();
}
struct GlaRaw1 { pg8::f32x4 la[2]; uint4 k, v[2]; };
__device__ __forceinline__ void gla_raw1_issue(const Args& a, GlaRaw1& r, int unit, int lt) {
    const int c = unit & 255, h = (unit >> 8) & 3, b = unit >> 10;
    const size_t tok0 = (size_t)b * SEQ + c * 64; const int row = lt >> 2, q4 = lt & 3;
    const float* lp = a.la() + (tok0 + row) * 128 + h * 32 + 8 * q4;
    r.la[0] = *(const pg8::f32x4*)lp; r.la[1] = *(const pg8::f32x4*)(lp + 4);
    r.k = *(const uint4*)(a.qbkb() + (tok0 + row) * 256 + 128 + h * 32 + 8 * q4);
    const bf16* vp = a.vb() + (tok0 + row) * 256 + h * 64 + 16 * q4;
    r.v[0] = *(const uint4*)vp; r.v[1] = *(const uint4*)(vp + 8);
}
__device__ __forceinline__ void gla_p1_phase(const Args& a, LAS unsigned char* L, int wv, int bid, int G) {
    const int NU = BATCH * 4 * NCH;
    const int grp = wv >> 2, lw = wv & 3;
    LAS float* sb = (LAS float*)L + grp * 9344; LAS float* skT = sb + 64 * 33; LAS float* sv = skT + 32 * 66;
    int unit = bid + grp * G;
    GlaRaw1 R;
    { const int lt = lw * 64 + lane_id_opaque(); if (unit < NU) gla_raw1_issue(a, R, unit, lt); }
    while (unit - grp * G < NU) {
        const int lane = lane_id_opaque(), lt = lw * 64 + lane, r16 = lane & 15, g = lane >> 4;
        const bool act = unit < NU;
        const int row = lt >> 2, q4 = lt & 3;
        if (act) { LAS float* p = sb + row * 33 + 8 * q4;
#pragma unroll
            for (int e = 0; e < 4; ++e) { p[e] = R.la[0][e]; p[4 + e] = R.la[1][e]; } }
        __syncthreads();
        if (act) {
#pragma unroll
            for (int cc = 0; cc < 8; ++cc) { const int d = lw * 8 + cc; float v = sb[lane * 33 + d];
#pragma unroll
                for (int o = 1; o < 64; o <<= 1) { const float t = shup(v, o, lane); if (lane >= o) v += t; }
                sb[lane * 33 + d] = v; }
        }
        __syncthreads();
        float dlast = 0.f;
        if (act) {
            const int d0 = 8 * q4;
            const unsigned ww[4] = {R.k.x, R.k.y, R.k.z, R.k.w};
#pragma unroll
            for (int e = 0; e < 4; ++e) {
                skT[(d0 + 2 * e) * 66 + row] = __uint_as_float(ww[e] << 16) * __expf(sb[63 * 33 + d0 + 2 * e] - sb[row * 33 + d0 + 2 * e]);
                skT[(d0 + 2 * e + 1) * 66 + row] = __uint_as_float(ww[e] & 0xffff0000u) * __expf(sb[63 * 33 + d0 + 2 * e + 1] - sb[row * 33 + d0 + 2 * e + 1]);
            }
            LAS float* vd = sv + row * 80 + 16 * q4;
#pragma unroll
            for (int hh = 0; hh < 2; ++hh) { const unsigned vw[4] = {R.v[hh].x, R.v[hh].y, R.v[hh].z, R.v[hh].w};
#pragma unroll
                for (int e = 0; e < 4; ++e) { vd[8 * hh + 2 * e] = __uint_as_float(vw[e] << 16); vd[8 * hh + 2 * e + 1] = __uint_as_float(vw[e] & 0xffff0000u); } }
            if (lt < 32) dlast = __expf(sb[63 * 33 + lt]);
        }
        const int cur = unit, nunit = unit + 2 * G;
        if (nunit < NU) gla_raw1_issue(a, R, nunit, lt);
        __syncthreads();
        if (act) {
            pg8::f32x4 acc0 = {0.f, 0.f, 0.f, 0.f}, acc1 = {0.f, 0.f, 0.f, 0.f};
#pragma unroll
            for (int ks = 0; ks < 16; ++ks) { const float bv = sv[(4 * ks + g) * 80 + 16 * lw + r16];
                acc0 = __builtin_amdgcn_mfma_f32_16x16x4f32(skT[r16 * 66 + 4 * ks + g], bv, acc0, 0, 0, 0);
                acc1 = __builtin_amdgcn_mfma_f32_16x16x4f32(skT[(16 + r16) * 66 + 4 * ks + g], bv, acc1, 0, 0, 0); }
#pragma unroll
            for (int r = 0; r < 4; ++r) { a.U()[(size_t)cur * 2048 + (4 * g + r) * 64 + 16 * lw + r16] = acc0[r]; a.U()[(size_t)cur * 2048 + (16 + 4 * g + r) * 64 + 16 * lw + r16] = acc1[r]; }
            if (lt < 32) a.Dc()[(size_t)cur * 32 + lt] = dlast;
        }
        unit = nunit;
        __syncthreads();
    }
}
__device__ __forceinline__ void gla_scan_slice(const Args& a, int slice, LAS unsigned char* L, int wv) {
    const int tid = wv * 64 + lane_id_opaque();
    const int e = tid & 63, sg = tid >> 6, bh = slice >> 5, d = slice & 31;
    LAS float* sS = (LAS float*)L; LAS float* sP = sS + 512;
    float Uv[32], Dv[32];
    const size_t unit0 = (size_t)bh * 256 + sg * 32;
#pragma unroll
    for (int c = 0; c < 32; ++c) { Dv[c] = a.Dc()[(unit0 + c) * 32 + d]; Uv[c] = a.U()[(unit0 + c) * 2048 + d * 64 + e]; }
    float S = 0.f, P = 1.f;
#pragma unroll
    for (int c = 0; c < 32; ++c) { S = Dv[c] * S + Uv[c]; P *= Dv[c]; }
    sS[sg * 64 + e] = S; sP[sg * 64 + e] = P;
    __syncthreads();
    float S0 = 0.f;
    for (int s2 = 0; s2 < sg; ++s2) S0 = sP[s2 * 64 + e] * S0 + sS[s2 * 64 + e];
    S = S0;
#pragma unroll
    for (int c = 0; c < 32; ++c) { a.Sst()[(unit0 + c) * 2048 + d * 64 + e] = S; S = Dv[c] * S + Uv[c]; }
    __syncthreads();
}
struct GlaRaw { pg8::f32x4 la[2], st[2]; uint4 q, k, v[2]; };
__device__ __forceinline__ void gla_raw_issue(const Args& a, GlaRaw& r, int unit, int lt) {
    const int c = unit & 255, h = (unit >> 8) & 3, b = unit >> 10;
    const size_t tok0 = (size_t)b * SEQ + c * 64; const int row = lt >> 2, q4 = lt & 3;
    const float* lp = a.la() + (tok0 + row) * 128 + h * 32 + 8 * q4;
    r.la[0] = *(const pg8::f32x4*)lp; r.la[1] = *(const pg8::f32x4*)(lp + 4);
    r.q = *(const uint4*)(a.qbkb() + (tok0 + row) * 256 + h * 32 + 8 * q4);
    r.k = *(const uint4*)(a.qbkb() + (tok0 + row) * 256 + 128 + h * 32 + 8 * q4);
    const bf16* vp = a.vb() + (tok0 + row) * 256 + h * 64 + 16 * q4;
    r.v[0] = *(const uint4*)vp; r.v[1] = *(const uint4*)(vp + 8);
    const float* sp = a.Sst() + (size_t)unit * 2048 + 8 * lt;
    r.st[0] = *(const pg8::f32x4*)sp; r.st[1] = *(const pg8::f32x4*)(sp + 4);
}
__device__ __forceinline__ void gla_p3_phase(const Args& a, int l, LAS unsigned char* L, int wv, int bid, int G, int dry) {
    constexpr int GF = 4288 + 2176 + 5120 + 2560 + 4224;
    const int NU = BATCH * 4 * NCH;
    const int grp = wv >> 2, lw = wv & 3;
    LAS float* sb = (LAS float*)L + grp * GF; LAS float* sk = sb + 64 * 33; LAS float* so = sb; LAS float* sq = sb + 4288; LAS float* sv = sq + 2176; LAS float* sS = sv + 5120; LAS float* sa = sS + 2560;
    int unit = bid + grp * G;
    GlaRaw R;
    { const int lt = lw * 64 + lane_id_opaque(); if (unit < NU) gla_raw_issue(a, R, unit, lt); }
    while (unit - grp * G < NU) {
        const int lane = lane_id_opaque(), lt = lw * 64 + lane, r16 = lane & 15, g = lane >> 4;
        const bool act = unit < NU;
        const int uc = act ? unit : 0;
        const int c = uc & 255, h = (uc >> 8) & 3, b = uc >> 10;
        const size_t tok0 = (size_t)b * SEQ + c * 64;
        const int row = lt >> 2, q4 = lt & 3;
        uint4* gptr = (uint4*)(a.cb() + (tok0 + row) * 1024 + 512 + h * 64 + 16 * q4);
        uint4 gate[2] = {make_uint4(0, 0, 0, 0), make_uint4(0, 0, 0, 0)};
        if (act) { gate[0] = gptr[0]; gate[1] = gptr[1]; }
        if (act) { LAS float* p = sb + row * 33 + 8 * q4;
#pragma unroll
            for (int e = 0; e < 4; ++e) { p[e] = R.la[0][e]; p[4 + e] = R.la[1][e]; } }
        __syncthreads();
        if (act) {
#pragma unroll
            for (int cc = 0; cc < 8; ++cc) { const int d = lw * 8 + cc; float v = sb[lane * 33 + d];
#pragma unroll
                for (int o = 1; o < 64; o <<= 1) { const float t = shup(v, o, lane); if (lane >= o) v += t; }
                sb[lane * 33 + d] = v; }
        }
        __syncthreads();
        float qk_keep[16];
        if (act) {
            const int d0 = 8 * q4;
            const unsigned qw[4] = {R.q.x, R.q.y, R.q.z, R.q.w}, kw[4] = {R.k.x, R.k.y, R.k.z, R.k.w};
#pragma unroll
            for (int e = 0; e < 4; ++e) {
                const float d0v = sb[row * 33 + d0 + 2 * e] - sb[31 * 33 + d0 + 2 * e], d1v = sb[row * 33 + d0 + 2 * e + 1] - sb[31 * 33 + d0 + 2 * e + 1];
                const float e0 = __expf(d0v), e1 = __expf(d1v);
                sq[row * 34 + d0 + 2 * e] = __uint_as_float(qw[e] << 16) * e0; sq[row * 34 + d0 + 2 * e + 1] = __uint_as_float(qw[e] & 0xffff0000u) * e1;
                qk_keep[2 * e] = __uint_as_float(kw[e] << 16) * __builtin_amdgcn_rcpf(e0); qk_keep[2 * e + 1] = __uint_as_float(kw[e] & 0xffff0000u) * __builtin_amdgcn_rcpf(e1);
            }
            LAS float* vd = sv + row * 80 + 16 * q4;
#pragma unroll
            for (int hh = 0; hh < 2; ++hh) { const unsigned vw[4] = {R.v[hh].x, R.v[hh].y, R.v[hh].z, R.v[hh].w};
#pragma unroll
                for (int e = 0; e < 4; ++e) { vd[8 * hh + 2 * e] = __uint_as_float(vw[e] << 16); vd[8 * hh + 2 * e + 1] = __uint_as_float(vw[e] & 0xffff0000u); } }
            const int sd = (8 * lt) >> 6, se = (8 * lt) & 63; const float em = __expf(sb[31 * 33 + sd]);
            LAS float* sd_ = sS + sd * 80 + se;
#pragma unroll
            for (int e = 0; e < 4; ++e) { sd_[e] = R.st[0][e] * em; sd_[4 + e] = R.st[1][e] * em; }
        }
        const int cur = unit, nunit = unit + 2 * G;
        if (nunit < NU) gla_raw_issue(a, R, nunit, lt);
        if (act) {
#pragma unroll
            for (int e = 0; e < 8; ++e) sk[row * 34 + 8 * q4 + e] = qk_keep[e];
        }
        __syncthreads();
        if (act) {
            for (int tt = lw; tt < 10; tt += 4) {
                const int rb = tt >= 6 ? 3 : tt >= 3 ? 2 : tt >= 1 ? 1 : 0, cb = tt - (rb * (rb + 1)) / 2;
                pg8::f32x4 acc = {0.f, 0.f, 0.f, 0.f};
#pragma unroll
                for (int ks = 0; ks < 8; ++ks) acc = __builtin_amdgcn_mfma_f32_16x16x4f32(sq[(16 * rb + r16) * 34 + 4 * ks + g], sk[(16 * cb + r16) * 34 + 4 * ks + g], acc, 0, 0, 0);
#pragma unroll
                for (int r = 0; r < 4; ++r) { const int i = 16 * rb + 4 * g + r, j = 16 * cb + r16; sa[i * 66 + j] = (j <= i) ? acc[r] : 0.f; }
            }
        }
        __syncthreads();
        pg8::f32x4 oacc[4];
        if (act) {
#pragma unroll
            for (int rb = 0; rb < 4; ++rb) oacc[rb] = (pg8::f32x4){0.f, 0.f, 0.f, 0.f};
#pragma unroll
            for (int ks = 0; ks < 8; ++ks) { const float bv = sS[(4 * ks + g) * 80 + 16 * lw + r16];
#pragma unroll
                for (int rb = 0; rb < 4; ++rb) oacc[rb] = __builtin_amdgcn_mfma_f32_16x16x4f32(sq[(16 * rb + r16) * 34 + 4 * ks + g], bv, oacc[rb], 0, 0, 0); }
#pragma unroll
            for (int ks = 0; ks < 16; ++ks) { const float bv = sv[(4 * ks + g) * 80 + 16 * lw + r16];
#pragma unroll
                for (int rb = 0; rb < 4; ++rb) if (ks < 4 * (rb + 1)) oacc[rb] = __builtin_amdgcn_mfma_f32_16x16x4f32(sa[(16 * rb + r16) * 66 + 4 * ks + g], bv, oacc[rb], 0, 0, 0); }
        }
        __syncthreads();
        if (act) {
#pragma unroll
            for (int rb = 0; rb < 4; ++rb)
#pragma unroll
                for (int r = 0; r < 4; ++r) so[(16 * rb + 4 * g + r) * 65 + 16 * lw + r16] = oacc[rb][r];
        }
        __syncthreads();
        if (act) {
            const LAS float* orow = so + row * 65 + 16 * q4;
            float ov[16]; float ss = 0.f;
#pragma unroll
            for (int e = 0; e < 16; ++e) { ov[e] = orow[e]; ss += ov[e] * ov[e]; }
            ss += shx(ss, 1, lane); ss += shx(ss, 2, lane);
            const float inv = pg8::rsq_f(ss * (1.f / 64.f) + EPS);
            const float* gg = a.g_gla_out() + l * 64 + 16 * q4;
            unsigned ow[8];
#pragma unroll
            for (int e = 0; e < 8; ++e) { const unsigned gw = (e < 4) ? ((e == 0) ? gate[0].x : (e == 1) ? gate[0].y : (e == 2) ? gate[0].z : gate[0].w) : ((e == 4) ? gate[1].x : (e == 5) ? gate[1].y : (e == 6) ? gate[1].z : gate[1].w);
                ow[e] = cvtpk(ov[2 * e] * inv * gg[2 * e] * __uint_as_float(gw << 16), ov[2 * e + 1] * inv * gg[2 * e + 1] * __uint_as_float(gw & 0xffff0000u)); }
            if (!dry) { gptr[0] = make_uint4(ow[0], ow[1], ow[2], ow[3]); gptr[1] = make_uint4(ow[4], ow[5], ow[6], ow[7]); } else asm volatile("" :: "v"(ow[0]), "v"(ow[3]), "v"(ow[7]));
        }
        (void)cur;
        unit = nunit;
        __syncthreads();
    }
}

__device__ __forceinline__ int src_col_in(int R) {
    const int tile = R >> 8, loc = R & 255, bj = loc >> 7, wc = (loc >> 5) & 3, j = loc & 31;
    switch (tile) {
        case 0: case 1: return C_QA + (4 * tile + wc) * 64 + 32 * bj + j;
        case 2: case 3: return C_KA + (4 * (tile - 2) + wc) * 64 + 32 * bj + j;
        case 4: case 5: return C_VA + 256 * (tile - 4) + loc;
        case 6: case 7: return C_GA + 256 * (tile - 6) + loc;
        case 8: return C_QB + loc;
        case 9: return C_VB + loc;
        case 10: return C_GB + loc;
        case 11: return C_QM + wc * 64 + 32 * bj + j;
        case 12: return C_GM + loc;
        default: return loc < 128 ? -(loc + 2) : -1;
    }
}

__device__ __forceinline__ void conv_item(const float* W, int ldw, int sc0, const float* g, bf16* WT, int R0, int k0, LAS float* scr, int lane) {
    float wv_[32];
#pragma unroll
    for (int i = 0; i < 32; ++i) { const int kk = 2 * i + (lane >> 5); wv_[i] = W[(size_t)(k0 + kk) * ldw + sc0 + (lane & 31)]; }
#pragma unroll
    for (int i = 0; i < 32; ++i) { const int kk = 2 * i + (lane >> 5); scr[kk * 33 + (lane & 31)] = wv_[i] * (g ? g[k0 + kk] : 1.f); }
    asm volatile("s_waitcnt lgkmcnt(0)" ::: "memory");
    const int c = lane & 7;
#pragma unroll
    for (int j = 0; j < 4; ++j) { const int n = (lane >> 3) + 8 * j; const LAS float* sp = scr + (8 * c) * 33 + n;
        uint4 o; o.x = pk2(sp[0 * 33], sp[1 * 33]); o.y = pk2(sp[2 * 33], sp[3 * 33]); o.z = pk2(sp[4 * 33], sp[5 * 33]); o.w = pk2(sp[6 * 33], sp[7 * 33]);
        *(uint4*)(WT + (size_t)(R0 + n) * DM + k0 + 8 * c) = o; }
    asm volatile("s_waitcnt lgkmcnt(0)" ::: "memory");
}
__device__ __forceinline__ void p0_prologue(const Args& a, LAS unsigned char* L, int bid, int G, int wv) {
    const int lane = lane_id_opaque(), gtid = bid * NTHREADS + wv * 64 + lane, nthreads = G * NTHREADS, gwave = bid * NWAVES + wv, nwaves = G * NWAVES;
    LAS float* scr = (LAS float*)(L + wv * 16384);
    constexpr int NB_IN = NINP / 32, I_IN = DEPTH * 16 * NB_IN, I_OUT = DEPTH * 16 * (DM / 32), I_MEM = DEPTH * 16 * 16;
    for (int it = gwave; it < I_IN + I_OUT + I_MEM; it += nwaves) {
        if (it < I_IN) {
            const int nb = it % NB_IN, kb = (it / NB_IN) % 16, l = it / (NB_IN * 16);
            const int sc = src_col_in(32 * nb);
            if (sc >= 0) conv_item(a.w_in() + (size_t)l * DM * NIN, NIN, sc, a.g_pre() + l * DM, a.wt_in() + (size_t)l * NINP * DM, 32 * nb, 64 * kb, scr, lane);
            else {
                const int R = 32 * nb + (lane & 31), kq = 64 * kb + 32 * (lane >> 5);
                const float* W = a.w_in() + (size_t)l * DM * NIN; const float* g = a.g_pre() + l * DM;
                const float* wg = a.w_gate_up() + (size_t)l * 16 * 128 + (R & 127);
                for (int k8 = 0; k8 < 4; ++k8) {
                    float v[8];
#pragma unroll
                    for (int kk = 0; kk < 8; ++kk) { float sacc = 0.f;
                        if (sc != -1) { const float* wr = W + (size_t)(kq + 8 * k8 + kk) * NIN + C_RB;
#pragma unroll
                            for (int r = 0; r < 16; ++r) sacc += wr[r] * wg[r * 128]; }
                        v[kk] = sacc * g[kq + 8 * k8 + kk]; }
                    uint4 o; o.x = pk2(v[0], v[1]); o.y = pk2(v[2], v[3]); o.z = pk2(v[4], v[5]); o.w = pk2(v[6], v[7]);
                    *(uint4*)(a.wt_in() + ((size_t)l * NINP + R) * DM + kq + 8 * k8) = o;
                }
            }
        } else if (it < I_IN + I_OUT) {
            const int r = it - I_IN, nb = r % 32, kb = (r / 32) % 16, l = r / 512;
            conv_item(a.w_out() + (size_t)l * DM * DM, DM, 32 * nb, nullptr, a.wt_out() + (size_t)l * DM * DM, 32 * nb, 64 * kb, scr, lane);
        } else {
            const int r = it - I_IN - I_OUT, nb = r % 16, kb = (r / 16) % 16, l = r / 256;
            const int loc = 32 * nb; int sc;
            if (loc < 256) { const int bj = loc >> 7, wc = (loc >> 5) & 3; sc = wc * 64 + 32 * bj; } else sc = loc;
            conv_item(a.w_mem_kv() + (size_t)l * DM * 512, 512, sc, a.g_mem() + l * DM, a.wt_mem() + (size_t)l * 512 * DM, loc, 64 * kb, scr, lane);
        }
    }
    for (int row = gwave; row < TM; row += nwaves) {
        const float4* xr = (const float4*)(a.mem() + (size_t)row * DM) + lane;
        float s = 0.f;
#pragma unroll
        for (int j = 0; j < 4; ++j) {
            const float4 v = xr[64 * j]; s += (v.x * v.x + v.y * v.y) + (v.z * v.z + v.w * v.w);
            uint2 o; o.x = pk2(v.x, v.y); o.y = pk2(v.z, v.w);
            *((uint2*)(a.membf() + (size_t)row * DM) + lane + 64 * j) = o;
        }
        s = wave_sum(s, lane);
        if (lane < 16) a.ssqm()[(size_t)row * 16 + lane] = (lane == 0) ? s : 0.f;
    }
    for (int row0 = gwave * 4; row0 < T; row0 += nwaves * 4) {
        float4 v[4][4];
#pragma unroll
        for (int rr = 0; rr < 4; ++rr)
#pragma unroll
            for (int j = 0; j < 4; ++j) v[rr][j] = ((const float4*)(a.x() + (size_t)(row0 + rr) * DM) + lane)[64 * j];
#pragma unroll
        for (int rr = 0; rr < 4; ++rr) {
            float sacc = 0.f;
#pragma unroll
            for (int j = 0; j < 4; ++j) {
                const float4 w = v[rr][j]; sacc += (w.x * w.x + w.y * w.y) + (w.z * w.z + w.w * w.w);
                uint2 o; o.x = pk2(w.x, w.y); o.y = pk2(w.z, w.w);
                *((uint2*)(a.xb() + (size_t)(row0 + rr) * DM) + lane + 64 * j) = o;
            }
            sacc = wave_sum(sacc, lane);
            if (lane < 16) a.ssq()[(size_t)(row0 + rr) * 16 + lane] = (lane == 0) ? sacc : 0.f;
        }
    }
}

constexpr int N_STEPS = 2 + 5 * DEPTH;
constexpr int CW_BAR = 4096;
#ifndef MK_SPLIT
#define MK_SPLIT 0
#endif
#ifndef PROBE
#define PROBE 0
#endif
__global__ void __launch_bounds__(NTHREADS, 2) mk_fwd(KArgs aa) {
    extern __shared__ __attribute__((aligned(16))) unsigned char lds[];
    const int G = gridDim.x;
    PG8_LAS unsigned char* L = (PG8_LAS unsigned char*)lds;
    const int wave_s = __builtin_amdgcn_readfirstlane(threadIdx.x >> 6);
    {
        const int tid0 = wave_s * 64 + (int)__builtin_amdgcn_mbcnt_hi(~0u, __builtin_amdgcn_mbcnt_lo(~0u, 0u));
        for (int u = tid0; u < 512 / 4; u += NTHREADS) ((LAS unsigned*)(L + MISC_OFF))[u] = 0u;
        __syncthreads();
    }
    unsigned* barw = (unsigned*)(aa.ws + O_CTL) + CW_BAR;
    XcdBarrier bar; bar.bar = barw; bar.x = 0; bar.st = nullptr;
    if (!MK_SPLIT) bar = xcd_barrier_post(barw, (volatile LAS unsigned*)(L + MISC_OFF) + 8, wave_s * 64 + (int)__builtin_amdgcn_mbcnt_hi(~0u, __builtin_amdgcn_mbcnt_lo(~0u, 0u)));
    const int ph_lo = aa.ph_lo, ph_hi = aa.ph_hi;
    for (int st = ph_lo; st < ph_hi; ++st) {
        int bid_o = blockIdx.x, wv_o = wave_s;
        asm volatile("" : "+s"(bid_o)); asm volatile("" : "+s"(wv_o));
        Args a; a.kp = (const __attribute__((address_space(4))) KArgs*)__builtin_amdgcn_kernarg_segment_ptr();
        asm volatile("" : "+s"(a.kp));
        const int wave = wv_o, bid = bid_o;
        if (st == 0) {
            p0_prologue(a, L, bid, G, wave);
            if (PROBE == 11) p0_prologue(a, L, bid, G, wave);
        } else if (st == 1) {
            pg8::Gemm g{a.membf(), a.wt_mem(), TM, DEPTH * 512, DM}; pg8::StaticOrder S; S.init(TM, DEPTH * 512, G, bid);
            pg8::EpiMem E{a.memk(), a.memv(), a.ssqm(), a.g_k_mem(), TM};
            pg8::gemm_phase<pg8::EpiMem, pg8::StaticOrder, false, true>(L, g, S, E, wave);
        } else {
            const int l = (st - 2) / 5, k = (st - 2) % 5;
            for (int rep = 0; rep < ((PROBE == k + 1) ? 2 : 1); ++rep) {
            const int dry = (PROBE == k + 1 && rep == 0 && (k == 3 || k == 4 || k == 1)) ? 1 : 0;
            if (k == 0) {
                if (bid == 0) { const int t0 = wave * 64 + lane_id_opaque(); a.gcnt()[t0] = 0u; a.gcnt()[t0 + 512] = 0u; }
                pg8::Gemm g{a.xb(), a.wt_in() + (size_t)l * NINP * DM, T, NINP, DM}; pg8::StaticOrder S; S.init(T, NINP, G, bid);
                pg8::EpiIn E{a.qa(), a.ka(), a.va(), a.cb(), a.qbkb(), a.vb(), a.qm(), a.la(), a.kmp(), a.ssq(), a.g_q_moba() + l * 64, a.g_k_moba() + l * 64, a.g_q_mem() + l * 64, a.b_gate_up() + l * 128};
                if (PROBE == 13) { pg8::EpiDry ED; pg8::gemm_phase<pg8::EpiDry, pg8::StaticOrder, true, true>(L, g, S, ED, wave); }
                pg8::gemm_phase<pg8::EpiIn, pg8::StaticOrder, true, true>(L, g, S, E, wave);
            } else if (k == 1) {
                const float zthr = zero_thr(softmax_ref(a.g_q_moba() + l * 64, a.g_k_moba() + l * 64));
                moba_route_phase(a, L, wave, bid, G, zthr, dry);
                gla_p1_phase(a, L, wave, bid, G);
            } else if (k == 2) {
                for (int sl = bid; sl < 256; sl += G) gla_scan_slice(a, sl, L, wave);
                if (PROBE == 9) moba_pairs_phase(a, l, L, wave, bid, G, 1);
                if (PROBE == 10) for (int sl = bid; sl < 256; sl += G) gla_scan_slice(a, sl, L, wave);
                moba_pairs_phase(a, l, L, wave, bid, G);
            } else if (k == 3) {
                const float Mref = softmax_ref(a.g_q_moba() + l * 64, a.g_k_moba() + l * 64);
                if (PROBE >= 6) {
                    if (PROBE == 6) for (int u = bid; u < BATCH * 8 * 64; u += 2 * G) moba_own_pair(a, u, (u + G < BATCH * 8 * 64) ? u + G : u, L, wave, Mref, 1);
                    const float Mm0 = softmax_ref(a.g_q_mem() + l * 64, a.g_k_mem() + l * 64);
                    if (PROBE == 7) mem_attn_phase(a, l, L, wave, bid, G, Mm0, 1);
                    if (PROBE == 8) gla_p3_phase(a, l, L, wave, bid, G, 1);
                }
                for (int u = bid; u < BATCH * 8 * 64; u += 2 * G) moba_own_pair(a, u, (u + G < BATCH * 8 * 64) ? u + G : u, L, wave, Mref, dry);
                const float Mm = softmax_ref(a.g_q_mem() + l * 64, a.g_k_mem() + l * 64);
                mem_attn_phase(a, l, L, wave, bid, G, Mm, dry);
                gla_p3_phase(a, l, L, wave, bid, G, dry);
            } else {
                pg8::Gemm g{a.cb(), a.wt_out() + (size_t)l * DM * DM, T, DM, DM}; pg8::StaticOrder S; S.init(T, DM, G, bid);
                if (l == 0) { pg8::EpiOut<1, 0> E{a.x(), a.out(), a.xb(), a.ssq()}; pg8::gemm_phase<pg8::EpiOut<1, 0>, pg8::StaticOrder, true, true>(L, g, S, E, wave); }
                else if (l == DEPTH - 1) { pg8::EpiOut<0, 1> E{a.x(), a.out(), a.xb(), a.ssq()}; pg8::gemm_phase<pg8::EpiOut<0, 1>, pg8::StaticOrder, true, true>(L, g, S, E, wave); }
                else { pg8::EpiOut<0, 0> E{a.x(), a.out(), a.xb(), a.ssq()}; pg8::gemm_phase<pg8::EpiOut<0, 0>, pg8::StaticOrder, true, true>(L, g, S, E, wave); }
            }
            }
        }
        if (!MK_SPLIT && st + 1 < ph_hi && st != 1) {
            XcdBarrier b2 = bar; unsigned* bp = b2.bar; unsigned bx = b2.x;
            asm volatile("" : "+s"(bp)); asm volatile("" : "+s"(bx));
            b2.bar = bp; b2.x = bx;
            xcd_barrier(b2, wave);
            if (PROBE == 12) xcd_barrier(b2, wave);
        }
    }
}

extern "C" void kernel_launch(void* const* d_in, const int* in_sizes, int n_in, void* d_out, int out_size, void* d_ws, size_t ws_size, hipStream_t stream) {
    static int grid = 0;
    if (grid == 0) {
        int dev = 0, cus = 0;
        if (hipGetDevice(&dev) != hipSuccess || hipDeviceGetAttribute(&cus, hipDeviceAttributeMultiprocessorCount, dev) != hipSuccess) { grid = -1; return; }
        if (hipFuncSetAttribute((const void*)mk_fwd, hipFuncAttributeMaxDynamicSharedMemorySize, LDS_BYTES) != hipSuccess) { fprintf(stderr, "hipFuncSetAttribute failed\n"); grid = -1; return; }
        grid = cus;
    }
    if (grid < 0) return;
    KArgs a{};
    a.x = (const float*)d_in[0]; a.mem = (const float*)d_in[1]; a.g_pre = (const float*)d_in[2]; a.w_in = (const float*)d_in[3];
    a.g_q_moba = (const float*)d_in[4]; a.g_k_moba = (const float*)d_in[5]; a.w_gate_up = (const float*)d_in[6]; a.b_gate_up = (const float*)d_in[7];
    a.g_gla_out = (const float*)d_in[8]; a.g_mem = (const float*)d_in[9]; a.w_mem_kv = (const float*)d_in[10]; a.g_q_mem = (const float*)d_in[11];
    a.g_k_mem = (const float*)d_in[12]; a.w_out = (const float*)d_in[13];
    a.out = (float*)d_out;
    a.ws = (unsigned char*)d_ws;
    (void)ws_size; (void)in_sizes; (void)n_in; (void)out_size;
    (void)hipMemsetAsync((char*)d_ws + O_CTL, 0, 1 << 16, stream);
#if MK_SPLIT
    for (int st = 0; st < N_STEPS; ++st) { a.ph_lo = st; a.ph_hi = st + 1; hipLaunchKernelGGL(mk_fwd, dim3(grid), dim3(NTHREADS), LDS_BYTES, stream, a); }
#else
    a.ph_lo = 0; a.ph_hi = N_STEPS;
    hipLaunchKernelGGL(mk_fwd, dim3(grid), dim3(NTHREADS), LDS_BYTES, stream, a);
#endif
}
```

```cpp
#include <hip/hip_runtime.h>
#include <cstdio>
#include <cstdint>
#include <cstddef>

constexpr int BATCH = 2, SEQ = 16384, DM = 1024, DEPTH = 4, T = BATCH * SEQ;
constexpr int MEM_LEN = 256, TM = BATCH * MEM_LEN;
constexpr int NIN = 3344;
constexpr int C_QA = 0, C_KA = 512, C_VA = 1024, C_GA = 1536, C_QB = 2048, C_KB = 2176, C_VB = 2304, C_GB = 2560, C_RB = 2816, C_QM = 2832, C_GM = 3088;
constexpr int NB = SEQ / 256;
constexpr int NCH = SEQ / 64;
constexpr float EPS = 1e-6f;
constexpr int NINP = 14 * 256;
constexpr float LOG2E = 1.4426950408889634f;
constexpr float QSCALE = 0.125f * LOG2E;

__device__ __forceinline__ int lane_id_opaque() { int l; asm volatile("v_mbcnt_lo_u32_b32 %0, -1, 0\n\tv_mbcnt_hi_u32_b32 %0, -1, %0" : "=v"(l)); return l; }
__device__ __forceinline__ float red16(float v) { const auto r = __builtin_amdgcn_permlane16_swap(__float_as_uint(v), __float_as_uint(v), false, false); return __uint_as_float(r[0]) + __uint_as_float(r[1]); }
__device__ __forceinline__ float red32(float v) { const auto r = __builtin_amdgcn_permlane32_swap(__float_as_uint(v), __float_as_uint(v), false, false); return __uint_as_float(r[0]) + __uint_as_float(r[1]); }
template <int CTRL> __device__ __forceinline__ float dppmov(float v) { return __int_as_float(__builtin_amdgcn_update_dpp(0, __float_as_int(v), CTRL, 0xF, 0xF, false)); }
__device__ __forceinline__ float row16_sum(float v) { v += dppmov<0x128>(v); v += dppmov<0x124>(v); v += dppmov<0x4E>(v); v += dppmov<0xB1>(v); return v; }
__device__ __forceinline__ float shx(float v, int mask, int lane) { return __int_as_float(__builtin_amdgcn_ds_bpermute((lane ^ mask) << 2, __float_as_int(v))); }
__device__ __forceinline__ int shx_i(int v, int mask, int lane) { return __builtin_amdgcn_ds_bpermute((lane ^ mask) << 2, v); }
__device__ __forceinline__ float shup(float v, int o, int lane) { return __int_as_float(__builtin_amdgcn_ds_bpermute((lane >= o ? lane - o : lane) << 2, __float_as_int(v))); }
__device__ __forceinline__ int shup_i(int v, int o, int lane) { return __builtin_amdgcn_ds_bpermute((lane >= o ? lane - o : lane) << 2, v); }

namespace pg8 {
#define PG8_LAS __attribute__((address_space(3)))
typedef unsigned short bf16_t;
typedef short bf16x8 __attribute__((ext_vector_type(8)));
typedef float f32x4 __attribute__((ext_vector_type(4)));
typedef unsigned u32x4 __attribute__((ext_vector_type(4)));
constexpr int BM = 256, BK = 64, HALF = 128, HTB = HALF * BK * 2  , STAGE_BYTES = 8 * HTB, NXCD = 8, WGM = 8;

__host__ __device__ __forceinline__ int lds_byte(int r, int c) { const int st = (r >> 4) * 2 + (c >> 5), rr = r & 15, cc = c & 31, ob = rr * 64 + cc * 2; return st * 1024 + (ob ^ (((ob >> 9) & 1) << 5)); }
__host__ __device__ __forceinline__ void stage_rc(int b, int& R, int& C) { const int st = b / 1024, sb = b % 1024, swz = sb ^ (((sb >> 9) & 1) << 5); R = (st >> 1) * 16 + swz / 64; C = (st & 1) * 32 + (swz % 64) / 2; }
__host__ __device__ __forceinline__ int perm32(int rho) { const int n = rho >> 4, i = rho & 15; return 8 * (i >> 2) + 4 * n + (i & 3); }

struct Unit { int pm, pn; };
struct Gemm { const bf16_t* A; const bf16_t* Bt; int M, N, K; };

struct StaticOrder {
    int nM, nN, nwg, G, c;
    __host__ __device__ void init(int M, int N, int G_, int c_) { nM = M / BM; nN = N / BM; nwg = nM * nN; G = G_; c = c_; }
    __host__ __device__ bool next(int i, Unit& u) const {
        const long L = (long)i * G + c; if (L >= nwg) return false;
        int wgid = (int)L; { const int q = nwg / NXCD, r = nwg % NXCD, xcd = wgid % NXCD, off = wgid / NXCD; wgid = (xcd < r ? xcd * (q + 1) : r * (q + 1) + (xcd - r) * q) + off; }
        const int nig = WGM * nN, gid = wgid / nig, fm = gid * WGM, gsz = (nM - fm) < WGM ? (nM - fm) : WGM;
        u.pm = fm + ((wgid % nig) % gsz); u.pn = (wgid % nig) / gsz; return true;
    }
    __device__ __forceinline__ void a_ready(const Unit&) const {}
    __device__ __forceinline__ void done(const Unit&) const {}
};

__device__ __forceinline__ unsigned cvt_pk_bf16(float lo, float hi) { unsigned r; asm volatile("v_cvt_pk_bf16_f32 %0, %1, %2" : "=v"(r) : "v"(lo), "v"(hi)); return r; }
__device__ __forceinline__ float silu_f(float g) { return g * __builtin_amdgcn_rcpf(1.f + __builtin_amdgcn_exp2f(-1.4426950408889634f * g)); }
__device__ __forceinline__ float rsq_f(float x) { return __builtin_amdgcn_rsqf(x); }
typedef unsigned u32x2 __attribute__((ext_vector_type(2)));

struct EpiIn {
    static constexpr bool PERM = true, AFTER_DRAIN = false;
    bf16_t *qa, *ka, *va, *cb, *qbkb, *vb, *qm; float *la, *kmp; const float *ssq, *gq, *gk, *gqm, *bgu;
    __device__ __forceinline__ void operator()(const f32x4 (&acc)[2][2][4][2], const Unit& u, int wr, int wc, int fr, int fq) const {
        const int row0 = u.pm * BM + wr * 64 + fr, lane = fq * 16 + fr;
        float rs[2][4];
        {
            f32x4 pp[2][4];
#pragma unroll
            for (int ai = 0; ai < 2; ++ai)
#pragma unroll
                for (int m = 0; m < 4; ++m) pp[ai][m] = *(const f32x4*)(ssq + (size_t)(row0 + ai * HALF + m * 16) * 16 + fq * 4);
            asm volatile("" : "+v"(pp[0][0]), "+v"(pp[0][1]), "+v"(pp[0][2]), "+v"(pp[0][3]), "+v"(pp[1][0]), "+v"(pp[1][1]), "+v"(pp[1][2]), "+v"(pp[1][3]));
#pragma unroll
            for (int ai = 0; ai < 2; ++ai)
#pragma unroll
                for (int m = 0; m < 4; ++m) {
                    const f32x4 p = pp[ai][m];
                    float s = (p[0] + p[1]) + (p[2] + p[3]);
                    s = red16(s); s = red32(s);
                    rs[ai][m] = rsq_f(s * (1.f / 1024.f) + EPS);
                }
        }
        const int pn = u.pn;
        if (pn <= 3 || pn == 11) {
            bf16_t* dst; const float* g; float qs; int head, ld;
            if (pn <= 1) { dst = qa; g = gq; qs = QSCALE; head = 4 * pn + wc; ld = 512; }
            else if (pn <= 3) { dst = ka; g = gk; qs = 1.f; head = 4 * (pn - 2) + wc; ld = 512; }
            else { dst = qm; g = gqm; qs = QSCALE; head = wc; ld = 256; }
            f32x4 gv[2][2];
#pragma unroll
            for (int bj = 0; bj < 2; ++bj)
#pragma unroll
                for (int n = 0; n < 2; ++n) gv[bj][n] = *(const f32x4*)(g + 32 * bj + 8 * fq + 4 * n);
            f32x4 ksum[2][2];
#pragma unroll
            for (int bj = 0; bj < 2; ++bj)
#pragma unroll
                for (int n = 0; n < 2; ++n) ksum[bj][n] = (f32x4){0.f, 0.f, 0.f, 0.f};
#pragma unroll
            for (int ai = 0; ai < 2; ++ai)
#pragma unroll
                for (int m = 0; m < 4; ++m) {
                    f32x4 v[2][2]; float ss = 0.f;
#pragma unroll
                    for (int bj = 0; bj < 2; ++bj)
#pragma unroll
                        for (int n = 0; n < 2; ++n) { v[bj][n] = acc[ai][bj][m][n] * rs[ai][m]; const f32x4 t = v[bj][n]; ss += (t[0] * t[0] + t[1] * t[1]) + (t[2] * t[2] + t[3] * t[3]); }
                    ss = red16(ss); ss = red32(ss);
                    const float inv = rsq_f(ss * (1.f / 64.f) + EPS);
                    const int grow = row0 + ai * HALF + m * 16;
                    bf16_t* rowp = (pn <= 3) ? dst + (((size_t)((u.pm >> 6) * 8 + head)) * SEQ + (grow & (SEQ - 1))) * 64 + 8 * fq : dst + (size_t)grow * ld + head * 64 + 8 * fq;
#pragma unroll
                    for (int bj = 0; bj < 2; ++bj) {
                        const f32x4 a = v[bj][0] * inv * gv[bj][0], b = v[bj][1] * inv * gv[bj][1];
                        ksum[bj][0] += a; ksum[bj][1] += b;
                        u32x4 w; w.x = cvt_pk_bf16(a[0] * qs, a[1] * qs); w.y = cvt_pk_bf16(a[2] * qs, a[3] * qs); w.z = cvt_pk_bf16(b[0] * qs, b[1] * qs); w.w = cvt_pk_bf16(b[2] * qs, b[3] * qs);
                        *(u32x4*)(rowp + 32 * bj) = w;
                    }
                }
            if (pn == 2 || pn == 3) {
#pragma unroll
                for (int bj = 0; bj < 2; ++bj)
#pragma unroll
                    for (int n = 0; n < 2; ++n)
#pragma unroll
                        for (int e = 0; e < 4; ++e) ksum[bj][n][e] = row16_sum(ksum[bj][n][e]);
                if (fr == 0) {
                    const int b = u.pm >> 6, blk = u.pm & 63;
                    float* kp = kmp + ((((size_t)(b * 8 + head) * 64 + blk) * 2 + wr) * 64) + 8 * fq;
#pragma unroll
                    for (int bj = 0; bj < 2; ++bj)
#pragma unroll
                        for (int n = 0; n < 2; ++n) *(f32x4*)(kp + 32 * bj + 4 * n) = ksum[bj][n];
                }
            }
        } else if (pn == 13) {
            f32x4 bv[2];
#pragma unroll
            for (int n = 0; n < 2; ++n) bv[n] = *(const f32x4*)(bgu + 32 * wc + 8 * fq + 4 * n);
#pragma unroll
            for (int ai = 0; ai < 2; ++ai)
#pragma unroll
                for (int m = 0; m < 4; ++m) {
                    float* rowp = la + (size_t)(row0 + ai * HALF + m * 16) * 128 + 32 * wc + 8 * fq;
#pragma unroll
                    for (int n = 0; n < 2; ++n) {
                        const f32x4 z = acc[ai][0][m][n] * rs[ai][m] + bv[n]; f32x4 o;
#pragma unroll
                        for (int e = 0; e < 4; ++e) o[e] = (fminf(z[e], 0.f) - 0.6931471805599453f * __builtin_amdgcn_logf(1.f + __builtin_amdgcn_exp2f(-1.4426950408889634f * fabsf(z[e])))) * (1.f / 16.f);
                        *(f32x4*)(rowp + 4 * n) = o;
                    }
                }
        } else {
            const int b = u.pm >> 6;
            if (pn == 4 || pn == 5) {
                bf16_t* base = va + (((size_t)(b * 8 + 4 * (pn - 4) + (wc >> 1))) * SEQ + (row0 & (SEQ - 1))) * 64 + 32 * (wc & 1) + 8 * fq;
                plain_rows<64, (long)2 * SEQ * 64, false>(acc, rs, base, 1.f);
            } else if (pn == 6 || pn == 7) plain_rows<1024, HALF, true>(acc, rs, cb + (size_t)row0 * 1024 + 256 * (pn - 6) + 32 * wc + 8 * fq, 1.f);
            else if (pn == 8) plain_rows<256, HALF, false>(acc, rs, qbkb + (size_t)row0 * 256 + 32 * wc + 8 * fq, 0.17677669529663687f);
            else if (pn == 9) plain_rows<256, HALF, false>(acc, rs, vb + (size_t)row0 * 256 + 32 * wc + 8 * fq, 1.f);
            else if (pn == 10) plain_rows<1024, HALF, true>(acc, rs, cb + (size_t)row0 * 1024 + 512 + 32 * wc + 8 * fq, 1.f);
            else plain_rows<1024, HALF, true>(acc, rs, cb + (size_t)row0 * 1024 + 768 + 32 * wc + 8 * fq, 1.f);
        }
    }
    template <int LD, long BJ, bool GATE> static __device__ __forceinline__ void plain_rows(const f32x4 (&acc)[2][2][4][2], const float (&rs)[2][4], bf16_t* base, float sc0) {
#pragma unroll
        for (int ai = 0; ai < 2; ++ai)
#pragma unroll
            for (int m = 0; m < 4; ++m) {
                bf16_t* rowp = base + (size_t)(ai * HALF + m * 16) * LD;
#pragma unroll
                for (int bj = 0; bj < 2; ++bj) {
                    const float sc = rs[ai][m] * (bj == 0 ? sc0 : 1.f);
                    f32x4 a = acc[ai][bj][m][0] * sc, b = acc[ai][bj][m][1] * sc;
                    if (GATE) {
#pragma unroll
                        for (int e = 0; e < 4; ++e) { a[e] = silu_f(a[e]); b[e] = silu_f(b[e]); }
                    }
                    u32x4 w; w.x = cvt_pk_bf16(a[0], a[1]); w.y = cvt_pk_bf16(a[2], a[3]); w.z = cvt_pk_bf16(b[0], b[1]); w.w = cvt_pk_bf16(b[2], b[3]);
                    *(u32x4*)(rowp + BJ * bj) = w;
                }
            }
    }
};
struct EpiDry {
    static constexpr bool PERM = true, AFTER_DRAIN = false;
    __device__ __forceinline__ void operator()(const f32x4 (&acc)[2][2][4][2], const Unit& u, int wr, int wc, int fr, int fq) const {
        f32x4 t = {0.f, 0.f, 0.f, 0.f};
#pragma unroll
        for (int ai = 0; ai < 2; ++ai)
#pragma unroll
            for (int bj = 0; bj < 2; ++bj)
#pragma unroll
                for (int m = 0; m < 4; ++m) t += acc[ai][bj][m][0] + acc[ai][bj][m][1];
        asm volatile("" :: "v"(t));
    }
};
template <int FIRST, int LAST> struct EpiOut {
    static constexpr bool PERM = false, AFTER_DRAIN = false;
    const float* xin; float* xout; bf16_t* xb; float* ssq;
    __device__ __forceinline__ void operator()(const f32x4 (&acc)[2][2][4][2], const Unit& u, int wr, int wc, int fr, int fq) const {
        const int row0 = u.pm * BM + wr * 64 + fr, col0 = u.pn * BM + wc * 32 + 4 * fq;
#pragma unroll
        for (int ai = 0; ai < 2; ++ai)
#pragma unroll
            for (int mh = 0; mh < 2; ++mh) {
                f32x4 xr[2][2][2];
                if (FIRST) {
#pragma unroll
                    for (int mm = 0; mm < 2; ++mm)
#pragma unroll
                        for (int bj = 0; bj < 2; ++bj)
#pragma unroll
                            for (int n = 0; n < 2; ++n) xr[mm][bj][n] = *(const f32x4*)(xin + (size_t)(row0 + ai * HALF + (2 * mh + mm) * 16) * DM + col0 + bj * HALF + n * 16);
                } else {
                    u32x2 xw[2][2][2];
#pragma unroll
                    for (int mm = 0; mm < 2; ++mm)
#pragma unroll
                        for (int bj = 0; bj < 2; ++bj)
#pragma unroll
                            for (int n = 0; n < 2; ++n) xw[mm][bj][n] = *(const u32x2*)(xb + (size_t)(row0 + ai * HALF + (2 * mh + mm) * 16) * DM + col0 + bj * HALF + n * 16);
                    asm volatile("" : "+v"(xw[0][0][0]), "+v"(xw[0][0][1]), "+v"(xw[0][1][0]), "+v"(xw[0][1][1]), "+v"(xw[1][0][0]), "+v"(xw[1][0][1]), "+v"(xw[1][1][0]), "+v"(xw[1][1][1]));
#pragma unroll
                    for (int mm = 0; mm < 2; ++mm)
#pragma unroll
                        for (int bj = 0; bj < 2; ++bj)
#pragma unroll
                            for (int n = 0; n < 2; ++n) { const u32x2 w = xw[mm][bj][n]; xr[mm][bj][n] = (f32x4){__uint_as_float(w.x << 16), __uint_as_float(w.x & 0xffff0000u), __uint_as_float(w.y << 16), __uint_as_float(w.y & 0xffff0000u)}; }
                }
#pragma unroll
                for (int mm = 0; mm < 2; ++mm) {
                    const int m = 2 * mh + mm, row = row0 + ai * HALF + m * 16; float ss = 0.f;
#pragma unroll
                    for (int bj = 0; bj < 2; ++bj)
#pragma unroll
                        for (int n = 0; n < 2; ++n) {
                            const size_t off = (size_t)row * DM + col0 + bj * HALF + n * 16;
                            const f32x4 v = xr[mm][bj][n] + acc[ai][bj][m][n];
                            if (LAST) *(f32x4*)(xout + off) = v;
                            else { u32x2 w; w.x = cvt_pk_bf16(v[0], v[1]); w.y = cvt_pk_bf16(v[2], v[3]); *(u32x2*)(xb + off) = w;
                                   const float r0 = __uint_as_float(w.x << 16), r1 = __uint_as_float(w.x & 0xffff0000u), r2 = __uint_as_float(w.y << 16), r3 = __uint_as_float(w.y & 0xffff0000u);
                                   ss += (r0 * r0 + r1 * r1) + (r2 * r2 + r3 * r3); }
                        }
                    if (!LAST) { ss = red16(ss); ss = red32(ss); if (fq == 0) ssq[(size_t)row * 16 + 4 * u.pn + wc] = ss; }
                }
                asm volatile("" ::: "memory");
            }
    }
};

struct EpiMem {
    static constexpr bool PERM = true, AFTER_DRAIN = false;
    bf16_t *memk, *memv; const float *ssqm, *gkm; int tm;
    __device__ __forceinline__ void operator()(const f32x4 (&acc)[2][2][4][2], const Unit& u, int wr, int wc, int fr, int fq) const {
        const int row0 = u.pm * BM + wr * 64 + fr, lane = fq * 16 + fr;
        float rs[2][4];
#pragma unroll
        for (int ai = 0; ai < 2; ++ai)
#pragma unroll
            for (int m = 0; m < 4; ++m) {
                const int row = row0 + ai * HALF + m * 16;
                const f32x4 p = *(const f32x4*)(ssqm + (size_t)row * 16 + fq * 4);
                float s = (p[0] + p[1]) + (p[2] + p[3]);
                s = red16(s); s = red32(s);
                rs[ai][m] = rsq_f(s * (1.f / 1024.f) + EPS);
            }
        const int layer = u.pn >> 1;
        if ((u.pn & 1) == 0) {
            bf16_t* dst = memk + (size_t)layer * tm * 256; const float* g = gkm + layer * 64;
            f32x4 gv[2][2];
#pragma unroll
            for (int bj = 0; bj < 2; ++bj)
#pragma unroll
                for (int n = 0; n < 2; ++n) gv[bj][n] = *(const f32x4*)(g + 32 * bj + 8 * fq + 4 * n);
#pragma unroll
            for (int ai = 0; ai < 2; ++ai)
#pragma unroll
                for (int m = 0; m < 4; ++m) {
                    f32x4 v[2][2]; float ss = 0.f;
#pragma unroll
                    for (int bj = 0; bj < 2; ++bj)
#pragma unroll
                        for (int n = 0; n < 2; ++n) { v[bj][n] = acc[ai][bj][m][n] * rs[ai][m]; const f32x4 t = v[bj][n]; ss += (t[0] * t[0] + t[1] * t[1]) + (t[2] * t[2] + t[3] * t[3]); }
                    ss = red16(ss); ss = red32(ss);
                    const float inv = rsq_f(ss * (1.f / 64.f) + EPS);
                    bf16_t* rowp = dst + (size_t)(row0 + ai * HALF + m * 16) * 256 + wc * 64 + 8 * fq;
#pragma unroll
                    for (int bj = 0; bj < 2; ++bj) {
                        const f32x4 a = v[bj][0] * inv * gv[bj][0], b = v[bj][1] * inv * gv[bj][1];
                        u32x4 w; w.x = cvt_pk_bf16(a[0], a[1]); w.y = cvt_pk_bf16(a[2], a[3]); w.z = cvt_pk_bf16(b[0], b[1]); w.w = cvt_pk_bf16(b[2], b[3]);
                        *(u32x4*)(rowp + 32 * bj) = w;
                    }
                }
        } else {
            bf16_t* dst = memv + (size_t)layer * tm * 256;
#pragma unroll
            for (int ai = 0; ai < 2; ++ai)
#pragma unroll
                for (int m = 0; m < 4; ++m) {
                    bf16_t* rowp = dst + (size_t)(row0 + ai * HALF + m * 16) * 256 + 32 * wc + 8 * fq;
#pragma unroll
                    for (int bj = 0; bj < 2; ++bj) {
                        const f32x4 a = acc[ai][bj][m][0] * rs[ai][m], b = acc[ai][bj][m][1] * rs[ai][m];
                        u32x4 w; w.x = cvt_pk_bf16(a[0], a[1]); w.y = cvt_pk_bf16(a[2], a[3]); w.z = cvt_pk_bf16(b[0], b[1]); w.w = cvt_pk_bf16(b[2], b[3]);
                        *(u32x4*)(rowp + HALF * bj) = w;
                    }
                }
        }
    }
};
template <class Epi, class Sched, bool ALIGN_EPI = false, bool SP2 = false>
__device__ __forceinline__ void gemm_phase(PG8_LAS unsigned char* lds, const Gemm g, const Sched& S, const Epi& E, int wv) {
    const int tid_l = wv * 64 + lane_id_opaque();
    const int tid = tid_l, wid = __builtin_amdgcn_readfirstlane(tid >> 6), lane = tid & 63, wr = wid >> 2, wc = wid & 3, fr = lane & 15, fq = lane >> 4;
    const int K = g.K, nt = K / BK;
    unsigned voffA[2], voffB[2];
#pragma unroll
    for (int i = 0; i < 2; ++i) { int R, C; stage_rc(tid * 16 + i * 8192, R, C); const int Rb = Epi::PERM ? ((R & ~31) + perm32(R & 31)) : R;
        voffA[i] = (unsigned)(R * K + C) * 2u; voffB[i] = (unsigned)(Rb * K + C) * 2u; }
    const size_t kstep = (size_t)(BK * 2);
    const size_t hstep = (size_t)HALF * K * 2;
    const size_t tstep = 2 * hstep;
    const unsigned ldsw = (unsigned)wid * 1024u;
    const int aoff = lds_byte(wr * 64 + fr, fq * 8), boff = lds_byte(wc * 32 + fr, fq * 8);
#define PG8_SA(b, h) (((b) * 2 + (h)) * HTB)
#define PG8_SB(b, h) ((4 + (b) * 2 + (h)) * HTB)
#define PG8_STAGE(bufoff, gbase, voff) do { _Pragma("unroll") for (int _i = 0; _i < 2; ++_i) \
        __builtin_amdgcn_global_load_lds((const unsigned*)((const char*)(gbase) + (voff)[_i]), (PG8_LAS unsigned*)(lds + (bufoff) + ldsw + _i * 8192), 16, 0, 0); } while (0)
#define PG8_LDA(dst, b, h) do { _Pragma("unroll") for (int m = 0; m < 4; ++m) _Pragma("unroll") for (int k = 0; k < 2; ++k) dst[m][k] = *(const PG8_LAS bf16x8*)(lds + PG8_SA(b, h) + aoff + m * 2048 + k * 1024); } while (0)
#define PG8_LDB(dst, b, h) do { _Pragma("unroll") for (int n = 0; n < 2; ++n) _Pragma("unroll") for (int k = 0; k < 2; ++k) dst[n][k] = *(const PG8_LAS bf16x8*)(lds + PG8_SB(b, h) + boff + n * 2048 + k * 1024); } while (0)
#define PG8_MMA(ai, bj, At, Bt) do { __builtin_amdgcn_s_setprio(1); _Pragma("unroll") for (int m = 0; m < 4; ++m) _Pragma("unroll") for (int n = 0; n < 2; ++n) _Pragma("unroll") for (int k = 0; k < 2; ++k) \
        acc[ai][bj][m][n] = __builtin_amdgcn_mfma_f32_16x16x32_bf16(Bt[n][k], At[m][k], acc[ai][bj][m][n], 0, 0, 0); __builtin_amdgcn_s_setprio(0); } while (0)
#define PG8_WAIT_V(n) asm volatile("s_waitcnt vmcnt(" #n ")" ::: "memory")
#define PG8_WAIT_L(n) asm volatile("s_waitcnt lgkmcnt(" #n ")" ::: "memory")
#define PG8_BAR __builtin_amdgcn_s_barrier()
#define PG8_SCHED __builtin_amdgcn_sched_barrier(0)
    Unit cur, nxt; int ui = 0;
    if (!S.next(0, cur)) return;
    f32x4 acc[2][2][4][2];
#pragma unroll
    for (int a = 0; a < 2; ++a)
#pragma unroll
        for (int b = 0; b < 2; ++b)
#pragma unroll
            for (int m = 0; m < 4; ++m)
#pragma unroll
                for (int n = 0; n < 2; ++n) acc[a][b][m][n] = (f32x4){0.f, 0.f, 0.f, 0.f};
    bf16x8 At[4][2], B0[2][2], B1[2][2];
    const char* cA = (const char*)g.A + (size_t)cur.pm * tstep; const char* cB = (const char*)g.Bt + (size_t)cur.pn * tstep;
    S.a_ready(cur);
    if constexpr (SP2) {
        PG8_STAGE(PG8_SB(0, 0), cB, voffB); PG8_STAGE(PG8_SB(0, 1), cB + hstep, voffB); PG8_STAGE(PG8_SA(0, 0), cA, voffA); PG8_STAGE(PG8_SA(0, 1), cA + hstep, voffA);
        if (wr == 1) PG8_BAR;
        PG8_WAIT_V(2); PG8_BAR;
        PG8_STAGE(PG8_SB(1, 0), cB + kstep, voffB); PG8_STAGE(PG8_SA(1, 0), cA + kstep, voffA); PG8_STAGE(PG8_SB(1, 1), cB + hstep + kstep, voffB);
        PG8_WAIT_V(6); PG8_BAR;
    } else {
        PG8_STAGE(PG8_SB(0, 0), cB, voffB); PG8_STAGE(PG8_SA(0, 0), cA, voffA); PG8_STAGE(PG8_SB(0, 1), cB + hstep, voffB); PG8_STAGE(PG8_SA(0, 1), cA + hstep, voffA);
        if (wr == 1) PG8_BAR;
        PG8_WAIT_V(4); PG8_BAR;
        PG8_STAGE(PG8_SB(1, 0), cB + kstep, voffB); PG8_STAGE(PG8_SA(1, 0), cA + kstep, voffA); PG8_STAGE(PG8_SB(1, 1), cB + hstep + kstep, voffB);
        PG8_WAIT_V(6); PG8_BAR;
    }
    for (;;) {
        const bool has_next = S.next(ui + 1, nxt);
        const char* nA = has_next ? (const char*)g.A + (size_t)nxt.pm * tstep : cA; const char* nB = has_next ? (const char*)g.Bt + (size_t)nxt.pn * tstep : cB;
        for (int t = 0; t < nt; t += 2) {
            const bool last = (t == nt - 2);
            const char* a1 = cA + (size_t)(t + 1) * kstep;
            const char* a2 = last ? nA : cA + (size_t)(t + 2) * kstep; const char* b2 = last ? nB : cB + (size_t)(t + 2) * kstep;
            const char* a3 = a2 + kstep; const char* b3 = b2 + kstep;
            if (last && has_next) S.a_ready(nxt);
            if constexpr (SP2) {
            PG8_LDB(B0, 0, 0); PG8_LDB(B1, 0, 1); PG8_SCHED; PG8_LDA(At, 0, 0); PG8_STAGE(PG8_SA(1, 1), a1 + hstep, voffA);
            PG8_WAIT_V(8); PG8_WAIT_L(0); PG8_BAR; PG8_MMA(0, 0, At, B0); PG8_MMA(0, 1, At, B1); PG8_BAR; PG8_SCHED;
            PG8_LDA(At, 0, 1); PG8_STAGE(PG8_SB(0, 0), b2, voffB); PG8_STAGE(PG8_SB(0, 1), b2 + hstep, voffB); PG8_STAGE(PG8_SA(0, 0), a2, voffA);
            PG8_WAIT_V(8); PG8_WAIT_L(0); PG8_BAR; PG8_MMA(1, 0, At, B0); PG8_MMA(1, 1, At, B1); PG8_BAR; PG8_SCHED;
            PG8_LDB(B0, 1, 0); PG8_LDB(B1, 1, 1); PG8_SCHED; PG8_LDA(At, 1, 0); PG8_STAGE(PG8_SA(0, 1), a2 + hstep, voffA);
            PG8_WAIT_V(8); PG8_WAIT_L(0); PG8_BAR; PG8_MMA(0, 0, At, B0); PG8_MMA(0, 1, At, B1); PG8_BAR; PG8_SCHED;
            PG8_LDA(At, 1, 1); PG8_STAGE(PG8_SB(1, 0), b3, voffB); PG8_STAGE(PG8_SB(1, 1), b3 + hstep, voffB); PG8_STAGE(PG8_SA(1, 0), a3, voffA);
            PG8_WAIT_V(8); PG8_WAIT_L(0); PG8_BAR; PG8_MMA(1, 0, At, B0); PG8_MMA(1, 1, At, B1); PG8_BAR; PG8_SCHED;
            } else {
            PG8_LDB(B0, 0, 0); PG8_SCHED; PG8_LDA(At, 0, 0); PG8_STAGE(PG8_SA(1, 1), a1 + hstep, voffA);
            PG8_WAIT_L(8); PG8_BAR; PG8_WAIT_L(0); PG8_MMA(0, 0, At, B0); PG8_BAR; PG8_SCHED;
            PG8_LDB(B1, 0, 1); PG8_STAGE(PG8_SB(0, 0), b2, voffB);
            PG8_BAR; PG8_WAIT_L(0); PG8_MMA(0, 1, At, B1); PG8_BAR;
            PG8_LDA(At, 0, 1); PG8_STAGE(PG8_SA(0, 0), a2, voffA);
            PG8_BAR; PG8_WAIT_L(0); PG8_MMA(1, 0, At, B0); PG8_BAR; PG8_SCHED;
            PG8_STAGE(PG8_SB(0, 1), b2 + hstep, voffB);
            PG8_WAIT_V(6); PG8_BAR; PG8_MMA(1, 1, At, B1); PG8_BAR;
            PG8_LDB(B0, 1, 0); PG8_SCHED; PG8_LDA(At, 1, 0); PG8_STAGE(PG8_SA(0, 1), a2 + hstep, voffA);
            PG8_WAIT_L(8); PG8_BAR; PG8_WAIT_L(0); PG8_MMA(0, 0, At, B0); PG8_BAR; PG8_SCHED;
            PG8_LDB(B1, 1, 1); PG8_STAGE(PG8_SB(1, 0), b3, voffB);
            PG8_BAR; PG8_WAIT_L(0); PG8_MMA(0, 1, At, B1); PG8_BAR;
            PG8_LDA(At, 1, 1); PG8_STAGE(PG8_SA(1, 0), a3, voffA);
            PG8_BAR; PG8_WAIT_L(0); PG8_MMA(1, 0, At, B0); PG8_BAR; PG8_SCHED;
            PG8_STAGE(PG8_SB(1, 1), b3 + hstep, voffB);
            PG8_WAIT_V(6); PG8_BAR; PG8_MMA(1, 1, At, B1); PG8_BAR;
            }
        }
        if constexpr (ALIGN_EPI) { if (wr == 0) PG8_BAR; }
        if constexpr (!Epi::AFTER_DRAIN) { E(acc, cur, wr, wc, fr, fq); S.done(cur); }
        if (!has_next) break;
#pragma unroll
        for (int a = 0; a < 2; ++a)
#pragma unroll
            for (int b = 0; b < 2; ++b)
#pragma unroll
                for (int m = 0; m < 4; ++m)
#pragma unroll
                    for (int n = 0; n < 2; ++n) acc[a][b][m][n] = (f32x4){0.f, 0.f, 0.f, 0.f};
        cur = nxt; cA = nA; cB = nB; ++ui;
        if constexpr (ALIGN_EPI) { if (wr == 1) PG8_BAR; }
    }
    PG8_WAIT_V(0);
    if constexpr (!ALIGN_EPI) { if (wr == 0) PG8_BAR; }
    PG8_BAR;
    if constexpr (Epi::AFTER_DRAIN) { E.fused(acc, cur, wr, wc, fr, fq, lds, wid, lane); S.done(cur); }
#undef PG8_SA
#undef PG8_SB
#undef PG8_STAGE
#undef PG8_LDA
#undef PG8_LDB
#undef PG8_MMA
#undef PG8_WAIT_V
#undef PG8_WAIT_L
#undef PG8_BAR
#undef PG8_SCHED
}
}

#define LAS __attribute__((address_space(3)))
typedef unsigned short bf16;
#define XB_TMO      128
#define XB_XCNT(j)  (256  + 64 * (j))
#define XB_XSUB(j)  (1280 + 64 * (j))
#define XB_XGEN(j)  (2304 + 64 * (j))
#define XB_TOP      3328
#define XB_TOPGEN   3392
#define XCD_BAR_WORDS 3456
#define XB_SPIN_CAP (1u << 18)

__device__ __forceinline__ unsigned xb_ld(unsigned* p)              { return __hip_atomic_load(p, __ATOMIC_RELAXED, __HIP_MEMORY_SCOPE_AGENT); }
__device__ __forceinline__ unsigned xb_add(unsigned* p, unsigned v) { return __hip_atomic_fetch_add(p, v, __ATOMIC_RELAXED, __HIP_MEMORY_SCOPE_AGENT); }
__device__ __forceinline__ unsigned xb_xcc_id() { return (unsigned)__builtin_amdgcn_s_getreg((3 << 11) | 20) & 0xFu; }
#define XB_SPIN(cond, bar) do { unsigned _sp = 0; while (cond) { __builtin_amdgcn_s_sleep(1); \
    if ((++_sp & 255u) == 0u) { if (xb_ld(&(bar)[XB_TMO])) break; if (_sp > XB_SPIN_CAP) { atomicAdd(&(bar)[XB_TMO], 1u); break; } } } } while (0)

struct XcdBarrier {
    unsigned* bar; unsigned x;
    volatile LAS unsigned* st;
};

__device__ __forceinline__ XcdBarrier xcd_barrier_post(unsigned* bar, volatile LAS unsigned* st, int tid) {
    XcdBarrier b; b.bar = bar; b.x = xb_xcc_id(); b.st = st;
    if (tid == 0) (void)xb_add(&bar[XB_XCNT(b.x)], 1u);
    return b;
}
__device__ __forceinline__ void xcd_barrier_complete(unsigned* bar, unsigned x, unsigned& nloc, unsigned& nx) {
    const unsigned G = gridDim.x * gridDim.y * gridDim.z;
    unsigned sum, cnt, mine, sp = 0u;
    for (;;) {
        sum = 0u; cnt = 0u; mine = 0u;
#pragma unroll
        for (unsigned j = 0; j < 16; ++j) { const unsigned c = xb_ld(&bar[XB_XCNT(j)]); sum += c; cnt += (c > 0u) ? 1u : 0u; mine = (j == x) ? c : mine; }
        if (sum == G) break;
        __builtin_amdgcn_s_sleep(1);
        if ((++sp & 255u) == 0u) { if (xb_ld(&bar[XB_TMO])) break; if (sp > XB_SPIN_CAP) { atomicAdd(&bar[XB_TMO], 1u); break; } }
    }
    nloc = mine > 0u ? mine : 1u; nx = cnt > 0u ? cnt : 1u;
}

__device__ __forceinline__ void xcd_barrier(const XcdBarrier& b, int wv) {
    const int tid = wv * 64 + lane_id_opaque();
    asm volatile("s_waitcnt vmcnt(0)" ::: "memory");
    __syncthreads();
    if (tid == 0) {
        unsigned* bar = b.bar;
        __builtin_amdgcn_s_waitcnt(0);
        unsigned nloc = b.st[0], nx = b.st[1];
        if (nloc == 0u) { xcd_barrier_complete(bar, b.x, nloc, nx); b.st[0] = nloc; b.st[1] = nx; }
        const unsigned old = xb_add(&bar[XB_XSUB(b.x)], 1u);
        const unsigned gen = old / nloc;
        if (old + 1u == (gen + 1u) * nloc) {
            __builtin_amdgcn_fence(__ATOMIC_RELEASE, "agent");
            asm volatile("s_waitcnt vmcnt(0)" ::: "memory");
            const unsigned og = xb_add(&bar[XB_TOP], 1u);
            const unsigned tg = og / nx;
            if (og + 1u == (tg + 1u) * nx) xb_add(&bar[XB_TOPGEN], 1u);
            else XB_SPIN(xb_ld(&bar[XB_TOPGEN]) == tg, bar);
            __builtin_amdgcn_fence(__ATOMIC_ACQUIRE, "agent");
            xb_add(&bar[XB_XGEN(b.x)], 1u);
            asm volatile("s_waitcnt vmcnt(0)" ::: "memory");
        } else {
            XB_SPIN(xb_ld(&bar[XB_XGEN(b.x)]) == gen, bar);
            __builtin_amdgcn_fence(__ATOMIC_ACQUIRE, "agent");
            asm volatile("s_waitcnt vmcnt(0)" ::: "memory");
        }
    }
    __syncthreads();
}


#define GAS __attribute__((address_space(1)))
constexpr int NWAVES = 8, NTHREADS = 512;
constexpr int RING_BYTES = 131072, LDS_BYTES = 163840, MISC_OFF = LDS_BYTES - 512;

__device__ __forceinline__ float bf2f(unsigned short b) { return __uint_as_float((unsigned)b << 16); }
__device__ __forceinline__ unsigned f2bf(float f) { unsigned u = __float_as_uint(f); return (u + 0x7fffu + ((u >> 16) & 1u)) >> 16; }
__device__ __forceinline__ unsigned pk2(float lo, float hi) { return f2bf(lo) | (f2bf(hi) << 16); }
__device__ __forceinline__ float wave_sum(float v, int lane) {
#pragma unroll
    for (int o = 1; o < 64; o <<= 1) v += shx(v, o, lane);
    return v;
}
__device__ __forceinline__ float wave_max(float v, int lane) {
#pragma unroll
    for (int o = 1; o < 64; o <<= 1) v = fmaxf(v, shx(v, o, lane));
    return v;
}

constexpr size_t al256(size_t x) { return (x + 255) & ~(size_t)255; }
constexpr size_t O_CTL = 0;
constexpr size_t O_WT_IN = O_CTL + (1 << 16);
constexpr size_t O_WT_OUT = O_WT_IN + al256((size_t)DEPTH * NINP * DM * 2);
constexpr size_t O_WT_MEM = O_WT_OUT + al256((size_t)DEPTH * DM * DM * 2);
constexpr size_t O_XB = O_WT_MEM + al256((size_t)DEPTH * 512 * DM * 2);
constexpr size_t O_QA = O_XB + al256((size_t)T * DM * 2);
constexpr size_t O_KA = O_QA + al256((size_t)T * 512 * 2);
constexpr size_t O_VA = O_KA + al256((size_t)T * 512 * 2);
constexpr size_t O_CB = O_VA + al256((size_t)T * 512 * 2);
constexpr size_t O_QBKB = O_CB + al256((size_t)T * 1024 * 2);
constexpr size_t O_VB = O_QBKB + al256((size_t)T * 256 * 2);
constexpr size_t O_QM = O_VB + al256((size_t)T * 256 * 2);
constexpr size_t O_SSQ = O_QM + al256((size_t)T * 256 * 2);
constexpr size_t O_LA = O_SSQ + al256((size_t)T * 16 * 4);
constexpr size_t O_KMP = O_LA + al256((size_t)T * 128 * 4);
constexpr size_t O_LISTS = O_KMP + al256((size_t)BATCH * 8 * NB * 2 * 64 * 4);
constexpr size_t O_GCNT = O_LISTS + al256((size_t)BATCH * 8 * 256 * 2016 * 2);
constexpr size_t O_PARTO = O_GCNT + al256(1024 * 4);
constexpr size_t O_PARTL = O_PARTO + al256((size_t)T * 8 * 3 * 64 * 2);
constexpr size_t O_MEMK = O_PARTL + al256((size_t)T * 8 * 4 * 4);
constexpr size_t O_MEMV = O_MEMK + al256((size_t)DEPTH * TM * 256 * 2);
constexpr size_t O_MEMBF = O_MEMV + al256((size_t)DEPTH * TM * 256 * 2);
constexpr size_t O_SSQM = O_MEMBF + al256((size_t)TM * DM * 2);
constexpr size_t O_U = O_SSQM + al256((size_t)TM * 16 * 4);
constexpr size_t O_SST = O_U + al256((size_t)BATCH * 4 * NCH * 2048 * 4);
constexpr size_t O_DC = O_SST + al256((size_t)BATCH * 4 * NCH * 2048 * 4);
constexpr size_t O_PMASK = O_DC + al256((size_t)BATCH * 4 * NCH * 32 * 4);
constexpr size_t WS_END = O_PMASK + al256((size_t)T * 8);
static_assert(WS_END <= (size_t)536870912, "workspace map exceeds 4 x largest tensor");

struct KArgs {
    const float *x, *mem, *g_pre, *w_in, *g_q_moba, *g_k_moba, *w_gate_up, *b_gate_up, *g_gla_out, *g_mem, *w_mem_kv, *g_q_mem, *g_k_mem, *w_out;
    float* out;
    unsigned char* ws;
    int ph_lo, ph_hi;
};
struct Args {
    const __attribute__((address_space(4))) KArgs* kp;
    __device__ __forceinline__ const float* x() const { return kp->x; }
    __device__ __forceinline__ const float* mem() const { return kp->mem; }
    __device__ __forceinline__ const float* g_pre() const { return kp->g_pre; }
    __device__ __forceinline__ const float* w_in() const { return kp->w_in; }
    __device__ __forceinline__ const float* g_q_moba() const { return kp->g_q_moba; }
    __device__ __forceinline__ const float* g_k_moba() const { return kp->g_k_moba; }
    __device__ __forceinline__ const float* w_gate_up() const { return kp->w_gate_up; }
    __device__ __forceinline__ const float* b_gate_up() const { return kp->b_gate_up; }
    __device__ __forceinline__ const float* g_gla_out() const { return kp->g_gla_out; }
    __device__ __forceinline__ const float* g_mem() const { return kp->g_mem; }
    __device__ __forceinline__ const float* w_mem_kv() const { return kp->w_mem_kv; }
    __device__ __forceinline__ const float* g_q_mem() const { return kp->g_q_mem; }
    __device__ __forceinline__ const float* g_k_mem() const { return kp->g_k_mem; }
    __device__ __forceinline__ const float* w_out() const { return kp->w_out; }
    __device__ __forceinline__ float* out() const { return kp->out; }
    __device__ __forceinline__ unsigned char* ws() const { return kp->ws; }
    __device__ __forceinline__ unsigned* ctl() const { return (unsigned*)(kp->ws + O_CTL); }
    __device__ __forceinline__ bf16* wt_in() const { return (bf16*)(kp->ws + O_WT_IN); }
    __device__ __forceinline__ bf16* wt_out() const { return (bf16*)(kp->ws + O_WT_OUT); }
    __device__ __forceinline__ bf16* wt_mem() const { return (bf16*)(kp->ws + O_WT_MEM); }
    __device__ __forceinline__ bf16* xb() const { return (bf16*)(kp->ws + O_XB); }
    __device__ __forceinline__ bf16* qa() const { return (bf16*)(kp->ws + O_QA); }
    __device__ __forceinline__ bf16* ka() const { return (bf16*)(kp->ws + O_KA); }
    __device__ __forceinline__ bf16* va() const { return (bf16*)(kp->ws + O_VA); }
    __device__ __forceinline__ bf16* cb() const { return (bf16*)(kp->ws + O_CB); }
    __device__ __forceinline__ bf16* qbkb() const { return (bf16*)(kp->ws + O_QBKB); }
    __device__ __forceinline__ bf16* vb() const { return (bf16*)(kp->ws + O_VB); }
    __device__ __forceinline__ bf16* qm() const { return (bf16*)(kp->ws + O_QM); }
    __device__ __forceinline__ float* ssq() const { return (float*)(kp->ws + O_SSQ); }
    __device__ __forceinline__ float* la() const { return (float*)(kp->ws + O_LA); }
    __device__ __forceinline__ float* kmp() const { return (float*)(kp->ws + O_KMP); }
    __device__ __forceinline__ unsigned short* lists() const { return (unsigned short*)(kp->ws + O_LISTS); }
    __device__ __forceinline__ unsigned* gcnt() const { return (unsigned*)(kp->ws + O_GCNT); }
    __device__ __forceinline__ bf16* partO() const { return (bf16*)(kp->ws + O_PARTO); }
    __device__ __forceinline__ float* partL() const { return (float*)(kp->ws + O_PARTL); }
    __device__ __forceinline__ bf16* memk() const { return (bf16*)(kp->ws + O_MEMK); }
    __device__ __forceinline__ bf16* memv() const { return (bf16*)(kp->ws + O_MEMV); }
    __device__ __forceinline__ bf16* membf() const { return (bf16*)(kp->ws + O_MEMBF); }
    __device__ __forceinline__ float* ssqm() const { return (float*)(kp->ws + O_SSQM); }
    __device__ __forceinline__ float* U() const { return (float*)(kp->ws + O_U); }
    __device__ __forceinline__ float* Sst() const { return (float*)(kp->ws + O_SST); }
    __device__ __forceinline__ float* Dc() const { return (float*)(kp->ws + O_DC); }
    __device__ __forceinline__ unsigned char* pmask() const { return (unsigned char*)(kp->ws + O_PMASK); }
};


typedef short s16x8 __attribute__((ext_vector_type(8)));
typedef short s16x4 __attribute__((ext_vector_type(4)));
typedef float f32x16 __attribute__((ext_vector_type(16)));
typedef float f32x2_t __attribute__((ext_vector_type(2)));
typedef __bf16 bf16x2_t __attribute__((ext_vector_type(2)));
constexpr int KIMG_CH = 4112;
constexpr int VIMG_DH = 16448;
constexpr int KIMG_OFF = 0, VIMG_OFF = 8 * KIMG_CH, ATT_LDS_END = VIMG_OFF + 2 * VIMG_DH;
constexpr int LIST_PER_BH = 256 * 2016;
__device__ __forceinline__ int list_off(int j) { return 256 * (63 * j - (j * (j - 1)) / 2); }
__device__ __forceinline__ int crow(int r, int hi) { return (r & 3) + 8 * (r >> 2) + 4 * hi; }
__device__ __forceinline__ unsigned cvtpk(float lo, float hi) { f32x2_t v = {lo, hi}; bf16x2_t b = __builtin_convertvector(v, bf16x2_t); return __builtin_bit_cast(unsigned, b); }
__device__ __forceinline__ s16x4 vtr(const LAS unsigned char* p) { typedef short v4i16_t __attribute__((ext_vector_type(4))); return __builtin_bit_cast(s16x4, __builtin_amdgcn_ds_read_tr16_b64_v4i16((LAS v4i16_t*)p)); }

struct KVRegs { uint4 k[4], v[4]; };
__device__ __forceinline__ void kv_issue(KVRegs& r, const bf16* kg, const bf16* vg, int stride, int tid) {
    const int c = tid & 7, k0 = tid >> 3;
#pragma unroll
    for (int i = 0; i < 4; ++i) { const size_t o = (size_t)(k0 + 64 * i) * stride + c * 8; r.k[i] = *(const uint4*)(kg + o); r.v[i] = *(const uint4*)(vg + o); }
}
__device__ __forceinline__ void kv_commit(LAS unsigned char* L, const KVRegs& r, int tid) {
    const int c = tid & 7, k0 = tid >> 3;
#pragma unroll
    for (int i = 0; i < 4; ++i) { const int key = k0 + 64 * i;
        *(LAS pg8::u32x4*)(L + KIMG_OFF + c * KIMG_CH + key * 16) = (pg8::u32x4){r.k[i].x, r.k[i].y, r.k[i].z, r.k[i].w};
        *(LAS pg8::u32x4*)(L + VIMG_OFF + (c >> 2) * VIMG_DH + key * 64 + (c & 3) * 16) = (pg8::u32x4){r.v[i].x, r.v[i].y, r.v[i].z, r.v[i].w}; }
}
__device__ __forceinline__ void load_kv_tiles(LAS unsigned char* L, const bf16* kg, const bf16* vg, int stride, int tid) { KVRegs r; kv_issue(r, kg, vg, stride, tid); kv_commit(L, r, tid); }
__device__ __forceinline__ void attn_tiles(const LAS unsigned char* L, const s16x8 (&qf)[4], f32x16& cin, float cstep, int kt0, int kt1, int mask_kt, int r32, int hi, int lane, f32x16 (&o)[2], float& lsum) {
    const LAS unsigned char* kp = L + KIMG_OFF + hi * KIMG_CH + r32 * 16;
    const LAS unsigned char* vp = L + VIMG_OFF + ((lane >> 4) & 1) * 32 + (lane & 3) * 8 + (4 * hi + ((lane & 15) >> 2)) * 64;
    for (int kt = kt0; kt < kt1; ++kt) {
        f32x16 s = cin;
#pragma unroll
        for (int d0 = 0; d0 < 4; ++d0) { const s16x8 kf = *(const LAS s16x8*)(kp + 2 * d0 * KIMG_CH + kt * 512); s = __builtin_amdgcn_mfma_f32_32x32x16_bf16(kf, qf[d0], s, 0, 0, 0); }
        if (kt == mask_kt) {
#pragma unroll
            for (int r = 0; r < 16; ++r) if (crow(r, hi) > r32) s[r] = -INFINITY;
        }
        float ps = 0.f;
#pragma unroll
        for (int r = 0; r < 16; ++r) { s[r] = __builtin_amdgcn_exp2f(s[r]); ps += s[r]; }
        lsum += ps;
        union { unsigned w[4]; s16x8 v; } p0, p1;
#pragma unroll
        for (int e = 0; e < 4; ++e) { p0.w[e] = cvtpk(s[2 * e], s[2 * e + 1]); p1.w[e] = cvtpk(s[8 + 2 * e], s[8 + 2 * e + 1]); }
#pragma unroll
        for (int dh = 0; dh < 2; ++dh) {
            const LAS unsigned char* vq = vp + dh * VIMG_DH + kt * 2048;
            const s16x4 a0 = vtr(vq), a1 = vtr(vq + 512), a2 = vtr(vq + 1024), a3 = vtr(vq + 1536);
            const s16x8 f0 = {a0[0], a0[1], a0[2], a0[3], a1[0], a1[1], a1[2], a1[3]}, f1 = {a2[0], a2[1], a2[2], a2[3], a3[0], a3[1], a3[2], a3[3]};
            o[dh] = __builtin_amdgcn_mfma_f32_32x32x16_bf16(f0, p0.v, o[dh], 0, 0, 0);
            o[dh] = __builtin_amdgcn_mfma_f32_32x32x16_bf16(f1, p1.v, o[dh], 0, 0, 0);
        }
#pragma unroll
        for (int r = 0; r < 16; ++r) cin[r] += cstep;
    }
}
__device__ __forceinline__ void load_qfrag(s16x8 (&qf)[4], const bf16* qrow, int hi) {
#pragma unroll
    for (int d0 = 0; d0 < 4; ++d0) qf[d0] = *(const s16x8*)(qrow + 16 * d0 + 8 * hi);
}
__device__ __forceinline__ float softmax_ref(const float* gq, const float* gk) {
    const int lane = lane_id_opaque();
    const float a = wave_max(fabsf(gq[lane]), lane), b = wave_max(fabsf(gk[lane]), lane);
    return 64.f * QSCALE * a * b * 1.01f;
}

__device__ __forceinline__ float zero_thr(float Mref) { return 104.f + 2.f * Mref * 0.6931471805599453f + 1.f; }

__device__ __forceinline__ size_t hm_off(int b, int h, int t) { return (((size_t)(b * 8 + h)) * SEQ + t) * 64; }
struct RouteRaw { s16x8 q[4]; float km[16]; };
__device__ __forceinline__ void route_decode(int p, int& bh, int& i) { i = 63 - (p >> 4); bh = p & 15; }
__device__ __forceinline__ void route_raw_issue(const Args& a, RouteRaw& r, int unit, int tid) {
    int bh, i; route_decode(unit, bh, i); const int b = bh >> 3, h = bh & 7;
    load_qfrag(r.q, a.qa() + hm_off(b, h, i * 256 + (tid >> 6) * 32 + (tid & 31)), (tid >> 5) & 1);
#pragma unroll
    for (int k = 0; k < 8; ++k) { const int e = tid + NTHREADS * k;
        if (e < i * 64) { const float* p = a.kmp() + (((size_t)bh * 64 + (e >> 6)) * 2) * 64 + (e & 63); r.km[2 * k] = p[0]; r.km[2 * k + 1] = p[64]; } }
}
__device__ __forceinline__ void top3_insert(float s, int j, float& v0, float& v1, float& v2, int& i0, int& i1, int& i2) {
    const bool g0 = s > v0, g1 = s > v1, g2 = s > v2;
    v2 = g1 ? v1 : (g2 ? s : v2); i2 = g1 ? i1 : (g2 ? j : i2);
    v1 = g0 ? v0 : (g1 ? s : v1); i1 = g0 ? i0 : (g1 ? j : i1);
    v0 = g0 ? s : v0; i0 = g0 ? j : i0;
}
__device__ __forceinline__ void moba_route_phase(const Args& a, LAS unsigned char* L, int wv, int bid, int G, float zthr, int dry) {
    constexpr int KMP = 64 * 16 + 16;
    LAS unsigned short* kmh = (LAS unsigned short*)L; LAS unsigned short* kml = (LAS unsigned short*)(L + 8 * KMP);
    LAS int* cnt = (LAS int*)(L + 16 * KMP);
    LAS int* basep = cnt + 64;
    const int NU = BATCH * 8 * 63;
    int rnd = 0;
    int unit = bid;
    RouteRaw R;
    if (unit < NU) route_raw_issue(a, R, unit, wv * 64 + lane_id_opaque());
    while (unit < NU) {
        const int tid = wv * 64 + lane_id_opaque(), lane = tid & 63, r32 = lane & 31, hi = lane >> 5;
        int bh, i; route_decode(unit, bh, i); const int b = bh >> 3, h = bh & 7;
#pragma unroll
        for (int k = 0; k < 8; ++k) { const int e = tid + NTHREADS * k; if (e < i * 64) { const int j = e >> 6, d = e & 63; const float v = R.km[2 * k] + R.km[2 * k + 1];
                const unsigned hb = f2bf(v); const float vh = __uint_as_float(hb << 16); const unsigned lb = f2bf(v - vh);
                const int off = (d >> 3) * (KMP / 2) + j * 8 + (d & 7); kmh[off] = (unsigned short)hb; kml[off] = (unsigned short)lb; } }
        if (tid < 64) cnt[tid] = 0;
        const int t = i * 256 + wv * 32 + r32;
        s16x8 qf[4];
#pragma unroll
        for (int c = 0; c < 4; ++c) qf[c] = R.q[c];
        ++rnd;
        const int nunit = rnd * G + ((rnd & 1) ? (G - 1 - bid) : bid);
        if (nunit < NU) route_raw_issue(a, R, nunit, tid);
        __syncthreads();
        float v0 = -INFINITY, v1 = -INFINITY, v2 = -INFINITY; int i0 = 1 << 20, i1 = 1 << 20, i2 = 1 << 20;
        const int njt = i > 32 ? 2 : 1;
        for (int jt = 0; jt < njt; ++jt) {
            f32x16 g;
#pragma unroll
            for (int r = 0; r < 16; ++r) g[r] = 0.f;
            const LAS unsigned char* kh = (const LAS unsigned char*)kmh + hi * KMP + (32 * jt + r32) * 16;
            const LAS unsigned char* kl = (const LAS unsigned char*)kml + hi * KMP + (32 * jt + r32) * 16;
#pragma unroll
            for (int ks = 0; ks < 4; ++ks) {
                g = __builtin_amdgcn_mfma_f32_32x32x16_bf16(*(const LAS s16x8*)(kh + 2 * ks * KMP), qf[ks], g, 0, 0, 0);
                g = __builtin_amdgcn_mfma_f32_32x32x16_bf16(*(const LAS s16x8*)(kl + 2 * ks * KMP), qf[ks], g, 0, 0, 0);
            }
#pragma unroll
            for (int r = 0; r < 16; ++r) { const int j = 32 * jt + crow(r, hi); const float sv = (j < i) ? g[r] : -INFINITY; top3_insert(sv, j, v0, v1, v2, i0, i1, i2); }
        }
        {
            const auto x0 = __builtin_amdgcn_permlane32_swap(__float_as_uint(v0), __float_as_uint(v0), false, false), x1 = __builtin_amdgcn_permlane32_swap(__float_as_uint(v1), __float_as_uint(v1), false, false), x2 = __builtin_amdgcn_permlane32_swap(__float_as_uint(v2), __float_as_uint(v2), false, false);
            const auto y0 = __builtin_amdgcn_permlane32_swap((unsigned)i0, (unsigned)i0, false, false), y1 = __builtin_amdgcn_permlane32_swap((unsigned)i1, (unsigned)i1, false, false), y2 = __builtin_amdgcn_permlane32_swap((unsigned)i2, (unsigned)i2, false, false);
            const float pv[3] = {__uint_as_float(hi ? x0[0] : x0[1]), __uint_as_float(hi ? x1[0] : x1[1]), __uint_as_float(hi ? x2[0] : x2[1])};
            const int pi[3] = {(int)(hi ? y0[0] : y0[1]), (int)(hi ? y1[0] : y1[1]), (int)(hi ? y2[0] : y2[1])};
#pragma unroll
            for (int c = 0; c < 3; ++c) {
                const float sv = pv[c]; const int j = pi[c];
                const bool g0 = sv > v0 || (sv == v0 && j < i0), g1 = sv > v1 || (sv == v1 && j < i1), g2 = sv > v2 || (sv == v2 && j < i2);
                v2 = g1 ? v1 : (g2 ? sv : v2); i2 = g1 ? i1 : (g2 ? j : i2);
                v1 = g0 ? v0 : (g1 ? sv : v1); i1 = g0 ? i0 : (g1 ? j : i1);
                v0 = g0 ? sv : v0; i0 = g0 ? j : i0;
            }
        }
        int rk0 = 0, rk1 = 0, rk2 = 0; const int nsel = i < 3 ? i : 3; bool k0 = false, k1 = false, k2 = false;
        if (hi == 0) {
            if (dry) asm volatile("" :: "v"(i0), "v"(i1), "v"(i2));
            const float slope = exp2f(-(float)(h + 1));
            k0 = nsel > 0 && !(slope * (float)(t - 256 * i0 - 255) > zthr);
            k1 = nsel > 1 && !(slope * (float)(t - 256 * i1 - 255) > zthr);
            k2 = nsel > 2 && !(slope * (float)(t - 256 * i2 - 255) > zthr);
            if (!dry) a.pmask()[((size_t)(b * SEQ + t)) * 8 + h] = (unsigned char)((k0 ? 1 : 0) | (k1 ? 2 : 0) | (k2 ? 4 : 0));
            if (!dry && k0) rk0 = __hip_atomic_fetch_add(cnt + i0, 1, __ATOMIC_RELAXED, __HIP_MEMORY_SCOPE_WORKGROUP);
            if (!dry && k1) rk1 = __hip_atomic_fetch_add(cnt + i1, 1, __ATOMIC_RELAXED, __HIP_MEMORY_SCOPE_WORKGROUP);
            if (!dry && k2) rk2 = __hip_atomic_fetch_add(cnt + i2, 1, __ATOMIC_RELAXED, __HIP_MEMORY_SCOPE_WORKGROUP);
        }
        __syncthreads();
        if (!dry && tid < i) { const int c = cnt[tid]; basep[tid] = c > 0 ? (int)atomicAdd(a.gcnt() + bh * 64 + tid, (unsigned)c) : 0; }
        __syncthreads();
        if (!dry && hi == 0) {
            unsigned short* lst = a.lists() + (size_t)bh * LIST_PER_BH;
            if (k0) lst[list_off(i0) + basep[i0] + rk0] = (unsigned short)(t | (0 << 14));
            if (k1) lst[list_off(i1) + basep[i1] + rk1] = (unsigned short)(t | (1 << 14));
            if (k2) lst[list_off(i2) + basep[i2] + rk2] = (unsigned short)(t | (2 << 14));
        }
        unit = nunit;
        __syncthreads();
    }
}

__device__ __forceinline__ void moba_pairs_phase(const Args& a, int l, LAS unsigned char* L, int wv, int bid, int G, int dry = 0) {
    const int tid = wv * 64 + lane_id_opaque(), lane = tid & 63, wid = wv;
    LAS int* pre = (LAS int*)(L + ATT_LDS_END);
    LAS int* cntl = pre + 1028;
    LAS int* wtot = cntl + 1024;
    {
        const int c0 = (int)a.gcnt()[2 * tid], c1 = (int)a.gcnt()[2 * tid + 1];
        cntl[2 * tid] = c0; cntl[2 * tid + 1] = c1;
        const int n0 = (c0 + 255) >> 8, n1 = (c1 + 255) >> 8;
        int s = n0 + n1;
#pragma unroll
        for (int o = 1; o < 64; o <<= 1) { const int v = shup_i(s, o, lane); if (lane >= o) s += v; }
        if (lane == 63) wtot[wid] = s;
        __syncthreads();
        int wb = 0;
        for (int w = 0; w < wid; ++w) wb += wtot[w];
        const int excl = wb + s - (n0 + n1);
        pre[2 * tid] = excl; pre[2 * tid + 1] = excl + n0;
        if (tid == NTHREADS - 1) pre[1024] = excl + n0 + n1;
        __syncthreads();
    }
    const int total = pre[1024];
    LAS int* itab = wtot + 8;
    if (tid < 64) { const int it = bid + tid * G; int lo = 0, hh = 1023;
        if (it < total) { while (lo < hh) { const int mid = (lo + hh + 1) >> 1; if (pre[mid] <= it) lo = mid; else hh = mid - 1; } }
        itab[tid] = lo; }
    __syncthreads();
    const float Mref = softmax_ref(a.g_q_moba() + l * 64, a.g_k_moba() + l * 64);
    KVRegs kvr; s16x8 qf[4], qfn[4]; int tq = 0, slot = 0, cb_ = 0, ch_ = 0, cj_ = 0; bool valid = false;
    int ntq = 0, nslot = 0, nb_ = 0, nh_ = 0, nj_ = 0; bool nvalid = false; unsigned ne = 0;
    int item = bid;
#define PAIR_META(IT, B_, H_, J_, VALID_, E_) do { \
        const int tid2 = wv * 64 + lane_id_opaque(), lane2 = tid2 & 63; \
        const int bhj = itab[((IT) - bid) / G], chunk = (IT) - pre[bhj], n = cntl[bhj], bh = bhj >> 6; \
        J_ = bhj & 63; B_ = bh >> 3; H_ = bh & 7; \
        kv_issue(kvr, a.ka() + hm_off(B_, H_, J_ * 256), a.va() + hm_off(B_, H_, J_ * 256), 64, tid2); \
        int idx = chunk * 256 + wv * 32 + (lane2 & 31); VALID_ = idx < n; if (!VALID_) idx = n - 1; \
        E_ = a.lists()[(size_t)bh * LIST_PER_BH + list_off(J_) + idx]; } while (0)
    if (item < total) {
        unsigned e0; PAIR_META(item, cb_, ch_, cj_, valid, e0);
        tq = e0 & 0x3fff; slot = e0 >> 14;
        load_qfrag(qf, a.qa() + hm_off(cb_, ch_, tq), (lane_id_opaque() >> 5));
    }
    while (item < total) {
        const int tid2 = wv * 64 + lane_id_opaque(), lane = tid2 & 63, r32 = lane & 31, hi = lane >> 5;
        const int nitem = item + G; const bool has_next = nitem < total;
        __syncthreads();
        kv_commit(L, kvr, tid2);
        if (has_next) PAIR_META(nitem, nb_, nh_, nj_, nvalid, ne);
        __syncthreads();
        const size_t tok = (size_t)cb_ * SEQ + tq;
        const float slope2 = exp2f(-(float)(ch_ + 1)) * LOG2E;
        f32x16 cin;
#pragma unroll
        for (int r = 0; r < 16; ++r) cin[r] = fmaf(-slope2, (float)(tq - 256 * cj_ - crow(r, hi)), -Mref);
        f32x16 o[2]; float lsum = 0.f;
#pragma unroll
        for (int r = 0; r < 16; ++r) { o[0][r] = 0.f; o[1][r] = 0.f; }
        attn_tiles(L, qf, cin, 32.f * slope2, 0, 4, -1, r32, hi, lane, o, lsum);
        if (has_next) { ntq = ne & 0x3fff; nslot = ne >> 14; load_qfrag(qfn, a.qa() + hm_off(nb_, nh_, ntq), hi); }
        attn_tiles(L, qf, cin, 32.f * slope2, 4, 8, -1, r32, hi, lane, o, lsum);
        lsum = red32(lsum);
        if (dry) asm volatile("" :: "v"(o[0]), "v"(o[1]), "v"(lsum));
        if (valid && !dry) {
            const size_t pidx = (tok * 8 + ch_) * 3 + slot;
            bf16* po = a.partO() + pidx * 64;
#pragma unroll
            for (int dh = 0; dh < 2; ++dh)
#pragma unroll
                for (int g2 = 0; g2 < 2; ++g2) { uint4 w;
                    w.x = cvtpk(o[dh][8 * g2], o[dh][8 * g2 + 1]); w.y = cvtpk(o[dh][8 * g2 + 2], o[dh][8 * g2 + 3]); w.z = cvtpk(o[dh][8 * g2 + 4], o[dh][8 * g2 + 5]); w.w = cvtpk(o[dh][8 * g2 + 6], o[dh][8 * g2 + 7]);
                    *(uint4*)(po + 32 * hi + 16 * dh + 8 * g2) = w; }
            if (hi == 0) a.partL()[(tok * 8 + ch_) * 4 + slot] = lsum;
        }
#pragma unroll
        for (int d0 = 0; d0 < 4; ++d0) qf[d0] = qfn[d0];
        tq = ntq; slot = nslot; cb_ = nb_; ch_ = nh_; cj_ = nj_; valid = nvalid;
        item = nitem;
    }
#undef PAIR_META
    __syncthreads();
}

__device__ __forceinline__ void row_load_pieces(const bf16* row, int hi, uint2 (&pc)[8]) {
#pragma unroll
    for (int k = 0; k < 4; ++k) {
        const uint4 w = *(const uint4*)(row + 8 * (2 * k + hi));
        const auto s0 = __builtin_amdgcn_permlane32_swap(w.x, w.z, false, false), s1 = __builtin_amdgcn_permlane32_swap(w.y, w.w, false, false);
        pc[2 * k] = make_uint2(s0[0], s1[0]); pc[2 * k + 1] = make_uint2(s0[1], s1[1]);
    }
}
__device__ __forceinline__ void row_store_pieces(bf16* row, int hi, const uint2 (&pc)[8]) {
#pragma unroll
    for (int k = 0; k < 4; ++k) {
        const auto s0 = __builtin_amdgcn_permlane32_swap(pc[2 * k].x, pc[2 * k + 1].x, false, false), s1 = __builtin_amdgcn_permlane32_swap(pc[2 * k].y, pc[2 * k + 1].y, false, false);
        *(uint4*)(row + 8 * (2 * k + hi)) = make_uint4(s0[0], s1[0], s0[1], s1[1]);
    }
}
__device__ __forceinline__ void own_tile(const Args& a, const LAS unsigned char* Lt, const s16x8 (&qf)[4], unsigned pm, int b, int h, int i, int qt, int lane, float Mref, int dry) {
    const int r32 = lane & 31, hi = lane >> 5;
    const size_t tok = (size_t)b * SEQ + i * 256 + qt * 32 + r32;
    const float slope2 = exp2f(-(float)(h + 1)) * LOG2E;
    f32x16 cin;
#pragma unroll
    for (int r = 0; r < 16; ++r) cin[r] = fmaf(-slope2, (float)(32 * qt + r32 - crow(r, hi)), -Mref);
    f32x16 o[2]; float lsum = 0.f;
#pragma unroll
    for (int r = 0; r < 16; ++r) { o[0][r] = 0.f; o[1][r] = 0.f; }
    attn_tiles(Lt, qf, cin, 32.f * slope2, 0, qt + 1, qt, r32, hi, lane, o, lsum);
    lsum = red32(lsum);
    bf16* cp = a.cb() + tok * 1024 + h * 64;
    uint4 gw[4];
#pragma unroll
    for (int k = 0; k < 4; ++k) gw[k] = *(const uint4*)(cp + 8 * (2 * k + hi));
    if (pm) { const pg8::f32x4 pl = *(const pg8::f32x4*)(a.partL() + (tok * 8 + h) * 4);
        lsum += ((pm & 1u) ? pl[0] : 0.f) + ((pm & 2u) ? pl[1] : 0.f) + ((pm & 4u) ? pl[2] : 0.f); }
    for (int s = 0; s < 3; ++s) {
        if (!((pm >> s) & 1u)) continue;
        const size_t pidx = (tok * 8 + h) * 3 + s;
        const bf16* po = a.partO() + pidx * 64;
#pragma unroll
        for (int dh = 0; dh < 2; ++dh)
#pragma unroll
            for (int g2 = 0; g2 < 2; ++g2) { const uint4 w = *(const uint4*)(po + 32 * hi + 16 * dh + 8 * g2); const unsigned ww[4] = {w.x, w.y, w.z, w.w};
#pragma unroll
                for (int e = 0; e < 4; ++e) { o[dh][8 * g2 + 2 * e] += __uint_as_float(ww[e] << 16); o[dh][8 * g2 + 2 * e + 1] += __uint_as_float(ww[e] & 0xffff0000u); } }
    }
    const float inv = __builtin_amdgcn_rcpf(lsum);
    uint2 gt[8];
#pragma unroll
    for (int k = 0; k < 4; ++k) {
        const auto s0 = __builtin_amdgcn_permlane32_swap(gw[k].x, gw[k].z, false, false), s1 = __builtin_amdgcn_permlane32_swap(gw[k].y, gw[k].w, false, false);
        gt[2 * k] = make_uint2(s0[0], s1[0]); gt[2 * k + 1] = make_uint2(s0[1], s1[1]); }
#pragma unroll
    for (int c = 0; c < 8; ++c) { const int dh = c >> 2, g4 = c & 3; uint2 w;
        w.x = cvtpk(o[dh][4 * g4] * inv * __uint_as_float(gt[c].x << 16), o[dh][4 * g4 + 1] * inv * __uint_as_float(gt[c].x & 0xffff0000u));
        w.y = cvtpk(o[dh][4 * g4 + 2] * inv * __uint_as_float(gt[c].y << 16), o[dh][4 * g4 + 3] * inv * __uint_as_float(gt[c].y & 0xffff0000u));
        gt[c] = w; }
    if (!dry) row_store_pieces(cp, hi, gt); else asm volatile("" :: "v"(gt[0].x), "v"(gt[3].y), "v"(gt[7].x));
}
__device__ __forceinline__ void moba_own_pair(const Args& a, int uA, int uB, LAS unsigned char* L, int wv, float Mref, int dry = 0) {
    const int tid = wv * 64 + lane_id_opaque(), lane = tid & 63, wid = wv, hi = lane >> 5;
    const int bhA = uA >> 6, iA = uA & 63, bA = bhA >> 3, hA = bhA & 7, bhB = uB >> 6, iB = uB & 63, bB = bhB >> 3, hB = bhB & 7;
    __syncthreads();
    load_kv_tiles(L, a.ka() + hm_off(bA, hA, iA * 256), a.va() + hm_off(bA, hA, iA * 256), 64, tid);
    const bool single = (uA == uB);
    if (!single) load_kv_tiles(L + ATT_LDS_END, a.ka() + hm_off(bB, hB, iB * 256), a.va() + hm_off(bB, hB, iB * 256), 64, tid);
    s16x8 qfA[4], qfB[4];
    load_qfrag(qfA, a.qa() + hm_off(bA, hA, iA * 256 + wid * 32 + (lane & 31)), hi);
    load_qfrag(qfB, a.qa() + hm_off(bB, hB, iB * 256 + (7 - wid) * 32 + (lane & 31)), hi);
    const unsigned pmA = iA > 0 ? (unsigned)a.pmask()[((size_t)bA * SEQ + iA * 256 + wid * 32 + (lane & 31)) * 8 + hA] : 0u;
    const unsigned pmB = iB > 0 ? (unsigned)a.pmask()[((size_t)bB * SEQ + iB * 256 + (7 - wid) * 32 + (lane & 31)) * 8 + hB] : 0u;
    __syncthreads();
    own_tile(a, L, qfA, pmA, bA, hA, iA, wid, lane, Mref, dry);
    own_tile(a, single ? L : L + ATT_LDS_END, qfB, pmB, bB, hB, iB, 7 - wid, lane, Mref, dry);
}

__device__ __forceinline__ void mem_attn_phase(const Args& a, int l, LAS unsigned char* L, int wv, int bid, int G, float Mref, int dry) {
    const int NU = BATCH * 4 * 64;
    int unit = bid;
    KVRegs kvr; s16x8 qf[4], qfn[4];
    if (unit < NU) {
        const int tid = wv * 64 + lane_id_opaque(), lane = tid & 63;
        const int bhm = unit >> 6, qt = unit & 63, b = bhm >> 2, hm = bhm & 3;
        const size_t kvoff = ((size_t)l * TM + b * MEM_LEN) * 256 + hm * 64;
        kv_issue(kvr, a.memk() + kvoff, a.memv() + kvoff, 256, tid);
        load_qfrag(qf, a.qm() + ((size_t)b * SEQ + qt * 256 + wv * 32 + (lane & 31)) * 256 + hm * 64, lane >> 5);
    }
    while (unit < NU) {
        const int tid = wv * 64 + lane_id_opaque(), lane = tid & 63, r32 = lane & 31, hi = lane >> 5;
        const int bhm = unit >> 6, qt = unit & 63, b = bhm >> 2, hm = bhm & 3;
        const int nunit = unit + G;
        __syncthreads();
        kv_commit(L, kvr, tid);
        if (nunit < NU) {
            const int nbhm = nunit >> 6, nqt = nunit & 63, nb = nbhm >> 2, nhm = nbhm & 3;
            const size_t kvoff = ((size_t)l * TM + nb * MEM_LEN) * 256 + nhm * 64;
            kv_issue(kvr, a.memk() + kvoff, a.memv() + kvoff, 256, tid);
            load_qfrag(qfn, a.qm() + ((size_t)nb * SEQ + nqt * 256 + wv * 32 + r32) * 256 + nhm * 64, hi);
        }
        const size_t tok = (size_t)b * SEQ + qt * 256 + wv * 32 + r32;
        bf16* cp = a.cb() + tok * 1024 + 768 + hm * 64;
        uint2 gt[8]; row_load_pieces(cp, hi, gt);
        __syncthreads();
        f32x16 cin;
#pragma unroll
        for (int r = 0; r < 16; ++r) cin[r] = -Mref;
        f32x16 o[2]; float lsum = 0.f;
#pragma unroll
        for (int r = 0; r < 16; ++r) { o[0][r] = 0.f; o[1][r] = 0.f; }
        attn_tiles(L, qf, cin, 0.f, 0, 8, -1, r32, hi, lane, o, lsum);
        lsum = red32(lsum);
        const float inv = __builtin_amdgcn_rcpf(lsum);
#pragma unroll
        for (int c = 0; c < 8; ++c) { const int dh = c >> 2, g4 = c & 3; const uint2 g2 = gt[c]; uint2 w;
            w.x = cvtpk(o[dh][4 * g4] * inv * __uint_as_float(g2.x << 16), o[dh][4 * g4 + 1] * inv * __uint_as_float(g2.x & 0xffff0000u));
            w.y = cvtpk(o[dh][4 * g4 + 2] * inv * __uint_as_float(g2.y << 16), o[dh][4 * g4 + 3] * inv * __uint_as_float(g2.y & 0xffff0000u));
            gt[c] = w; }
        if (!dry) row_store_pieces(cp, hi, gt); else asm volatile("" :: "v"(gt[0].x), "v"(gt[3].y), "v"(gt[7].x));
#pragma unroll
        for (int d0 = 0; d0 < 4; ++d0) qf[d0] = qfn[d0];
        unit = nunit;
    }
    __syncthreads();
}

__device__ __forceinline__ void gla_load_cumsum(const Args& a, LAS float* sb, size_t tok0, int h, int tid, int lane, int wid) {
    for (int e = tid; e < 64 * 32; e += NTHREADS) { const int t = e >> 5, d = e & 31; sb[t * 33 + d] = a.la()[(tok0 + t) * 128 + h * 32 + d]; }
    __syncthreads();
#pragma unroll
    for (int cc = 0; cc < 4; ++cc) { const int d = wid * 4 + cc; float v = sb[lane * 33 + d];
#pragma unroll
        for (int o = 1; o < 64; o <<= 1) { const float t = shup(v, o, lane); if (lane >= o) v += t; }
        sb[lane * 33 + d] = v; }
    __syncthreads();
}
struct GlaRaw1 { pg8::f32x4 la[2]; uint4 k, v[2]; };
__device__ __forceinline__ void gla_raw1_issue(const Args& a, GlaRaw1& r, int unit, int lt) {
    const int c = unit & 255, h = (unit >> 8) & 3, b = unit >> 10;
    const size_t tok0 = (size_t)b * SEQ + c * 64; const int row = lt >> 2, q4 = lt & 3;
    const float* lp = a.la() + (tok0 + row) * 128 + h * 32 + 8 * q4;
    r.la[0] = *(const pg8::f32x4*)lp; r.la[1] = *(const pg8::f32x4*)(lp + 4);
    r.k = *(const uint4*)(a.qbkb() + (tok0 + row) * 256 + 128 + h * 32 + 8 * q4);
    const bf16* vp = a.vb() + (tok0 + row) * 256 + h * 64 + 16 * q4;
    r.v[0] = *(const uint4*)vp; r.v[1] = *(const uint4*)(vp + 8);
}
__device__ __forceinline__ void gla_p1_phase(const Args& a, LAS unsigned char* L, int wv, int bid, int G) {
    const int NU = BATCH * 4 * NCH;
    const int grp = wv >> 2, lw = wv & 3;
    LAS float* sb = (LAS float*)L + grp * 9344; LAS float* skT = sb + 64 * 33; LAS float* sv = skT + 32 * 66;
    int unit = bid + grp * G;
    GlaRaw1 R;
    { const int lt = lw * 64 + lane_id_opaque(); if (unit < NU) gla_raw1_issue(a, R, unit, lt); }
    while (unit - grp * G < NU) {
        const int lane = lane_id_opaque(), lt = lw * 64 + lane, r16 = lane & 15, g = lane >> 4;
        const bool act = unit < NU;
        const int row = lt >> 2, q4 = lt & 3;
        if (act) { LAS float* p = sb + row * 33 + 8 * q4;
#pragma unroll
            for (int e = 0; e < 4; ++e) { p[e] = R.la[0][e]; p[4 + e] = R.la[1][e]; } }
        __syncthreads();
        if (act) {
#pragma unroll
            for (int cc = 0; cc < 8; ++cc) { const int d = lw * 8 + cc; float v = sb[lane * 33 + d];
#pragma unroll
                for (int o = 1; o < 64; o <<= 1) { const float t = shup(v, o, lane); if (lane >= o) v += t; }
                sb[lane * 33 + d] = v; }
        }
        __syncthreads();
        float dlast = 0.f;
        if (act) {
            const int d0 = 8 * q4;
            const unsigned ww[4] = {R.k.x, R.k.y, R.k.z, R.k.w};
#pragma unroll
            for (int e = 0; e < 4; ++e) {
                skT[(d0 + 2 * e) * 66 + row] = __uint_as_float(ww[e] << 16) * __expf(sb[63 * 33 + d0 + 2 * e] - sb[row * 33 + d0 + 2 * e]);
                skT[(d0 + 2 * e + 1) * 66 + row] = __uint_as_float(ww[e] & 0xffff0000u) * __expf(sb[63 * 33 + d0 + 2 * e + 1] - sb[row * 33 + d0 + 2 * e + 1]);
            }
            LAS float* vd = sv + row * 80 + 16 * q4;
#pragma unroll
            for (int hh = 0; hh < 2; ++hh) { const unsigned vw[4] = {R.v[hh].x, R.v[hh].y, R.v[hh].z, R.v[hh].w};
#pragma unroll
                for (int e = 0; e < 4; ++e) { vd[8 * hh + 2 * e] = __uint_as_float(vw[e] << 16); vd[8 * hh + 2 * e + 1] = __uint_as_float(vw[e] & 0xffff0000u); } }
            if (lt < 32) dlast = __expf(sb[63 * 33 + lt]);
        }
        const int cur = unit, nunit = unit + 2 * G;
        if (nunit < NU) gla_raw1_issue(a, R, nunit, lt);
        __syncthreads();
        if (act) {
            pg8::f32x4 acc0 = {0.f, 0.f, 0.f, 0.f}, acc1 = {0.f, 0.f, 0.f, 0.f};
#pragma unroll
            for (int ks = 0; ks < 16; ++ks) { const float bv = sv[(4 * ks + g) * 80 + 16 * lw + r16];
                acc0 = __builtin_amdgcn_mfma_f32_16x16x4f32(skT[r16 * 66 + 4 * ks + g], bv, acc0, 0, 0, 0);
                acc1 = __builtin_amdgcn_mfma_f32_16x16x4f32(skT[(16 + r16) * 66 + 4 * ks + g], bv, acc1, 0, 0, 0); }
#pragma unroll
            for (int r = 0; r < 4; ++r) { a.U()[(size_t)cur * 2048 + (4 * g + r) * 64 + 16 * lw + r16] = acc0[r]; a.U()[(size_t)cur * 2048 + (16 + 4 * g + r) * 64 + 16 * lw + r16] = acc1[r]; }
            if (lt < 32) a.Dc()[(size_t)cur * 32 + lt] = dlast;
        }
        unit = nunit;
        __syncthreads();
    }
}
__device__ __forceinline__ void gla_scan_slice(const Args& a, int slice, LAS unsigned char* L, int wv) {
    const int tid = wv * 64 + lane_id_opaque();
    const int e = tid & 63, sg = tid >> 6, bh = slice >> 5, d = slice & 31;
    LAS float* sS = (LAS float*)L; LAS float* sP = sS + 512;
    float Uv[32], Dv[32];
    const size_t unit0 = (size_t)bh * 256 + sg * 32;
#pragma unroll
    for (int c = 0; c < 32; ++c) { Dv[c] = a.Dc()[(unit0 + c) * 32 + d]; Uv[c] = a.U()[(unit0 + c) * 2048 + d * 64 + e]; }
    float S = 0.f, P = 1.f;
#pragma unroll
    for (int c = 0; c < 32; ++c) { S = Dv[c] * S + Uv[c]; P *= Dv[c]; }
    sS[sg * 64 + e] = S; sP[sg * 64 + e] = P;
    __syncthreads();
    float S0 = 0.f;
    for (int s2 = 0; s2 < sg; ++s2) S0 = sP[s2 * 64 + e] * S0 + sS[s2 * 64 + e];
    S = S0;
#pragma unroll
    for (int c = 0; c < 32; ++c) { a.Sst()[(unit0 + c) * 2048 + d * 64 + e] = S; S = Dv[c] * S + Uv[c]; }
    __syncthreads();
}
struct GlaRaw { pg8::f32x4 la[2], st[2]; uint4 q, k, v[2]; };
__device__ __forceinline__ void gla_raw_issue(const Args& a, GlaRaw& r, int unit, int lt) {
    const int c = unit & 255, h = (unit >> 8) & 3, b = unit >> 10;
    const size_t tok0 = (size_t)b * SEQ + c * 64; const int row = lt >> 2, q4 = lt & 3;
    const float* lp = a.la() + (tok0 + row) * 128 + h * 32 + 8 * q4;
    r.la[0] = *(const pg8::f32x4*)lp; r.la[1] = *(const pg8::f32x4*)(lp + 4);
    r.q = *(const uint4*)(a.qbkb() + (tok0 + row) * 256 + h * 32 + 8 * q4);
    r.k = *(const uint4*)(a.qbkb() + (tok0 + row) * 256 + 128 + h * 32 + 8 * q4);
    const bf16* vp = a.vb() + (tok0 + row) * 256 + h * 64 + 16 * q4;
    r.v[0] = *(const uint4*)vp; r.v[1] = *(const uint4*)(vp + 8);
    const float* sp = a.Sst() + (size_t)unit * 2048 + 8 * lt;
    r.st[0] = *(const pg8::f32x4*)sp; r.st[1] = *(const pg8::f32x4*)(sp + 4);
}
__device__ __forceinline__ void gla_p3_phase(const Args& a, int l, LAS unsigned char* L, int wv, int bid, int G, int dry) {
    constexpr int GF = 4288 + 2176 + 5120 + 2560 + 4224;
    const int NU = BATCH * 4 * NCH;
    const int grp = wv >> 2, lw = wv & 3;
    LAS float* sb = (LAS float*)L + grp * GF; LAS float* sk = sb + 64 * 33; LAS float* so = sb; LAS float* sq = sb + 4288; LAS float* sv = sq + 2176; LAS float* sS = sv + 5120; LAS float* sa = sS + 2560;
    int unit = bid + grp * G;
    GlaRaw R;
    { const int lt = lw * 64 + lane_id_opaque(); if (unit < NU) gla_raw_issue(a, R, unit, lt); }
    while (unit - grp * G < NU) {
        const int lane = lane_id_opaque(), lt = lw * 64 + lane, r16 = lane & 15, g = lane >> 4;
        const bool act = unit < NU;
        const int uc = act ? unit : 0;
        const int c = uc & 255, h = (uc >> 8) & 3, b = uc >> 10;
        const size_t tok0 = (size_t)b * SEQ + c * 64;
        const int row = lt >> 2, q4 = lt & 3;
        uint4* gptr = (uint4*)(a.cb() + (tok0 + row) * 1024 + 512 + h * 64 + 16 * q4);
        uint4 gate[2] = {make_uint4(0, 0, 0, 0), make_uint4(0, 0, 0, 0)};
        if (act) { gate[0] = gptr[0]; gate[1] = gptr[1]; }
        if (act) { LAS float* p = sb + row * 33 + 8 * q4;
#pragma unroll
            for (int e = 0; e < 4; ++e) { p[e] = R.la[0][e]; p[4 + e] = R.la[1][e]; } }
        __syncthreads();
        if (act) {
#pragma unroll
            for (int cc = 0; cc < 8; ++cc) { const int d = lw * 8 + cc; float v = sb[lane * 33 + d];
#pragma unroll
                for (int o = 1; o < 64; o <<= 1) { const float t = shup(v, o, lane); if (lane >= o) v += t; }
                sb[lane * 33 + d] = v; }
        }
        __syncthreads();
        float qk_keep[16];
        if (act) {
            const int d0 = 8 * q4;
            const unsigned qw[4] = {R.q.x, R.q.y, R.q.z, R.q.w}, kw[4] = {R.k.x, R.k.y, R.k.z, R.k.w};
#pragma unroll
            for (int e = 0; e < 4; ++e) {
                const float d0v = sb[row * 33 + d0 + 2 * e] - sb[31 * 33 + d0 + 2 * e], d1v = sb[row * 33 + d0 + 2 * e + 1] - sb[31 * 33 + d0 + 2 * e + 1];
                const float e0 = __expf(d0v), e1 = __expf(d1v);
                sq[row * 34 + d0 + 2 * e] = __uint_as_float(qw[e] << 16) * e0; sq[row * 34 + d0 + 2 * e + 1] = __uint_as_float(qw[e] & 0xffff0000u) * e1;
                qk_keep[2 * e] = __uint_as_float(kw[e] << 16) * __builtin_amdgcn_rcpf(e0); qk_keep[2 * e + 1] = __uint_as_float(kw[e] & 0xffff0000u) * __builtin_amdgcn_rcpf(e1);
            }
            LAS float* vd = sv + row * 80 + 16 * q4;
#pragma unroll
            for (int hh = 0; hh < 2; ++hh) { const unsigned vw[4] = {R.v[hh].x, R.v[hh].y, R.v[hh].z, R.v[hh].w};
#pragma unroll
                for (int e = 0; e < 4; ++e) { vd[8 * hh + 2 * e] = __uint_as_float(vw[e] << 16); vd[8 * hh + 2 * e + 1] = __uint_as_float(vw[e] & 0xffff0000u); } }
            const int sd = (8 * lt) >> 6, se = (8 * lt) & 63; const float em = __expf(sb[31 * 33 + sd]);
            LAS float* sd_ = sS + sd * 80 + se;
#pragma unroll
            for (int e = 0; e < 4; ++e) { sd_[e] = R.st[0][e] * em; sd_[4 + e] = R.st[1][e] * em; }
        }
        const int cur = unit, nunit = unit + 2 * G;
        if (nunit < NU) gla_raw_issue(a, R, nunit, lt);
        if (act) {
#pragma unroll
            for (int e = 0; e < 8; ++e) sk[row * 34 + 8 * q4 + e] = qk_keep[e];
        }
        __syncthreads();
        if (act) {
            for (int tt = lw; tt < 10; tt += 4) {
                const int rb = tt >= 6 ? 3 : tt >= 3 ? 2 : tt >= 1 ? 1 : 0, cb = tt - (rb * (rb + 1)) / 2;
                pg8::f32x4 acc = {0.f, 0.f, 0.f, 0.f};
#pragma unroll
                for (int ks = 0; ks < 8; ++ks) acc = __builtin_amdgcn_mfma_f32_16x16x4f32(sq[(16 * rb + r16) * 34 + 4 * ks + g], sk[(16 * cb + r16) * 34 + 4 * ks + g], acc, 0, 0, 0);
#pragma unroll
                for (int r = 0; r < 4; ++r) { const int i = 16 * rb + 4 * g + r, j = 16 * cb + r16; sa[i * 66 + j] = (j <= i) ? acc[r] : 0.f; }
            }
        }
        __syncthreads();
        pg8::f32x4 oacc[4];
        if (act) {
#pragma unroll
            for (int rb = 0; rb < 4; ++rb) oacc[rb] = (pg8::f32x4){0.f, 0.f, 0.f, 0.f};
#pragma unroll
            for (int ks = 0; ks < 8; ++ks) { const float bv = sS[(4 * ks + g) * 80 + 16 * lw + r16];
#pragma unroll
                for (int rb = 0; rb < 4; ++rb) oacc[rb] = __builtin_amdgcn_mfma_f32_16x16x4f32(sq[(16 * rb + r16) * 34 + 4 * ks + g], bv, oacc[rb], 0, 0, 0); }
#pragma unroll
            for (int ks = 0; ks < 16; ++ks) { const float bv = sv[(4 * ks + g) * 80 + 16 * lw + r16];
#pragma unroll
                for (int rb = 0; rb < 4; ++rb) if (ks < 4 * (rb + 1)) oacc[rb] = __builtin_amdgcn_mfma_f32_16x16x4f32(sa[(16 * rb + r16) * 66 + 4 * ks + g], bv, oacc[rb], 0, 0, 0); }
        }
        __syncthreads();
        if (act) {
#pragma unroll
            for (int rb = 0; rb < 4; ++rb)
#pragma unroll
                for (int r = 0; r < 4; ++r) so[(16 * rb + 4 * g + r) * 65 + 16 * lw + r16] = oacc[rb][r];
        }
        __syncthreads();
        if (act) {
            const LAS float* orow = so + row * 65 + 16 * q4;
            float ov[16]; float ss = 0.f;
#pragma unroll
            for (int e = 0; e < 16; ++e) { ov[e] = orow[e]; ss += ov[e] * ov[e]; }
            ss += shx(ss, 1, lane); ss += shx(ss, 2, lane);
            const float inv = pg8::rsq_f(ss * (1.f / 64.f) + EPS);
            const float* gg = a.g_gla_out() + l * 64 + 16 * q4;
            unsigned ow[8];
#pragma unroll
            for (int e = 0; e < 8; ++e) { const unsigned gw = (e < 4) ? ((e == 0) ? gate[0].x : (e == 1) ? gate[0].y : (e == 2) ? gate[0].z : gate[0].w) : ((e == 4) ? gate[1].x : (e == 5) ? gate[1].y : (e == 6) ? gate[1].z : gate[1].w);
                ow[e] = cvtpk(ov[2 * e] * inv * gg[2 * e] * __uint_as_float(gw << 16), ov[2 * e + 1] * inv * gg[2 * e + 1] * __uint_as_float(gw & 0xffff0000u)); }
            if (!dry) { gptr[0] = make_uint4(ow[0], ow[1], ow[2], ow[3]); gptr[1] = make_uint4(ow[4], ow[5], ow[6], ow[7]); } else asm volatile("" :: "v"(ow[0]), "v"(ow[3]), "v"(ow[7]));
        }
        (void)cur;
        unit = nunit;
        __syncthreads();
    }
}

__device__ __forceinline__ int src_col_in(int R) {
    const int tile = R >> 8, loc = R & 255, bj = loc >> 7, wc = (loc >> 5) & 3, j = loc & 31;
    switch (tile) {
        case 0: case 1: return C_QA + (4 * tile + wc) * 64 + 32 * bj + j;
        case 2: case 3: return C_KA + (4 * (tile - 2) + wc) * 64 + 32 * bj + j;
        case 4: case 5: return C_VA + 256 * (tile - 4) + loc;
        case 6: case 7: return C_GA + 256 * (tile - 6) + loc;
        case 8: return C_QB + loc;
        case 9: return C_VB + loc;
        case 10: return C_GB + loc;
        case 11: return C_QM + wc * 64 + 32 * bj + j;
        case 12: return C_GM + loc;
        default: return loc < 128 ? -(loc + 2) : -1;
    }
}

__device__ __forceinline__ void conv_item(const float* W, int ldw, int sc0, const float* g, bf16* WT, int R0, int k0, LAS float* scr, int lane) {
    float wv_[32];
#pragma unroll
    for (int i = 0; i < 32; ++i) { const int kk = 2 * i + (lane >> 5); wv_[i] = W[(size_t)(k0 + kk) * ldw + sc0 + (lane & 31)]; }
#pragma unroll
    for (int i = 0; i < 32; ++i) { const int kk = 2 * i + (lane >> 5); scr[kk * 33 + (lane & 31)] = wv_[i] * (g ? g[k0 + kk] : 1.f); }
    asm volatile("s_waitcnt lgkmcnt(0)" ::: "memory");
    const int c = lane & 7;
#pragma unroll
    for (int j = 0; j < 4; ++j) { const int n = (lane >> 3) + 8 * j; const LAS float* sp = scr + (8 * c) * 33 + n;
        uint4 o; o.x = pk2(sp[0 * 33], sp[1 * 33]); o.y = pk2(sp[2 * 33], sp[3 * 33]); o.z = pk2(sp[4 * 33], sp[5 * 33]); o.w = pk2(sp[6 * 33], sp[7 * 33]);
        *(uint4*)(WT + (size_t)(R0 + n) * DM + k0 + 8 * c) = o; }
    asm volatile("s_waitcnt lgkmcnt(0)" ::: "memory");
}
__device__ __forceinline__ void p0_prologue(const Args& a, LAS unsigned char* L, int bid, int G, int wv) {
    const int lane = lane_id_opaque(), gtid = bid * NTHREADS + wv * 64 + lane, nthreads = G * NTHREADS, gwave = bid * NWAVES + wv, nwaves = G * NWAVES;
    LAS float* scr = (LAS float*)(L + wv * 16384);
    constexpr int NB_IN = NINP / 32, I_IN = DEPTH * 16 * NB_IN, I_OUT = DEPTH * 16 * (DM / 32), I_MEM = DEPTH * 16 * 16;
    for (int it = gwave; it < I_IN + I_OUT + I_MEM; it += nwaves) {
        if (it < I_IN) {
            const int nb = it % NB_IN, kb = (it / NB_IN) % 16, l = it / (NB_IN * 16);
            const int sc = src_col_in(32 * nb);
            if (sc >= 0) conv_item(a.w_in() + (size_t)l * DM * NIN, NIN, sc, a.g_pre() + l * DM, a.wt_in() + (size_t)l * NINP * DM, 32 * nb, 64 * kb, scr, lane);
            else {
                const int R = 32 * nb + (lane & 31), kq = 64 * kb + 32 * (lane >> 5);
                const float* W = a.w_in() + (size_t)l * DM * NIN; const float* g = a.g_pre() + l * DM;
                const float* wg = a.w_gate_up() + (size_t)l * 16 * 128 + (R & 127);
                for (int k8 = 0; k8 < 4; ++k8) {
                    float v[8];
#pragma unroll
                    for (int kk = 0; kk < 8; ++kk) { float sacc = 0.f;
                        if (sc != -1) { const float* wr = W + (size_t)(kq + 8 * k8 + kk) * NIN + C_RB;
#pragma unroll
                            for (int r = 0; r < 16; ++r) sacc += wr[r] * wg[r * 128]; }
                        v[kk] = sacc * g[kq + 8 * k8 + kk]; }
                    uint4 o; o.x = pk2(v[0], v[1]); o.y = pk2(v[2], v[3]); o.z = pk2(v[4], v[5]); o.w = pk2(v[6], v[7]);
                    *(uint4*)(a.wt_in() + ((size_t)l * NINP + R) * DM + kq + 8 * k8) = o;
                }
            }
        } else if (it < I_IN + I_OUT) {
            const int r = it - I_IN, nb = r % 32, kb = (r / 32) % 16, l = r / 512;
            conv_item(a.w_out() + (size_t)l * DM * DM, DM, 32 * nb, nullptr, a.wt_out() + (size_t)l * DM * DM, 32 * nb, 64 * kb, scr, lane);
        } else {
            const int r = it - I_IN - I_OUT, nb = r % 16, kb = (r / 16) % 16, l = r / 256;
            const int loc = 32 * nb; int sc;
            if (loc < 256) { const int bj = loc >> 7, wc = (loc >> 5) & 3; sc = wc * 64 + 32 * bj; } else sc = loc;
            conv_item(a.w_mem_kv() + (size_t)l * DM * 512, 512, sc, a.g_mem() + l * DM, a.wt_mem() + (size_t)l * 512 * DM, loc, 64 * kb, scr, lane);
        }
    }
    for (int row = gwave; row < TM; row += nwaves) {
        const float4* xr = (const float4*)(a.mem() + (size_t)row * DM) + lane;
        float s = 0.f;
#pragma unroll
        for (int j = 0; j < 4; ++j) {
            const float4 v = xr[64 * j]; s += (v.x * v.x + v.y * v.y) + (v.z * v.z + v.w * v.w);
            uint2 o; o.x = pk2(v.x, v.y); o.y = pk2(v.z, v.w);
            *((uint2*)(a.membf() + (size_t)row * DM) + lane + 64 * j) = o;
        }
        s = wave_sum(s, lane);
        if (lane < 16) a.ssqm()[(size_t)row * 16 + lane] = (lane == 0) ? s : 0.f;
    }
    for (int row0 = gwave * 4; row0 < T; row0 += nwaves * 4) {
        float4 v[4][4];
#pragma unroll
        for (int rr = 0; rr < 4; ++rr)
#pragma unroll
            for (int j = 0; j < 4; ++j) v[rr][j] = ((const float4*)(a.x() + (size_t)(row0 + rr) * DM) + lane)[64 * j];
#pragma unroll
        for (int rr = 0; rr < 4; ++rr) {
            float sacc = 0.f;
#pragma unroll
            for (int j = 0; j < 4; ++j) {
                const float4 w = v[rr][j]; sacc += (w.x * w.x + w.y * w.y) + (w.z * w.z + w.w * w.w);
                uint2 o; o.x = pk2(w.x, w.y); o.y = pk2(w.z, w.w);
                *((uint2*)(a.xb() + (size_t)(row0 + rr) * DM) + lane + 64 * j) = o;
            }
            sacc = wave_sum(sacc, lane);
            if (lane < 16) a.ssq()[(size_t)(row0 + rr) * 16 + lane] = (lane == 0) ? sacc : 0.f;
        }
    }
}

constexpr int N_STEPS = 2 + 5 * DEPTH;
constexpr int CW_BAR = 4096;
#ifndef MK_SPLIT
#define MK_SPLIT 0
#endif
#ifndef PROBE
#define PROBE 0
#endif
__global__ void __launch_bounds__(NTHREADS, 2) mk_fwd(KArgs aa) {
    extern __shared__ __attribute__((aligned(16))) unsigned char lds[];
    const int G = gridDim.x;
    PG8_LAS unsigned char* L = (PG8_LAS unsigned char*)lds;
    const int wave_s = __builtin_amdgcn_readfirstlane(threadIdx.x >> 6);
    {
        const int tid0 = wave_s * 64 + (int)__builtin_amdgcn_mbcnt_hi(~0u, __builtin_amdgcn_mbcnt_lo(~0u, 0u));
        for (int u = tid0; u < 512 / 4; u += NTHREADS) ((LAS unsigned*)(L + MISC_OFF))[u] = 0u;
        __syncthreads();
    }
    unsigned* barw = (unsigned*)(aa.ws + O_CTL) + CW_BAR;
    XcdBarrier bar; bar.bar = barw; bar.x = 0; bar.st = nullptr;
    if (!MK_SPLIT) bar = xcd_barrier_post(barw, (volatile LAS unsigned*)(L + MISC_OFF) + 8, wave_s * 64 + (int)__builtin_amdgcn_mbcnt_hi(~0u, __builtin_amdgcn_mbcnt_lo(~0u, 0u)));
    const int ph_lo = aa.ph_lo, ph_hi = aa.ph_hi;
    for (int st = ph_lo; st < ph_hi; ++st) {
        int bid_o = blockIdx.x, wv_o = wave_s;
        asm volatile("" : "+s"(bid_o)); asm volatile("" : "+s"(wv_o));
        Args a; a.kp = (const __attribute__((address_space(4))) KArgs*)__builtin_amdgcn_kernarg_segment_ptr();
        asm volatile("" : "+s"(a.kp));
        const int wave = wv_o, bid = bid_o;
        if (st == 0) {
            p0_prologue(a, L, bid, G, wave);
            if (PROBE == 11) p0_prologue(a, L, bid, G, wave);
        } else if (st == 1) {
            pg8::Gemm g{a.membf(), a.wt_mem(), TM, DEPTH * 512, DM}; pg8::StaticOrder S; S.init(TM, DEPTH * 512, G, bid);
            pg8::EpiMem E{a.memk(), a.memv(), a.ssqm(), a.g_k_mem(), TM};
            pg8::gemm_phase<pg8::EpiMem, pg8::StaticOrder, false, true>(L, g, S, E, wave);
        } else {
            const int l = (st - 2) / 5, k = (st - 2) % 5;
            for (int rep = 0; rep < ((PROBE == k + 1) ? 2 : 1); ++rep) {
            const int dry = (PROBE == k + 1 && rep == 0 && (k == 3 || k == 4 || k == 1)) ? 1 : 0;
            if (k == 0) {
                if (bid == 0) { const int t0 = wave * 64 + lane_id_opaque(); a.gcnt()[t0] = 0u; a.gcnt()[t0 + 512] = 0u; }
                pg8::Gemm g{a.xb(), a.wt_in() + (size_t)l * NINP * DM, T, NINP, DM}; pg8::StaticOrder S; S.init(T, NINP, G, bid);
                pg8::EpiIn E{a.qa(), a.ka(), a.va(), a.cb(), a.qbkb(), a.vb(), a.qm(), a.la(), a.kmp(), a.ssq(), a.g_q_moba() + l * 64, a.g_k_moba() + l * 64, a.g_q_mem() + l * 64, a.b_gate_up() + l * 128};
                if (PROBE == 13) { pg8::EpiDry ED; pg8::gemm_phase<pg8::EpiDry, pg8::StaticOrder, true, true>(L, g, S, ED, wave); }
                pg8::gemm_phase<pg8::EpiIn, pg8::StaticOrder, true, true>(L, g, S, E, wave);
            } else if (k == 1) {
                const float zthr = zero_thr(softmax_ref(a.g_q_moba() + l * 64, a.g_k_moba() + l * 64));
                moba_route_phase(a, L, wave, bid, G, zthr, dry);
                gla_p1_phase(a, L, wave, bid, G);
            } else if (k == 2) {
                for (int sl = bid; sl < 256; sl += G) gla_scan_slice(a, sl, L, wave);
                if (PROBE == 9) moba_pairs_phase(a, l, L, wave, bid, G, 1);
                if (PROBE == 10) for (int sl = bid; sl < 256; sl += G) gla_scan_slice(a, sl, L, wave);
                moba_pairs_phase(a, l, L, wave, bid, G);
            } else if (k == 3) {
                const float Mref = softmax_ref(a.g_q_moba() + l * 64, a.g_k_moba() + l * 64);
                if (PROBE >= 6) {
                    if (PROBE == 6) for (int u = bid; u < BATCH * 8 * 64; u += 2 * G) moba_own_pair(a, u, (u + G < BATCH * 8 * 64) ? u + G : u, L, wave, Mref, 1);
                    const float Mm0 = softmax_ref(a.g_q_mem() + l * 64, a.g_k_mem() + l * 64);
                    if (PROBE == 7) mem_attn_phase(a, l, L, wave, bid, G, Mm0, 1);
                    if (PROBE == 8) gla_p3_phase(a, l, L, wave, bid, G, 1);
                }
                for (int u = bid; u < BATCH * 8 * 64; u += 2 * G) moba_own_pair(a, u, (u + G < BATCH * 8 * 64) ? u + G : u, L, wave, Mref, dry);
                const float Mm = softmax_ref(a.g_q_mem() + l * 64, a.g_k_mem() + l * 64);
                mem_attn_phase(a, l, L, wave, bid, G, Mm, dry);
                gla_p3_phase(a, l, L, wave, bid, G, dry);
            } else {
                pg8::Gemm g{a.cb(), a.wt_out() + (size_t)l * DM * DM, T, DM, DM}; pg8::StaticOrder S; S.init(T, DM, G, bid);
                if (l == 0) { pg8::EpiOut<1, 0> E{a.x(), a.out(), a.xb(), a.ssq()}; pg8::gemm_phase<pg8::EpiOut<1, 0>, pg8::StaticOrder, true, true>(L, g, S, E, wave); }
                else if (l == DEPTH - 1) { pg8::EpiOut<0, 1> E{a.x(), a.out(), a.xb(), a.ssq()}; pg8::gemm_phase<pg8::EpiOut<0, 1>, pg8::StaticOrder, true, true>(L, g, S, E, wave); }
                else { pg8::EpiOut<0, 0> E{a.x(), a.out(), a.xb(), a.ssq()}; pg8::gemm_phase<pg8::EpiOut<0, 0>, pg8::StaticOrder, true, true>(L, g, S, E, wave); }
            }
            }
        }
        if (!MK_SPLIT && st + 1 < ph_hi && st != 1) {
            XcdBarrier b2 = bar; unsigned* bp = b2.bar; unsigned bx = b2.x;
            asm volatile("" : "+s"(bp)); asm volatile("" : "+s"(bx));
            b2.bar = bp; b2.x = bx;
            xcd_barrier(b2, wave);
            if (PROBE == 12) xcd_barrier(b2, wave);
        }
    }
}

extern "C" void kernel_launch(void* const* d_in, const int* in_sizes, int n_in, void* d_out, int out_size, void* d_ws, size_t ws_size, hipStream_t stream) {
    static int grid = 0;
    if (grid == 0) {
        int dev = 0, cus = 0;
        if (hipGetDevice(&dev) != hipSuccess || hipDeviceGetAttribute(&cus, hipDeviceAttributeMultiprocessorCount, dev) != hipSuccess) { grid = -1; return; }
        if (hipFuncSetAttribute((const void*)mk_fwd, hipFuncAttributeMaxDynamicSharedMemorySize, LDS_BYTES) != hipSuccess) { fprintf(stderr, "hipFuncSetAttribute failed\n"); grid = -1; return; }
        grid = cus;
    }
    if (grid < 0) return;
    KArgs a{};
    a.x = (const float*)d_in[0]; a.mem = (const float*)d_in[1]; a.g_pre = (const float*)d_in[2]; a.w_in = (const float*)d_in[3];
    a.g_q_moba = (const float*)d_in[4]; a.g_k_moba = (const float*)d_in[5]; a.w_gate_up = (const float*)d_in[6]; a.b_gate_up = (const float*)d_in[7];
    a.g_gla_out = (const float*)d_in[8]; a.g_mem = (const float*)d_in[9]; a.w_mem_kv = (const float*)d_in[10]; a.g_q_mem = (const float*)d_in[11];
    a.g_k_mem = (const float*)d_in[12]; a.w_out = (const float*)d_in[13];
    a.out = (float*)d_out;
    a.ws = (unsigned char*)d_ws;
    (void)ws_size; (void)in_sizes; (void)n_in; (void)out_size;
    (void)hipMemsetAsync((char*)d_ws + O_CTL, 0, 1 << 16, stream);
#if MK_SPLIT
    for (int st = 0; st < N_STEPS; ++st) { a.ph_lo = st; a.ph_hi = st + 1; hipLaunchKernelGGL(mk_fwd, dim3(grid), dim3(NTHREADS), LDS_BYTES, stream, a); }
#else
    a.ph_lo = 0; a.ph_hi = N_STEPS;
    hipLaunchKernelGGL(mk_fwd, dim3(grid), dim3(NTHREADS), LDS_BYTES, stream, a);
#endif
}
```

```cpp
#include <hip/hip_runtime.h>
#include <cstdio>
#include <cstdint>
#include <cstddef>

constexpr int BATCH = 2, SEQ = 16384, DM = 1024, DEPTH = 4, T = BATCH * SEQ;
constexpr int MEM_LEN = 256, TM = BATCH * MEM_LEN;
constexpr int NIN = 3344;
constexpr int C_QA = 0, C_KA = 512, C_VA = 1024, C_GA = 1536, C_QB = 2048, C_KB = 2176, C_VB = 2304, C_GB = 2560, C_RB = 2816, C_QM = 2832, C_GM = 3088;
constexpr int NB = SEQ / 256;
constexpr int NCH = SEQ / 64;
constexpr float EPS = 1e-6f;
constexpr int NINP = 14 * 256;
constexpr float LOG2E = 1.4426950408889634f;
constexpr float QSCALE = 0.125f * LOG2E;

__device__ __forceinline__ int lane_id_opaque() { int l; asm volatile("v_mbcnt_lo_u32_b32 %0, -1, 0\n\tv_mbcnt_hi_u32_b32 %0, -1, %0" : "=v"(l)); return l; }
__device__ __forceinline__ float red16(float v) { const auto r = __builtin_amdgcn_permlane16_swap(__float_as_uint(v), __float_as_uint(v), false, false); return __uint_as_float(r[0]) + __uint_as_float(r[1]); }
__device__ __forceinline__ float red32(float v) { const auto r = __builtin_amdgcn_permlane32_swap(__float_as_uint(v), __float_as_uint(v), false, false); return __uint_as_float(r[0]) + __uint_as_float(r[1]); }
template <int CTRL> __device__ __forceinline__ float dppmov(float v) { return __int_as_float(__builtin_amdgcn_update_dpp(0, __float_as_int(v), CTRL, 0xF, 0xF, false)); }
__device__ __forceinline__ float row16_sum(float v) { v += dppmov<0x128>(v); v += dppmov<0x124>(v); v += dppmov<0x4E>(v); v += dppmov<0xB1>(v); return v; }
__device__ __forceinline__ float shx(float v, int mask, int lane) { return __int_as_float(__builtin_amdgcn_ds_bpermute((lane ^ mask) << 2, __float_as_int(v))); }
__device__ __forceinline__ int shx_i(int v, int mask, int lane) { return __builtin_amdgcn_ds_bpermute((lane ^ mask) << 2, v); }
__device__ __forceinline__ float shup(float v, int o, int lane) { return __int_as_float(__builtin_amdgcn_ds_bpermute((lane >= o ? lane - o : lane) << 2, __float_as_int(v))); }
__device__ __forceinline__ int shup_i(int v, int o, int lane) { return __builtin_amdgcn_ds_bpermute((lane >= o ? lane - o : lane) << 2, v); }

namespace pg8 {
#define PG8_LAS __attribute__((address_space(3)))
typedef unsigned short bf16_t;
typedef short bf16x8 __attribute__((ext_vector_type(8)));
typedef float f32x4 __attribute__((ext_vector_type(4)));
typedef unsigned u32x4 __attribute__((ext_vector_type(4)));
constexpr int BM = 256, BK = 64, HALF = 128, HTB = HALF * BK * 2  , STAGE_BYTES = 8 * HTB, NXCD = 8, WGM = 8;

__host__ __device__ __forceinline__ int lds_byte(int r, int c) { const int st = (r >> 4) * 2 + (c >> 5), rr = r & 15, cc = c & 31, ob = rr * 64 + cc * 2; return st * 1024 + (ob ^ (((ob >> 9) & 1) << 5)); }
__host__ __device__ __forceinline__ void stage_rc(int b, int& R, int& C) { const int st = b / 1024, sb = b % 1024, swz = sb ^ (((sb >> 9) & 1) << 5); R = (st >> 1) * 16 + swz / 64; C = (st & 1) * 32 + (swz % 64) / 2; }
__host__ __device__ __forceinline__ int perm32(int rho) { const int n = rho >> 4, i = rho & 15; return 8 * (i >> 2) + 4 * n + (i & 3); }

struct Unit { int pm, pn; };
struct Gemm { const bf16_t* A; const bf16_t* Bt; int M, N, K; };

struct StaticOrder {
    int nM, nN, nwg, G, c;
    __host__ __device__ void init(int M, int N, int G_, int c_) { nM = M / BM; nN = N / BM; nwg = nM * nN; G = G_; c = c_; }
    __host__ __device__ bool next(int i, Unit& u) const {
        const long L = (long)i * G + c; if (L >= nwg) return false;
        int wgid = (int)L; { const int q = nwg / NXCD, r = nwg % NXCD, xcd = wgid % NXCD, off = wgid / NXCD; wgid = (xcd < r ? xcd * (q + 1) : r * (q + 1) + (xcd - r) * q) + off; }
        const int nig = WGM * nN, gid = wgid / nig, fm = gid * WGM, gsz = (nM - fm) < WGM ? (nM - fm) : WGM;
        u.pm = fm + ((wgid % nig) % gsz); u.pn = (wgid % nig) / gsz; return true;
    }
    __device__ __forceinline__ void a_ready(const Unit&) const {}
    __device__ __forceinline__ void done(const Unit&) const {}
};

__device__ __forceinline__ unsigned cvt_pk_bf16(float lo, float hi) { unsigned r; asm volatile("v_cvt_pk_bf16_f32 %0, %1, %2" : "=v"(r) : "v"(lo), "v"(hi)); return r; }
__device__ __forceinline__ float silu_f(float g) { return g * __builtin_amdgcn_rcpf(1.f + __builtin_amdgcn_exp2f(-1.4426950408889634f * g)); }
__device__ __forceinline__ float rsq_f(float x) { return __builtin_amdgcn_rsqf(x); }
typedef unsigned u32x2 __attribute__((ext_vector_type(2)));

struct EpiIn {
    static constexpr bool PERM = true, AFTER_DRAIN = false;
    bf16_t *qa, *ka, *va, *cb, *qbkb, *vb, *qm; float *la, *kmp; const float *ssq, *gq, *gk, *gqm, *bgu;
    __device__ __forceinline__ void operator()(const f32x4 (&acc)[2][2][4][2], const Unit& u, int wr, int wc, int fr, int fq) const {
        const int row0 = u.pm * BM + wr * 64 + fr, lane = fq * 16 + fr;
        float rs[2][4];
        {
            f32x4 pp[2][4];
#pragma unroll
            for (int ai = 0; ai < 2; ++ai)
#pragma unroll
                for (int m = 0; m < 4; ++m) pp[ai][m] = *(const f32x4*)(ssq + (size_t)(row0 + ai * HALF + m * 16) * 16 + fq * 4);
            asm volatile("" : "+v"(pp[0][0]), "+v"(pp[0][1]), "+v"(pp[0][2]), "+v"(pp[0][3]), "+v"(pp[1][0]), "+v"(pp[1][1]), "+v"(pp[1][2]), "+v"(pp[1][3]));
#pragma unroll
            for (int ai = 0; ai < 2; ++ai)
#pragma unroll
                for (int m = 0; m < 4; ++m) {
                    const f32x4 p = pp[ai][m];
                    float s = (p[0] + p[1]) + (p[2] + p[3]);
                    s = red16(s); s = red32(s);
                    rs[ai][m] = rsq_f(s * (1.f / 1024.f) + EPS);
                }
        }
        const int pn = u.pn;
        if (pn <= 3 || pn == 11) {
            bf16_t* dst; const float* g; float qs; int head, ld;
            if (pn <= 1) { dst = qa; g = gq; qs = QSCALE; head = 4 * pn + wc; ld = 512; }
            else if (pn <= 3) { dst = ka; g = gk; qs = 1.f; head = 4 * (pn - 2) + wc; ld = 512; }
            else { dst = qm; g = gqm; qs = QSCALE; head = wc; ld = 256; }
            f32x4 gv[2][2];
#pragma unroll
            for (int bj = 0; bj < 2; ++bj)
#pragma unroll
                for (int n = 0; n < 2; ++n) gv[bj][n] = *(const f32x4*)(g + 32 * bj + 8 * fq + 4 * n);
            f32x4 ksum[2][2];
#pragma unroll
            for (int bj = 0; bj < 2; ++bj)
#pragma unroll
                for (int n = 0; n < 2; ++n) ksum[bj][n] = (f32x4){0.f, 0.f, 0.f, 0.f};
#pragma unroll
            for (int ai = 0; ai < 2; ++ai)
#pragma unroll
                for (int m = 0; m < 4; ++m) {
                    f32x4 v[2][2]; float ss = 0.f;
#pragma unroll
                    for (int bj = 0; bj < 2; ++bj)
#pragma unroll
                        for (int n = 0; n < 2; ++n) { v[bj][n] = acc[ai][bj][m][n] * rs[ai][m]; const f32x4 t = v[bj][n]; ss += (t[0] * t[0] + t[1] * t[1]) + (t[2] * t[2] + t[3] * t[3]); }
                    ss = red16(ss); ss = red32(ss);
                    const float inv = rsq_f(ss * (1.f / 64.f) + EPS);
                    const int grow = row0 + ai * HALF + m * 16;
                    bf16_t* rowp = (pn <= 3) ? dst + (((size_t)((u.pm >> 6) * 8 + head)) * SEQ + (grow & (SEQ - 1))) * 64 + 8 * fq : dst + (size_t)grow * ld + head * 64 + 8 * fq;
#pragma unroll
                    for (int bj = 0; bj < 2; ++bj) {
                        const f32x4 a = v[bj][0] * inv * gv[bj][0], b = v[bj][1] * inv * gv[bj][1];
                        ksum[bj][0] += a; ksum[bj][1] += b;
                        u32x4 w; w.x = cvt_pk_bf16(a[0] * qs, a[1] * qs); w.y = cvt_pk_bf16(a[2] * qs, a[3] * qs); w.z = cvt_pk_bf16(b[0] * qs, b[1] * qs); w.w = cvt_pk_bf16(b[2] * qs, b[3] * qs);
                        *(u32x4*)(rowp + 32 * bj) = w;
                    }
                }
            if (pn == 2 || pn == 3) {
#pragma unroll
                for (int bj = 0; bj < 2; ++bj)
#pragma unroll
                    for (int n = 0; n < 2; ++n)
#pragma unroll
                        for (int e = 0; e < 4; ++e) ksum[bj][n][e] = row16_sum(ksum[bj][n][e]);
                if (fr == 0) {
                    const int b = u.pm >> 6, blk = u.pm & 63;
                    float* kp = kmp + ((((size_t)(b * 8 + head) * 64 + blk) * 2 + wr) * 64) + 8 * fq;
#pragma unroll
                    for (int bj = 0; bj < 2; ++bj)
#pragma unroll
                        for (int n = 0; n < 2; ++n) *(f32x4*)(kp + 32 * bj + 4 * n) = ksum[bj][n];
                }
            }
        } else if (pn == 13) {
            f32x4 bv[2];
#pragma unroll
            for (int n = 0; n < 2; ++n) bv[n] = *(const f32x4*)(bgu + 32 * wc + 8 * fq + 4 * n);
#pragma unroll
            for (int ai = 0; ai < 2; ++ai)
#pragma unroll
                for (int m = 0; m < 4; ++m) {
                    float* rowp = la + (size_t)(row0 + ai * HALF + m * 16) * 128 + 32 * wc + 8 * fq;
#pragma unroll
                    for (int n = 0; n < 2; ++n) {
                        const f32x4 z = acc[ai][0][m][n] * rs[ai][m] + bv[n]; f32x4 o;
#pragma unroll
                        for (int e = 0; e < 4; ++e) o[e] = (fminf(z[e], 0.f) - 0.6931471805599453f * __builtin_amdgcn_logf(1.f + __builtin_amdgcn_exp2f(-1.4426950408889634f * fabsf(z[e])))) * (1.f / 16.f);
                        *(f32x4*)(rowp + 4 * n) = o;
                    }
                }
        } else {
            const int b = u.pm >> 6;
            if (pn == 4 || pn == 5) {
                bf16_t* base = va + (((size_t)(b * 8 + 4 * (pn - 4) + (wc >> 1))) * SEQ + (row0 & (SEQ - 1))) * 64 + 32 * (wc & 1) + 8 * fq;
                plain_rows<64, (long)2 * SEQ * 64, false>(acc, rs, base, 1.f);
            } else if (pn == 6 || pn == 7) plain_rows<1024, HALF, true>(acc, rs, cb + (size_t)row0 * 1024 + 256 * (pn - 6) + 32 * wc + 8 * fq, 1.f);
            else if (pn == 8) plain_rows<256, HALF, false>(acc, rs, qbkb + (size_t)row0 * 256 + 32 * wc + 8 * fq, 0.17677669529663687f);
            else if (pn == 9) plain_rows<256, HALF, false>(acc, rs, vb + (size_t)row0 * 256 + 32 * wc + 8 * fq, 1.f);
            else if (pn == 10) plain_rows<1024, HALF, true>(acc, rs, cb + (size_t)row0 * 1024 + 512 + 32 * wc + 8 * fq, 1.f);
            else plain_rows<1024, HALF, true>(acc, rs, cb + (size_t)row0 * 1024 + 768 + 32 * wc + 8 * fq, 1.f);
        }
    }
    template <int LD, long BJ, bool GATE> static __device__ __forceinline__ void plain_rows(const f32x4 (&acc)[2][2][4][2], const float (&rs)[2][4], bf16_t* base, float sc0) {
#pragma unroll
        for (int ai = 0; ai < 2; ++ai)
#pragma unroll
            for (int m = 0; m < 4; ++m) {
                bf16_t* rowp = base + (size_t)(ai * HALF + m * 16) * LD;
#pragma unroll
                for (int bj = 0; bj < 2; ++bj) {
                    const float sc = rs[ai][m] * (bj == 0 ? sc0 : 1.f);
                    f32x4 a = acc[ai][bj][m][0] * sc, b = acc[ai][bj][m][1] * sc;
                    if (GATE) {
#pragma unroll
                        for (int e = 0; e < 4; ++e) { a[e] = silu_f(a[e]); b[e] = silu_f(b[e]); }
                    }
                    u32x4 w; w.x = cvt_pk_bf16(a[0], a[1]); w.y = cvt_pk_bf16(a[2], a[3]); w.z = cvt_pk_bf16(b[0], b[1]); w.w = cvt_pk_bf16(b[2], b[3]);
                    *(u32x4*)(rowp + BJ * bj) = w;
                }
            }
    }
};
struct EpiDry {
    static constexpr bool PERM = true, AFTER_DRAIN = false;
    __device__ __forceinline__ void operator()(const f32x4 (&acc)[2][2][4][2], const Unit& u, int wr, int wc, int fr, int fq) const {
        f32x4 t = {0.f, 0.f, 0.f, 0.f};
#pragma unroll
        for (int ai = 0; ai < 2; ++ai)
#pragma unroll
            for (int bj = 0; bj < 2; ++bj)
#pragma unroll
                for (int m = 0; m < 4; ++m) t += acc[ai][bj][m][0] + acc[ai][bj][m][1];
        asm volatile("" :: "v"(t));
    }
};
template <int FIRST, int LAST> struct EpiOut {
    static constexpr bool PERM = false, AFTER_DRAIN = false;
    const float* xin; float* xout; bf16_t* xb; float* ssq;
    __device__ __forceinline__ void operator()(const f32x4 (&acc)[2][2][4][2], const Unit& u, int wr, int wc, int fr, int fq) const {
        const int row0 = u.pm * BM + wr * 64 + fr, col0 = u.pn * BM + wc * 32 + 4 * fq;
#pragma unroll
        for (int ai = 0; ai < 2; ++ai)
#pragma unroll
            for (int mh = 0; mh < 2; ++mh) {
                f32x4 xr[2][2][2];
                if (FIRST) {
#pragma unroll
                    for (int mm = 0; mm < 2; ++mm)
#pragma unroll
                        for (int bj = 0; bj < 2; ++bj)
#pragma unroll
                            for (int n = 0; n < 2; ++n) xr[mm][bj][n] = *(const f32x4*)(xin + (size_t)(row0 + ai * HALF + (2 * mh + mm) * 16) * DM + col0 + bj * HALF + n * 16);
                } else {
                    u32x2 xw[2][2][2];
#pragma unroll
                    for (int mm = 0; mm < 2; ++mm)
#pragma unroll
                        for (int bj = 0; bj < 2; ++bj)
#pragma unroll
                            for (int n = 0; n < 2; ++n) xw[mm][bj][n] = *(const u32x2*)(xb + (size_t)(row0 + ai * HALF + (2 * mh + mm) * 16) * DM + col0 + bj * HALF + n * 16);
                    asm volatile("" : "+v"(xw[0][0][0]), "+v"(xw[0][0][1]), "+v"(xw[0][1][0]), "+v"(xw[0][1][1]), "+v"(xw[1][0][0]), "+v"(xw[1][0][1]), "+v"(xw[1][1][0]), "+v"(xw[1][1][1]));
#pragma unroll
                    for (int mm = 0; mm < 2; ++mm)
#pragma unroll
                        for (int bj = 0; bj < 2; ++bj)
#pragma unroll
                            for (int n = 0; n < 2; ++n) { const u32x2 w = xw[mm][bj][n]; xr[mm][bj][n] = (f32x4){__uint_as_float(w.x << 16), __uint_as_float(w.x & 0xffff0000u), __uint_as_float(w.y << 16), __uint_as_float(w.y & 0xffff0000u)}; }
                }
#pragma unroll
                for (int mm = 0; mm < 2; ++mm) {
                    const int m = 2 * mh + mm, row = row0 + ai * HALF + m * 16; float ss = 0.f;
#pragma unroll
                    for (int bj = 0; bj < 2; ++bj)
#pragma unroll
                        for (int n = 0; n < 2; ++n) {
                            const size_t off = (size_t)row * DM + col0 + bj * HALF + n * 16;
                            const f32x4 v = xr[mm][bj][n] + acc[ai][bj][m][n];
                            if (LAST) *(f32x4*)(xout + off) = v;
                            else { u32x2 w; w.x = cvt_pk_bf16(v[0], v[1]); w.y = cvt_pk_bf16(v[2], v[3]); *(u32x2*)(xb + off) = w;
                                   const float r0 = __uint_as_float(w.x << 16), r1 = __uint_as_float(w.x & 0xffff0000u), r2 = __uint_as_float(w.y << 16), r3 = __uint_as_float(w.y & 0xffff0000u);
                                   ss += (r0 * r0 + r1 * r1) + (r2 * r2 + r3 * r3); }
                        }
                    if (!LAST) { ss = red16(ss); ss = red32(ss); if (fq == 0) ssq[(size_t)row * 16 + 4 * u.pn + wc] = ss; }
                }
                asm volatile("" ::: "memory");
            }
    }
};

struct EpiMem {
    static constexpr bool PERM = true, AFTER_DRAIN = false;
    bf16_t *memk, *memv; const float *ssqm, *gkm; int tm;
    __device__ __forceinline__ void operator()(const f32x4 (&acc)[2][2][4][2], const Unit& u, int wr, int wc, int fr, int fq) const {
        const int row0 = u.pm * BM + wr * 64 + fr, lane = fq * 16 + fr;
        float rs[2][4];
#pragma unroll
        for (int ai = 0; ai < 2; ++ai)
#pragma unroll
            for (int m = 0; m < 4; ++m) {
                const int row = row0 + ai * HALF + m * 16;
                const f32x4 p = *(const f32x4*)(ssqm + (size_t)row * 16 + fq * 4);
                float s = (p[0] + p[1]) + (p[2] + p[3]);
                s = red16(s); s = red32(s);
                rs[ai][m] = rsq_f(s * (1.f / 1024.f) + EPS);
            }
        const int layer = u.pn >> 1;
        if ((u.pn & 1) == 0) {
            bf16_t* dst = memk + (size_t)layer * tm * 256; const float* g = gkm + layer * 64;
            f32x4 gv[2][2];
#pragma unroll
            for (int bj = 0; bj < 2; ++bj)
#pragma unroll
                for (int n = 0; n < 2; ++n) gv[bj][n] = *(const f32x4*)(g + 32 * bj + 8 * fq + 4 * n);
#pragma unroll
            for (int ai = 0; ai < 2; ++ai)
#pragma unroll
                for (int m = 0; m < 4; ++m) {
                    f32x4 v[2][2]; float ss = 0.f;
#pragma unroll
                    for (int bj = 0; bj < 2; ++bj)
#pragma unroll
                        for (int n = 0; n < 2; ++n) { v[bj][n] = acc[ai][bj][m][n] * rs[ai][m]; const f32x4 t = v[bj][n]; ss += (t[0] * t[0] + t[1] * t[1]) + (t[2] * t[2] + t[3] * t[3]); }
                    ss = red16(ss); ss = red32(ss);
                    const float inv = rsq_f(ss * (1.f / 64.f) + EPS);
                    bf16_t* rowp = dst + (size_t)(row0 + ai * HALF + m * 16) * 256 + wc * 64 + 8 * fq;
#pragma unroll
                    for (int bj = 0; bj < 2; ++bj) {
                        const f32x4 a = v[bj][0] * inv * gv[bj][0], b = v[bj][1] * inv * gv[bj][1];
                        u32x4 w; w.x = cvt_pk_bf16(a[0], a[1]); w.y = cvt_pk_bf16(a[2], a[3]); w.z = cvt_pk_bf16(b[0], b[1]); w.w = cvt_pk_bf16(b[2], b[3]);
                        *(u32x4*)(rowp + 32 * bj) = w;
                    }
                }
        } else {
            bf16_t* dst = memv + (size_t)layer * tm * 256;
#pragma unroll
            for (int ai = 0; ai < 2; ++ai)
#pragma unroll
                for (int m = 0; m < 4; ++m) {
                    bf16_t* rowp = dst + (size_t)(row0 + ai * HALF + m * 16) * 256 + 32 * wc + 8 * fq;
#pragma unroll
                    for (int bj = 0; bj < 2; ++bj) {
                        const f32x4 a = acc[ai][bj][m][0] * rs[ai][m], b = acc[ai][bj][m][1] * rs[ai][m];
                        u32x4 w; w.x = cvt_pk_bf16(a[0], a[1]); w.y = cvt_pk_bf16(a[2], a[3]); w.z = cvt_pk_bf16(b[0], b[1]); w.w = cvt_pk_bf16(b[2], b[3]);
                        *(u32x4*)(rowp + HALF * bj) = w;
                    }
                }
        }
    }
};
template <class Epi, class Sched, bool ALIGN_EPI = false, bool SP2 = false>
__device__ __forceinline__ void gemm_phase(PG8_LAS unsigned char* lds, const Gemm g, const Sched& S, const Epi& E, int wv) {
    const int tid_l = wv * 64 + lane_id_opaque();
    const int tid = tid_l, wid = __builtin_amdgcn_readfirstlane(tid >> 6), lane = tid & 63, wr = wid >> 2, wc = wid & 3, fr = lane & 15, fq = lane >> 4;
    const int K = g.K, nt = K / BK;
    unsigned voffA[2], voffB[2];
#pragma unroll
    for (int i = 0; i < 2; ++i) { int R, C; stage_rc(tid * 16 + i * 8192, R, C); const int Rb = Epi::PERM ? ((R & ~31) + perm32(R & 31)) : R;
        voffA[i] = (unsigned)(R * K + C) * 2u; voffB[i] = (unsigned)(Rb * K + C) * 2u; }
    const size_t kstep = (size_t)(BK * 2);
    const size_t hstep = (size_t)HALF * K * 2;
    const size_t tstep = 2 * hstep;
    const unsigned ldsw = (unsigned)wid * 1024u;
    const int aoff = lds_byte(wr * 64 + fr, fq * 8), boff = lds_byte(wc * 32 + fr, fq * 8);
#define PG8_SA(b, h) (((b) * 2 + (h)) * HTB)
#define PG8_SB(b, h) ((4 + (b) * 2 + (h)) * HTB)
#define PG8_STAGE(bufoff, gbase, voff) do { _Pragma("unroll") for (int _i = 0; _i < 2; ++_i) \
        __builtin_amdgcn_global_load_lds((const unsigned*)((const char*)(gbase) + (voff)[_i]), (PG8_LAS unsigned*)(lds + (bufoff) + ldsw + _i * 8192), 16, 0, 0); } while (0)
#define PG8_LDA(dst, b, h) do { _Pragma("unroll") for (int m = 0; m < 4; ++m) _Pragma("unroll") for (int k = 0; k < 2; ++k) dst[m][k] = *(const PG8_LAS bf16x8*)(lds + PG8_SA(b, h) + aoff + m * 2048 + k * 1024); } while (0)
#define PG8_LDB(dst, b, h) do { _Pragma("unroll") for (int n = 0; n < 2; ++n) _Pragma("unroll") for (int k = 0; k < 2; ++k) dst[n][k] = *(const PG8_LAS bf16x8*)(lds + PG8_SB(b, h) + boff + n * 2048 + k * 1024); } while (0)
#define PG8_MMA(ai, bj, At, Bt) do { __builtin_amdgcn_s_setprio(1); _Pragma("unroll") for (int m = 0; m < 4; ++m) _Pragma("unroll") for (int n = 0; n < 2; ++n) _Pragma("unroll") for (int k = 0; k < 2; ++k) \
        acc[ai][bj][m][n] = __builtin_amdgcn_mfma_f32_16x16x32_bf16(Bt[n][k], At[m][k], acc[ai][bj][m][n], 0, 0, 0); __builtin_amdgcn_s_setprio(0); } while (0)
#define PG8_WAIT_V(n) asm volatile("s_waitcnt vmcnt(" #n ")" ::: "memory")
#define PG8_WAIT_L(n) asm volatile("s_waitcnt lgkmcnt(" #n ")" ::: "memory")
#define PG8_BAR __builtin_amdgcn_s_barrier()
#define PG8_SCHED __builtin_amdgcn_sched_barrier(0)
    Unit cur, nxt; int ui = 0;
    if (!S.next(0, cur)) return;
    f32x4 acc[2][2][4][2];
#pragma unroll
    for (int a = 0; a < 2; ++a)
#pragma unroll
        for (int b = 0; b < 2; ++b)
#pragma unroll
            for (int m = 0; m < 4; ++m)
#pragma unroll
                for (int n = 0; n < 2; ++n) acc[a][b][m][n] = (f32x4){0.f, 0.f, 0.f, 0.f};
    bf16x8 At[4][2], B0[2][2], B1[2][2];
    const char* cA = (const char*)g.A + (size_t)cur.pm * tstep; const char* cB = (const char*)g.Bt + (size_t)cur.pn * tstep;
    S.a_ready(cur);
    if constexpr (SP2) {
        PG8_STAGE(PG8_SB(0, 0), cB, voffB); PG8_STAGE(PG8_SB(0, 1), cB + hstep, voffB); PG8_STAGE(PG8_SA(0, 0), cA, voffA); PG8_STAGE(PG8_SA(0, 1), cA + hstep, voffA);
        if (wr == 1) PG8_BAR;
        PG8_WAIT_V(2); PG8_BAR;
        PG8_STAGE(PG8_SB(1, 0), cB + kstep, voffB); PG8_STAGE(PG8_SA(1, 0), cA + kstep, voffA); PG8_STAGE(PG8_SB(1, 1), cB + hstep + kstep, voffB);
        PG8_WAIT_V(6); PG8_BAR;
    } else {
        PG8_STAGE(PG8_SB(0, 0), cB, voffB); PG8_STAGE(PG8_SA(0, 0), cA, voffA); PG8_STAGE(PG8_SB(0, 1), cB + hstep, voffB); PG8_STAGE(PG8_SA(0, 1), cA + hstep, voffA);
        if (wr == 1) PG8_BAR;
        PG8_WAIT_V(4); PG8_BAR;
        PG8_STAGE(PG8_SB(1, 0), cB + kstep, voffB); PG8_STAGE(PG8_SA(1, 0), cA + kstep, voffA); PG8_STAGE(PG8_SB(1, 1), cB + hstep + kstep, voffB);
        PG8_WAIT_V(6); PG8_BAR;
    }
    for (;;) {
        const bool has_next = S.next(ui + 1, nxt);
        const char* nA = has_next ? (const char*)g.A + (size_t)nxt.pm * tstep : cA; const char* nB = has_next ? (const char*)g.Bt + (size_t)nxt.pn * tstep : cB;
        for (int t = 0; t < nt; t += 2) {
            const bool last = (t == nt - 2);
            const char* a1 = cA + (size_t)(t + 1) * kstep;
            const char* a2 = last ? nA : cA + (size_t)(t + 2) * kstep; const char* b2 = last ? nB : cB + (size_t)(t + 2) * kstep;
            const char* a3 = a2 + kstep; const char* b3 = b2 + kstep;
            if (last && has_next) S.a_ready(nxt);
            if constexpr (SP2) {
            PG8_LDB(B0, 0, 0); PG8_LDB(B1, 0, 1); PG8_SCHED; PG8_LDA(At, 0, 0); PG8_STAGE(PG8_SA(1, 1), a1 + hstep, voffA);
            PG8_WAIT_V(8); PG8_WAIT_L(0); PG8_BAR; PG8_MMA(0, 0, At, B0); PG8_MMA(0, 1, At, B1); PG8_BAR; PG8_SCHED;
            PG8_LDA(At, 0, 1); PG8_STAGE(PG8_SB(0, 0), b2, voffB); PG8_STAGE(PG8_SB(0, 1), b2 + hstep, voffB); PG8_STAGE(PG8_SA(0, 0), a2, voffA);
            PG8_WAIT_V(8); PG8_WAIT_L(0); PG8_BAR; PG8_MMA(1, 0, At, B0); PG8_MMA(1, 1, At, B1); PG8_BAR; PG8_SCHED;
            PG8_LDB(B0, 1, 0); PG8_LDB(B1, 1, 1); PG8_SCHED; PG8_LDA(At, 1, 0); PG8_STAGE(PG8_SA(0, 1), a2 + hstep, voffA);
            PG8_WAIT_V(8); PG8_WAIT_L(0); PG8_BAR; PG8_MMA(0, 0, At, B0); PG8_MMA(0, 1, At, B1); PG8_BAR; PG8_SCHED;
            PG8_LDA(At, 1, 1); PG8_STAGE(PG8_SB(1, 0), b3, voffB); PG8_STAGE(PG8_SB(1, 1), b3 + hstep, voffB); PG8_STAGE(PG8_SA(1, 0), a3, voffA);
            PG8_WAIT_V(8); PG8_WAIT_L(0); PG8_BAR; PG8_MMA(1, 0, At, B0); PG8_MMA(1, 1, At, B1); PG8_BAR; PG8_SCHED;
            } else {
            PG8_LDB(B0, 0, 0); PG8_SCHED; PG8_LDA(At, 0, 0); PG8_STAGE(PG8_SA(1, 1), a1 + hstep, voffA);
            PG8_WAIT_L(8); PG8_BAR; PG8_WAIT_L(0); PG8_MMA(0, 0, At, B0); PG8_BAR; PG8_SCHED;
            PG8_LDB(B1, 0, 1); PG8_STAGE(PG8_SB(0, 0), b2, voffB);
            PG8_BAR; PG8_WAIT_L(0); PG8_MMA(0, 1, At, B1); PG8_BAR;
            PG8_LDA(At, 0, 1); PG8_STAGE(PG8_SA(0, 0), a2, voffA);
            PG8_BAR; PG8_WAIT_L(0); PG8_MMA(1, 0, At, B0); PG8_BAR; PG8_SCHED;
            PG8_STAGE(PG8_SB(0, 1), b2 + hstep, voffB);
            PG8_WAIT_V(6); PG8_BAR; PG8_MMA(1, 1, At, B1); PG8_BAR;
            PG8_LDB(B0, 1, 0); PG8_SCHED; PG8_LDA(At, 1, 0); PG8_STAGE(PG8_SA(0, 1), a2 + hstep, voffA);
            PG8_WAIT_L(8); PG8_BAR; PG8_WAIT_L(0); PG8_MMA(0, 0, At, B0); PG8_BAR; PG8_SCHED;
            PG8_LDB(B1, 1, 1); PG8_STAGE(PG8_SB(1, 0), b3, voffB);
            PG8_BAR; PG8_WAIT_L(0); PG8_MMA(0, 1, At, B1); PG8_BAR;
            PG8_LDA(At, 1, 1); PG8_STAGE(PG8_SA(1, 0), a3, voffA);
            PG8_BAR; PG8_WAIT_L(0); PG8_MMA(1, 0, At, B0); PG8_BAR; PG8_SCHED;
            PG8_STAGE(PG8_SB(1, 1), b3 + hstep, voffB);
            PG8_WAIT_V(6); PG8_BAR; PG8_MMA(1, 1, At, B1); PG8_BAR;
            }
        }
        if constexpr (ALIGN_EPI) { if (wr == 0) PG8_BAR; }
        if constexpr (!Epi::AFTER_DRAIN) { E(acc, cur, wr, wc, fr, fq); S.done(cur); }
        if (!has_next) break;
#pragma unroll
        for (int a = 0; a < 2; ++a)
#pragma unroll
            for (int b = 0; b < 2; ++b)
#pragma unroll
                for (int m = 0; m < 4; ++m)
#pragma unroll
                    for (int n = 0; n < 2; ++n) acc[a][b][m][n] = (f32x4){0.f, 0.f, 0.f, 0.f};
        cur = nxt; cA = nA; cB = nB; ++ui;
        if constexpr (ALIGN_EPI) { if (wr == 1) PG8_BAR; }
    }
    PG8_WAIT_V(0);
    if constexpr (!ALIGN_EPI) { if (wr == 0) PG8_BAR; }
    PG8_BAR;
    if constexpr (Epi::AFTER_DRAIN) { E.fused(acc, cur, wr, wc, fr, fq, lds, wid, lane); S.done(cur); }
#undef PG8_SA
#undef PG8_SB
#undef PG8_STAGE
#undef PG8_LDA
#undef PG8_LDB
#undef PG8_MMA
#undef PG8_WAIT_V
#undef PG8_WAIT_L
#undef PG8_BAR
#undef PG8_SCHED
}
}

#define LAS __attribute__((address_space(3)))
typedef unsigned short bf16;
#define XB_TMO      128
#define XB_XCNT(j)  (256  + 64 * (j))
#define XB_XSUB(j)  (1280 + 64 * (j))
#define XB_XGEN(j)  (2304 + 64 * (j))
#define XB_TOP      3328
#define XB_TOPGEN   3392
#define XCD_BAR_WORDS 3456
#define XB_SPIN_CAP (1u << 18)

__device__ __forceinline__ unsigned xb_ld(unsigned* p)              { return __hip_atomic_load(p, __ATOMIC_RELAXED, __HIP_MEMORY_SCOPE_AGENT); }
__device__ __forceinline__ unsigned xb_add(unsigned* p, unsigned v) { return __hip_atomic_fetch_add(p, v, __ATOMIC_RELAXED, __HIP_MEMORY_SCOPE_AGENT); }
__device__ __forceinline__ unsigned xb_xcc_id() { return (unsigned)__builtin_amdgcn_s_getreg((3 << 11) | 20) & 0xFu; }
#define XB_SPIN(cond, bar) do { unsigned _sp = 0; while (cond) { __builtin_amdgcn_s_sleep(1); \
    if ((++_sp & 255u) == 0u) { if (xb_ld(&(bar)[XB_TMO])) break; if (_sp > XB_SPIN_CAP) { atomicAdd(&(bar)[XB_TMO], 1u); break; } } } } while (0)

struct XcdBarrier {
    unsigned* bar; unsigned x;
    volatile LAS unsigned* st;
};

__device__ __forceinline__ XcdBarrier xcd_barrier_post(unsigned* bar, volatile LAS unsigned* st, int tid) {
    XcdBarrier b; b.bar = bar; b.x = xb_xcc_id(); b.st = st;
    if (tid == 0) (void)xb_add(&bar[XB_XCNT(b.x)], 1u);
    return b;
}
__device__ __forceinline__ void xcd_barrier_complete(unsigned* bar, unsigned x, unsigned& nloc, unsigned& nx) {
    const unsigned G = gridDim.x * gridDim.y * gridDim.z;
    unsigned sum, cnt, mine, sp = 0u;
    for (;;) {
        sum = 0u; cnt = 0u; mine = 0u;
#pragma unroll
        for (unsigned j = 0; j < 16; ++j) { const unsigned c = xb_ld(&bar[XB_XCNT(j)]); sum += c; cnt += (c > 0u) ? 1u : 0u; mine = (j == x) ? c : mine; }
        if (sum == G) break;
        __builtin_amdgcn_s_sleep(1);
        if ((++sp & 255u) == 0u) { if (xb_ld(&bar[XB_TMO])) break; if (sp > XB_SPIN_CAP) { atomicAdd(&bar[XB_TMO], 1u); break; } }
    }
    nloc = mine > 0u ? mine : 1u; nx = cnt > 0u ? cnt : 1u;
}

__device__ __forceinline__ void xcd_barrier(const XcdBarrier& b, int wv) {
    const int tid = wv * 64 + lane_id_opaque();
    asm volatile("s_waitcnt vmcnt(0)" ::: "memory");
    __syncthreads();
    if (tid == 0) {
        unsigned* bar = b.bar;
        __builtin_amdgcn_s_waitcnt(0);
        unsigned nloc = b.st[0], nx = b.st[1];
        if (nloc == 0u) { xcd_barrier_complete(bar, b.x, nloc, nx); b.st[0] = nloc; b.st[1] = nx; }
        const unsigned old = xb_add(&bar[XB_XSUB(b.x)], 1u);
        const unsigned gen = old / nloc;
        if (old + 1u == (gen + 1u) * nloc) {
            __builtin_amdgcn_fence(__ATOMIC_RELEASE, "agent");
            asm volatile("s_waitcnt vmcnt(0)" ::: "memory");
            const unsigned og = xb_add(&bar[XB_TOP], 1u);
            const unsigned tg = og / nx;
            if (og + 1u == (tg + 1u) * nx) xb_add(&bar[XB_TOPGEN], 1u);
            else XB_SPIN(xb_ld(&bar[XB_TOPGEN]) == tg, bar);
            __builtin_amdgcn_fence(__ATOMIC_ACQUIRE, "agent");
            xb_add(&bar[XB_XGEN(b.x)], 1u);
            asm volatile("s_waitcnt vmcnt(0)" ::: "memory");
        } else {
            XB_SPIN(xb_ld(&bar[XB_XGEN(b.x)]) == gen, bar);
            __builtin_amdgcn_fence(__ATOMIC_ACQUIRE, "agent");
            asm volatile("s_waitcnt vmcnt(0)" ::: "memory");
        }
    }
    __syncthreads();
}


#define GAS __attribute__((address_space(1)))
constexpr int NWAVES = 8, NTHREADS = 512;
constexpr int RING_BYTES = 131072, LDS_BYTES = 163840, MISC_OFF = LDS_BYTES - 512;

__device__ __forceinline__ float bf2f(unsigned short b) { return __uint_as_float((unsigned)b << 16); }
__device__ __forceinline__ unsigned f2bf(float f) { unsigned u = __float_as_uint(f); return (u + 0x7fffu + ((u >> 16) & 1u)) >> 16; }
__device__ __forceinline__ unsigned pk2(float lo, float hi) { return f2bf(lo) | (f2bf(hi) << 16); }
__device__ __forceinline__ float wave_sum(float v, int lane) {
#pragma unroll
    for (int o = 1; o < 64; o <<= 1) v += shx(v, o, lane);
    return v;
}
__device__ __forceinline__ float wave_max(float v, int lane) {
#pragma unroll
    for (int o = 1; o < 64; o <<= 1) v = fmaxf(v, shx(v, o, lane));
    return v;
}

constexpr size_t al256(size_t x) { return (x + 255) & ~(size_t)255; }
constexpr size_t O_CTL = 0;
constexpr size_t O_WT_IN = O_CTL + (1 << 16);
constexpr size_t O_WT_OUT = O_WT_IN + al256((size_t)DEPTH * NINP * DM * 2);
constexpr size_t O_WT_MEM = O_WT_OUT + al256((size_t)DEPTH * DM * DM * 2);
constexpr size_t O_XB = O_WT_MEM + al256((size_t)DEPTH * 512 * DM * 2);
constexpr size_t O_QA = O_XB + al256((size_t)T * DM * 2);
constexpr size_t O_KA = O_QA + al256((size_t)T * 512 * 2);
constexpr size_t O_VA = O_KA + al256((size_t)T * 512 * 2);
constexpr size_t O_CB = O_VA + al256((size_t)T * 512 * 2);
constexpr size_t O_QBKB = O_CB + al256((size_t)T * 1024 * 2);
constexpr size_t O_VB = O_QBKB + al256((size_t)T * 256 * 2);
constexpr size_t O_QM = O_VB + al256((size_t)T * 256 * 2);
constexpr size_t O_SSQ = O_QM + al256((size_t)T * 256 * 2);
constexpr size_t O_LA = O_SSQ + al256((size_t)T * 16 * 4);
constexpr size_t O_KMP = O_LA + al256((size_t)T * 128 * 4);
constexpr size_t O_LISTS = O_KMP + al256((size_t)BATCH * 8 * NB * 2 * 64 * 4);
constexpr size_t O_GCNT = O_LISTS + al256((size_t)BATCH * 8 * 256 * 2016 * 2);
constexpr size_t O_PARTO = O_GCNT + al256(1024 * 4);
constexpr size_t O_PARTL = O_PARTO + al256((size_t)T * 8 * 3 * 64 * 2);
constexpr size_t O_MEMK = O_PARTL + al256((size_t)T * 8 * 4 * 4);
constexpr size_t O_MEMV = O_MEMK + al256((size_t)DEPTH * TM * 256 * 2);
constexpr size_t O_MEMBF = O_MEMV + al256((size_t)DEPTH * TM * 256 * 2);
constexpr size_t O_SSQM = O_MEMBF + al256((size_t)TM * DM * 2);
constexpr size_t O_U = O_SSQM + al256((size_t)TM * 16 * 4);
constexpr size_t O_SST = O_U + al256((size_t)BATCH * 4 * NCH * 2048 * 4);
constexpr size_t O_DC = O_SST + al256((size_t)BATCH * 4 * NCH * 2048 * 4);
constexpr size_t O_PMASK = O_DC + al256((size_t)BATCH * 4 * NCH * 32 * 4);
constexpr size_t WS_END = O_PMASK + al256((size_t)T * 8);
static_assert(WS_END <= (size_t)536870912, "workspace map exceeds 4 x largest tensor");

struct KArgs {
    const float *x, *mem, *g_pre, *w_in, *g_q_moba, *g_k_moba, *w_gate_up, *b_gate_up, *g_gla_out, *g_mem, *w_mem_kv, *g_q_mem, *g_k_mem, *w_out;
    float* out;
    unsigned char* ws;
    int ph_lo, ph_hi;
};
struct Args {
    const __attribute__((address_space(4))) KArgs* kp;
    __device__ __forceinline__ const float* x() const { return kp->x; }
    __device__ __forceinline__ const float* mem() const { return kp->mem; }
    __device__ __forceinline__ const float* g_pre() const { return kp->g_pre; }
    __device__ __forceinline__ const float* w_in() const { return kp->w_in; }
    __device__ __forceinline__ const float* g_q_moba() const { return kp->g_q_moba; }
    __device__ __forceinline__ const float* g_k_moba() const { return kp->g_k_moba; }
    __device__ __forceinline__ const float* w_gate_up() const { return kp->w_gate_up; }
    __device__ __forceinline__ const float* b_gate_up() const { return kp->b_gate_up; }
    __device__ __forceinline__ const float* g_gla_out() const { return kp->g_gla_out; }
    __device__ __forceinline__ const float* g_mem() const { return kp->g_mem; }
    __device__ __forceinline__ const float* w_mem_kv() const { return kp->w_mem_kv; }
    __device__ __forceinline__ const float* g_q_mem() const { return kp->g_q_mem; }
    __device__ __forceinline__ const float* g_k_mem() const { return kp->g_k_mem; }
    __device__ __forceinline__ const float* w_out() const { return kp->w_out; }
    __device__ __forceinline__ float* out() const { return kp->out; }
    __device__ __forceinline__ unsigned char* ws() const { return kp->ws; }
    __device__ __forceinline__ unsigned* ctl() const { return (unsigned*)(kp->ws + O_CTL); }
    __device__ __forceinline__ bf16* wt_in() const { return (bf16*)(kp->ws + O_WT_IN); }
    __device__ __forceinline__ bf16* wt_out() const { return (bf16*)(kp->ws + O_WT_OUT); }
    __device__ __forceinline__ bf16* wt_mem() const { return (bf16*)(kp->ws + O_WT_MEM); }
    __device__ __forceinline__ bf16* xb() const { return (bf16*)(kp->ws + O_XB); }
    __device__ __forceinline__ bf16* qa() const { return (bf16*)(kp->ws + O_QA); }
    __device__ __forceinline__ bf16* ka() const { return (bf16*)(kp->ws + O_KA); }
    __device__ __forceinline__ bf16* va() const { return (bf16*)(kp->ws + O_VA); }
    __device__ __forceinline__ bf16* cb() const { return (bf16*)(kp->ws + O_CB); }
    __device__ __forceinline__ bf16* qbkb() const { return (bf16*)(kp->ws + O_QBKB); }
    __device__ __forceinline__ bf16* vb() const { return (bf16*)(kp->ws + O_VB); }
    __device__ __forceinline__ bf16* qm() const { return (bf16*)(kp->ws + O_QM); }
    __device__ __forceinline__ float* ssq() const { return (float*)(kp->ws + O_SSQ); }
    __device__ __forceinline__ float* la() const { return (float*)(kp->ws + O_LA); }
    __device__ __forceinline__ float* kmp() const { return (float*)(kp->ws + O_KMP); }
    __device__ __forceinline__ unsigned short* lists() const { return (unsigned short*)(kp->ws + O_LISTS); }
    __device__ __forceinline__ unsigned* gcnt() const { return (unsigned*)(kp->ws + O_GCNT); }
    __device__ __forceinline__ bf16* partO() const { return (bf16*)(kp->ws + O_PARTO); }
    __device__ __forceinline__ float* partL() const { return (float*)(kp->ws + O_PARTL); }
    __device__ __forceinline__ bf16* memk() const { return (bf16*)(kp->ws + O_MEMK); }
    __device__ __forceinline__ bf16* memv() const { return (bf16*)(kp->ws + O_MEMV); }
    __device__ __forceinline__ bf16* membf() const { return (bf16*)(kp->ws + O_MEMBF); }
    __device__ __forceinline__ float* ssqm() const { return (float*)(kp->ws + O_SSQM); }
    __device__ __forceinline__ float* U() const { return (float*)(kp->ws + O_U); }
    __device__ __forceinline__ float* Sst() const { return (float*)(kp->ws + O_SST); }
    __device__ __forceinline__ float* Dc() const { return (float*)(kp->ws + O_DC); }
    __device__ __forceinline__ unsigned char* pmask() const { return (unsigned char*)(kp->ws + O_PMASK); }
};


typedef short s16x8 __attribute__((ext_vector_type(8)));
typedef short s16x4 __attribute__((ext_vector_type(4)));
typedef float f32x16 __attribute__((ext_vector_type(16)));
typedef float f32x2_t __attribute__((ext_vector_type(2)));
typedef __bf16 bf16x2_t __attribute__((ext_vector_type(2)));
constexpr int KIMG_CH = 4112;
constexpr int VIMG_DH = 16448;
constexpr int KIMG_OFF = 0, VIMG_OFF = 8 * KIMG_CH, ATT_LDS_END = VIMG_OFF + 2 * VIMG_DH;
constexpr int LIST_PER_BH = 256 * 2016;
__device__ __forceinline__ int list_off(int j) { return 256 * (63 * j - (j * (j - 1)) / 2); }
__device__ __forceinline__ int crow(int r, int hi) { return (r & 3) + 8 * (r >> 2) + 4 * hi; }
__device__ __forceinline__ unsigned cvtpk(float lo, float hi) { f32x2_t v = {lo, hi}; bf16x2_t b = __builtin_convertvector(v, bf16x2_t); return __builtin_bit_cast(unsigned, b); }
__device__ __forceinline__ s16x4 vtr(const LAS unsigned char* p) { typedef short v4i16_t __attribute__((ext_vector_type(4))); return __builtin_bit_cast(s16x4, __builtin_amdgcn_ds_read_tr16_b64_v4i16((LAS v4i16_t*)p)); }

struct KVRegs { uint4 k[4], v[4]; };
__device__ __forceinline__ void kv_issue(KVRegs& r, const bf16* kg, const bf16* vg, int stride, int tid) {
    const int c = tid & 7, k0 = tid >> 3;
#pragma unroll
    for (int i = 0; i < 4; ++i) { const size_t o = (size_t)(k0 + 64 * i) * stride + c * 8; r.k[i] = *(const uint4*)(kg + o); r.v[i] = *(const uint4*)(vg + o); }
}
__device__ __forceinline__ void kv_commit(LAS unsigned char* L, const KVRegs& r, int tid) {
    const int c = tid & 7, k0 = tid >> 3;
#pragma unroll
    for (int i = 0; i < 4; ++i) { const int key = k0 + 64 * i;
        *(LAS pg8::u32x4*)(L + KIMG_OFF + c * KIMG_CH + key * 16) = (pg8::u32x4){r.k[i].x, r.k[i].y, r.k[i].z, r.k[i].w};
        *(LAS pg8::u32x4*)(L + VIMG_OFF + (c >> 2) * VIMG_DH + key * 64 + (c & 3) * 16) = (pg8::u32x4){r.v[i].x, r.v[i].y, r.v[i].z, r.v[i].w}; }
}
__device__ __forceinline__ void load_kv_tiles(LAS unsigned char* L, const bf16* kg, const bf16* vg, int stride, int tid) { KVRegs r; kv_issue(r, kg, vg, stride, tid); kv_commit(L, r, tid); }
__device__ __forceinline__ void attn_tiles(const LAS unsigned char* L, const s16x8 (&qf)[4], f32x16& cin, float cstep, int kt0, int kt1, int mask_kt, int r32, int hi, int lane, f32x16 (&o)[2], float& lsum) {
    const LAS unsigned char* kp = L + KIMG_OFF + hi * KIMG_CH + r32 * 16;
    const LAS unsigned char* vp = L + VIMG_OFF + ((lane >> 4) & 1) * 32 + (lane & 3) * 8 + (4 * hi + ((lane & 15) >> 2)) * 64;
    for (int kt = kt0; kt < kt1; ++kt) {
        f32x16 s = cin;
#pragma unroll
        for (int d0 = 0; d0 < 4; ++d0) { const s16x8 kf = *(const LAS s16x8*)(kp + 2 * d0 * KIMG_CH + kt * 512); s = __builtin_amdgcn_mfma_f32_32x32x16_bf16(kf, qf[d0], s, 0, 0, 0); }
        if (kt == mask_kt) {
#pragma unroll
            for (int r = 0; r < 16; ++r) if (crow(r, hi) > r32) s[r] = -INFINITY;
        }
        float ps = 0.f;
#pragma unroll
        for (int r = 0; r < 16; ++r) { s[r] = __builtin_amdgcn_exp2f(s[r]); ps += s[r]; }
        lsum += ps;
        union { unsigned w[4]; s16x8 v; } p0, p1;
#pragma unroll
        for (int e = 0; e < 4; ++e) { p0.w[e] = cvtpk(s[2 * e], s[2 * e + 1]); p1.w[e] = cvtpk(s[8 + 2 * e], s[8 + 2 * e + 1]); }
#pragma unroll
        for (int dh = 0; dh < 2; ++dh) {
            const LAS unsigned char* vq = vp + dh * VIMG_DH + kt * 2048;
            const s16x4 a0 = vtr(vq), a1 = vtr(vq + 512), a2 = vtr(vq + 1024), a3 = vtr(vq + 1536);
            const s16x8 f0 = {a0[0], a0[1], a0[2], a0[3], a1[0], a1[1], a1[2], a1[3]}, f1 = {a2[0], a2[1], a2[2], a2[3], a3[0], a3[1], a3[2], a3[3]};
            o[dh] = __builtin_amdgcn_mfma_f32_32x32x16_bf16(f0, p0.v, o[dh], 0, 0, 0);
            o[dh] = __builtin_amdgcn_mfma_f32_32x32x16_bf16(f1, p1.v, o[dh], 0, 0, 0);
        }
#pragma unroll
        for (int r = 0; r < 16; ++r) cin[r] += cstep;
    }
}
__device__ __forceinline__ void load_qfrag(s16x8 (&qf)[4], const bf16* qrow, int hi) {
#pragma unroll
    for (int d0 = 0; d0 < 4; ++d0) qf[d0] = *(const s16x8*)(qrow + 16 * d0 + 8 * hi);
}
__device__ __forceinline__ float softmax_ref(const float* gq, const float* gk) {
    const int lane = lane_id_opaque();
    const float a = wave_max(fabsf(gq[lane]), lane), b = wave_max(fabsf(gk[lane]), lane);
    return 64.f * QSCALE * a * b * 1.01f;
}

__device__ __forceinline__ float zero_thr(float Mref) { return 104.f + 2.f * Mref * 0.6931471805599453f + 1.f; }

__device__ __forceinline__ size_t hm_off(int b, int h, int t) { return (((size_t)(b * 8 + h)) * SEQ + t) * 64; }
struct RouteRaw { s16x8 q[4]; float km[16]; };
__device__ __forceinline__ void route_decode(int p, int& bh, int& i) { i = 63 - (p >> 4); bh = p & 15; }
__device__ __forceinline__ void route_raw_issue(const Args& a, RouteRaw& r, int unit, int tid) {
    int bh, i; route_decode(unit, bh, i); const int b = bh >> 3, h = bh & 7;
    load_qfrag(r.q, a.qa() + hm_off(b, h, i * 256 + (tid >> 6) * 32 + (tid & 31)), (tid >> 5) & 1);
#pragma unroll
    for (int k = 0; k < 8; ++k) { const int e = tid + NTHREADS * k;
        if (e < i * 64) { const float* p = a.kmp() + (((size_t)bh * 64 + (e >> 6)) * 2) * 64 + (e & 63); r.km[2 * k] = p[0]; r.km[2 * k + 1] = p[64]; } }
}
__device__ __forceinline__ void top3_insert(float s, int j, float& v0, float& v1, float& v2, int& i0, int& i1, int& i2) {
    const bool g0 = s > v0, g1 = s > v1, g2 = s > v2;
    v2 = g1 ? v1 : (g2 ? s : v2); i2 = g1 ? i1 : (g2 ? j : i2);
    v1 = g0 ? v0 : (g1 ? s : v1); i1 = g0 ? i0 : (g1 ? j : i1);
    v0 = g0 ? s : v0; i0 = g0 ? j : i0;
}
__device__ __forceinline__ void moba_route_phase(const Args& a, LAS unsigned char* L, int wv, int bid, int G, float zthr, int dry) {
    constexpr int KMP = 64 * 16 + 16;
    LAS unsigned short* kmh = (LAS unsigned short*)L; LAS unsigned short* kml = (LAS unsigned short*)(L + 8 * KMP);
    LAS int* cnt = (LAS int*)(L + 16 * KMP);
    LAS int* basep = cnt + 64;
    const int NU = BATCH * 8 * 63;
    int rnd = 0;
    int unit = bid;
    RouteRaw R;
    if (unit < NU) route_raw_issue(a, R, unit, wv * 64 + lane_id_opaque());
    while (unit < NU) {
        const int tid = wv * 64 + lane_id_opaque(), lane = tid & 63, r32 = lane & 31, hi = lane >> 5;
        int bh, i; route_decode(unit, bh, i); const int b = bh >> 3, h = bh & 7;
#pragma unroll
        for (int k = 0; k < 8; ++k) { const int e = tid + NTHREADS * k; if (e < i * 64) { const int j = e >> 6, d = e & 63; const float v = R.km[2 * k] + R.km[2 * k + 1];
                const unsigned hb = f2bf(v); const float vh = __uint_as_float(hb << 16); const unsigned lb = f2bf(v - vh);
                const int off = (d >> 3) * (KMP / 2) + j * 8 + (d & 7); kmh[off] = (unsigned short)hb; kml[off] = (unsigned short)lb; } }
        if (tid < 64) cnt[tid] = 0;
        const int t = i * 256 + wv * 32 + r32;
        s16x8 qf[4];
#pragma unroll
        for (int c = 0; c < 4; ++c) qf[c] = R.q[c];
        ++rnd;
        const int nunit = rnd * G + ((rnd & 1) ? (G - 1 - bid) : bid);
        if (nunit < NU) route_raw_issue(a, R, nunit, tid);
        __syncthreads();
        float v0 = -INFINITY, v1 = -INFINITY, v2 = -INFINITY; int i0 = 1 << 20, i1 = 1 << 20, i2 = 1 << 20;
        const int njt = i > 32 ? 2 : 1;
        for (int jt = 0; jt < njt; ++jt) {
            f32x16 g;
#pragma unroll
            for (int r = 0; r < 16; ++r) g[r] = 0.f;
            const LAS unsigned char* kh = (const LAS unsigned char*)kmh + hi * KMP + (32 * jt + r32) * 16;
            const LAS unsigned char* kl = (const LAS unsigned char*)kml + hi * KMP + (32 * jt + r32) * 16;
#pragma unroll
            for (int ks = 0; ks < 4; ++ks) {
                g = __builtin_amdgcn_mfma_f32_32x32x16_bf16(*(const LAS s16x8*)(kh + 2 * ks * KMP), qf[ks], g, 0, 0, 0);
                g = __builtin_amdgcn_mfma_f32_32x32x16_bf16(*(const LAS s16x8*)(kl + 2 * ks * KMP), qf[ks], g, 0, 0, 0);
            }
#pragma unroll
            for (int r = 0; r < 16; ++r) { const int j = 32 * jt + crow(r, hi); const float sv = (j < i) ? g[r] : -INFINITY; top3_insert(sv, j, v0, v1, v2, i0, i1, i2); }
        }
        {
            const auto x0 = __builtin_amdgcn_permlane32_swap(__float_as_uint(v0), __float_as_uint(v0), false, false), x1 = __builtin_amdgcn_permlane32_swap(__float_as_uint(v1), __float_as_uint(v1), false, false), x2 = __builtin_amdgcn_permlane32_swap(__float_as_uint(v2), __float_as_uint(v2), false, false);
            const auto y0 = __builtin_amdgcn_permlane32_swap((unsigned)i0, (unsigned)i0, false, false), y1 = __builtin_amdgcn_permlane32_swap((unsigned)i1, (unsigned)i1, false, false), y2 = __builtin_amdgcn_permlane32_swap((unsigned)i2, (unsigned)i2, false, false);
            const float pv[3] = {__uint_as_float(hi ? x0[0] : x0[1]), __uint_as_float(hi ? x1[0] : x1[1]), __uint_as_float(hi ? x2[0] : x2[1])};
            const int pi[3] = {(int)(hi ? y0[0] : y0[1]), (int)(hi ? y1[0] : y1[1]), (int)(hi ? y2[0] : y2[1])};
#pragma unroll
            for (int c = 0; c < 3; ++c) {
                const float sv = pv[c]; const int j = pi[c];
                const bool g0 = sv > v0 || (sv == v0 && j < i0), g1 = sv > v1 || (sv == v1 && j < i1), g2 = sv > v2 || (sv == v2 && j < i2);
                v2 = g1 ? v1 : (g2 ? sv : v2); i2 = g1 ? i1 : (g2 ? j : i2);
                v1 = g0 ? v0 : (g1 ? sv : v1); i1 = g0 ? i0 : (g1 ? j : i1);
                v0 = g0 ? sv : v0; i0 = g0 ? j : i0;
            }
        }
        int rk0 = 0, rk1 = 0, rk2 = 0; const int nsel = i < 3 ? i : 3; bool k0 = false, k1 = false, k2 = false;
        if (hi == 0) {
            if (dry) asm volatile("" :: "v"(i0), "v"(i1), "v"(i2));
            const float slope = exp2f(-(float)(h + 1));
            k0 = nsel > 0 && !(slope * (float)(t - 256 * i0 - 255) > zthr);
            k1 = nsel > 1 && !(slope * (float)(t - 256 * i1 - 255) > zthr);
            k2 = nsel > 2 && !(slope * (float)(t - 256 * i2 - 255) > zthr);
            if (!dry) a.pmask()[((size_t)(b * SEQ + t)) * 8 + h] = (unsigned char)((k0 ? 1 : 0) | (k1 ? 2 : 0) | (k2 ? 4 : 0));
            if (!dry && k0) rk0 = __hip_atomic_fetch_add(cnt + i0, 1, __ATOMIC_RELAXED, __HIP_MEMORY_SCOPE_WORKGROUP);
            if (!dry && k1) rk1 = __hip_atomic_fetch_add(cnt + i1, 1, __ATOMIC_RELAXED, __HIP_MEMORY_SCOPE_WORKGROUP);
            if (!dry && k2) rk2 = __hip_atomic_fetch_add(cnt + i2, 1, __ATOMIC_RELAXED, __HIP_MEMORY_SCOPE_WORKGROUP);
        }
        __syncthreads();
        if (!dry && tid < i) { const int c = cnt[tid]; basep[tid] = c > 0 ? (int)atomicAdd(a.gcnt() + bh * 64 + tid, (unsigned)c) : 0; }
        __syncthreads();
        if (!dry && hi == 0) {
            unsigned short* lst = a.lists() + (size_t)bh * LIST_PER_BH;
            if (k0) lst[list_off(i0) + basep[i0] + rk0] = (unsigned short)(t | (0 << 14));
            if (k1) lst[list_off(i1) + basep[i1] + rk1] = (unsigned short)(t | (1 << 14));
            if (k2) lst[list_off(i2) + basep[i2] + rk2] = (unsigned short)(t | (2 << 14));
        }
        unit = nunit;
        __syncthreads();
    }
}

__device__ __forceinline__ void moba_pairs_phase(const Args& a, int l, LAS unsigned char* L, int wv, int bid, int G, int dry = 0) {
    const int tid = wv * 64 + lane_id_opaque(), lane = tid & 63, wid = wv;
    LAS int* pre = (LAS int*)(L + ATT_LDS_END);
    LAS int* cntl = pre + 1028;
    LAS int* wtot = cntl + 1024;
    {
        const int c0 = (int)a.gcnt()[2 * tid], c1 = (int)a.gcnt()[2 * tid + 1];
        cntl[2 * tid] = c0; cntl[2 * tid + 1] = c1;
        const int n0 = (c0 + 255) >> 8, n1 = (c1 + 255) >> 8;
        int s = n0 + n1;
#pragma unroll
        for (int o = 1; o < 64; o <<= 1) { const int v = shup_i(s, o, lane); if (lane >= o) s += v; }
        if (lane == 63) wtot[wid] = s;
        __syncthreads();
        int wb = 0;
        for (int w = 0; w < wid; ++w) wb += wtot[w];
        const int excl = wb + s - (n0 + n1);
        pre[2 * tid] = excl; pre[2 * tid + 1] = excl + n0;
        if (tid == NTHREADS - 1) pre[1024] = excl + n0 + n1;
        __syncthreads();
    }
    const int total = pre[1024];
    LAS int* itab = wtot + 8;
    if (tid < 64) { const int it = bid + tid * G; int lo = 0, hh = 1023;
        if (it < total) { while (lo < hh) { const int mid = (lo + hh + 1) >> 1; if (pre[mid] <= it) lo = mid; else hh = mid - 1; } }
        itab[tid] = lo; }
    __syncthreads();
    const float Mref = softmax_ref(a.g_q_moba() + l * 64, a.g_k_moba() + l * 64);
    KVRegs kvr; s16x8 qf[4], qfn[4]; int tq = 0, slot = 0, cb_ = 0, ch_ = 0, cj_ = 0; bool valid = false;
    int ntq = 0, nslot = 0, nb_ = 0, nh_ = 0, nj_ = 0; bool nvalid = false; unsigned ne = 0;
    int item = bid;
#define PAIR_META(IT, B_, H_, J_, VALID_, E_) do { \
        const int tid2 = wv * 64 + lane_id_opaque(), lane2 = tid2 & 63; \
        const int bhj = itab[((IT) - bid) / G], chunk = (IT) - pre[bhj], n = cntl[bhj], bh = bhj >> 6; \
        J_ = bhj & 63; B_ = bh >> 3; H_ = bh & 7; \
        kv_issue(kvr, a.ka() + hm_off(B_, H_, J_ * 256), a.va() + hm_off(B_, H_, J_ * 256), 64, tid2); \
        int idx = chunk * 256 + wv * 32 + (lane2 & 31); VALID_ = idx < n; if (!VALID_) idx = n - 1; \
        E_ = a.lists()[(size_t)bh * LIST_PER_BH + list_off(J_) + idx]; } while (0)
    if (item < total) {
        unsigned e0; PAIR_META(item, cb_, ch_, cj_, valid, e0);
        tq = e0 & 0x3fff; slot = e0 >> 14;
        load_qfrag(qf, a.qa() + hm_off(cb_, ch_, tq), (lane_id_opaque() >> 5));
    }
    while (item < total) {
        const int tid2 = wv * 64 + lane_id_opaque(), lane = tid2 & 63, r32 = lane & 31, hi = lane >> 5;
        const int nitem = item + G; const bool has_next = nitem < total;
        __syncthreads();
        kv_commit(L, kvr, tid2);
        if (has_next) PAIR_META(nitem, nb_, nh_, nj_, nvalid, ne);
        __syncthreads();
        const size_t tok = (size_t)cb_ * SEQ + tq;
        const float slope2 = exp2f(-(float)(ch_ + 1)) * LOG2E;
        f32x16 cin;
#pragma unroll
        for (int r = 0; r < 16; ++r) cin[r] = fmaf(-slope2, (float)(tq - 256 * cj_ - crow(r, hi)), -Mref);
        f32x16 o[2]; float lsum = 0.f;
#pragma unroll
        for (int r = 0; r < 16; ++r) { o[0][r] = 0.f; o[1][r] = 0.f; }
        attn_tiles(L, qf, cin, 32.f * slope2, 0, 4, -1, r32, hi, lane, o, lsum);
        if (has_next) { ntq = ne & 0x3fff; nslot = ne >> 14; load_qfrag(qfn, a.qa() + hm_off(nb_, nh_, ntq), hi); }
        attn_tiles(L, qf, cin, 32.f * slope2, 4, 8, -1, r32, hi, lane, o, lsum);
        lsum = red32(lsum);
        if (dry) asm volatile("" :: "v"(o[0]), "v"(o[1]), "v"(lsum));
        if (valid && !dry) {
            const size_t pidx = (tok * 8 + ch_) * 3 + slot;
            bf16* po = a.partO() + pidx * 64;
#pragma unroll
            for (int dh = 0; dh < 2; ++dh)
#pragma unroll
                for (int g2 = 0; g2 < 2; ++g2) { uint4 w;
                    w.x = cvtpk(o[dh][8 * g2], o[dh][8 * g2 + 1]); w.y = cvtpk(o[dh][8 * g2 + 2], o[dh][8 * g2 + 3]); w.z = cvtpk(o[dh][8 * g2 + 4], o[dh][8 * g2 + 5]); w.w = cvtpk(o[dh][8 * g2 + 6], o[dh][8 * g2 + 7]);
                    *(uint4*)(po + 32 * hi + 16 * dh + 8 * g2) = w; }
            if (hi == 0) a.partL()[(tok * 8 + ch_) * 4 + slot] = lsum;
        }
#pragma unroll
        for (int d0 = 0; d0 < 4; ++d0) qf[d0] = qfn[d0];
        tq = ntq; slot = nslot; cb_ = nb_; ch_ = nh_; cj_ = nj_; valid = nvalid;
        item = nitem;
    }
#undef PAIR_META
    __syncthreads();
}

__device__ __forceinline__ void row_load_pieces(const bf16* row, int hi, uint2 (&pc)[8]) {
#pragma unroll
    for (int k = 0; k < 4; ++k) {
        const uint4 w = *(const uint4*)(row + 8 * (2 * k + hi));
        const auto s0 = __builtin_amdgcn_permlane32_swap(w.x, w.z, false, false), s1 = __builtin_amdgcn_permlane32_swap(w.y, w.w, false, false);
        pc[2 * k] = make_uint2(s0[0], s1[0]); pc[2 * k + 1] = make_uint2(s0[1], s1[1]);
    }
}
__device__ __forceinline__ void row_store_pieces(bf16* row, int hi, const uint2 (&pc)[8]) {
#pragma unroll
    for (int k = 0; k < 4; ++k) {
        const auto s0 = __builtin_amdgcn_permlane32_swap(pc[2 * k].x, pc[2 * k + 1].x, false, false), s1 = __builtin_amdgcn_permlane32_swap(pc[2 * k].y, pc[2 * k + 1].y, false, false);
        *(uint4*)(row + 8 * (2 * k + hi)) = make_uint4(s0[0], s1[0], s0[1], s1[1]);
    }
}
__device__ __forceinline__ void own_tile(const Args& a, const LAS unsigned char* Lt, const s16x8 (&qf)[4], unsigned pm, int b, int h, int i, int qt, int lane, float Mref, int dry) {
    const int r32 = lane & 31, hi = lane >> 5;
    const size_t tok = (size_t)b * SEQ + i * 256 + qt * 32 + r32;
    const float slope2 = exp2f(-(float)(h + 1)) * LOG2E;
    f32x16 cin;
#pragma unroll
    for (int r = 0; r < 16; ++r) cin[r] = fmaf(-slope2, (float)(32 * qt + r32 - crow(r, hi)), -Mref);
    f32x16 o[2]; float lsum = 0.f;
#pragma unroll
    for (int r = 0; r < 16; ++r) { o[0][r] = 0.f; o[1][r] = 0.f; }
    attn_tiles(Lt, qf, cin, 32.f * slope2, 0, qt + 1, qt, r32, hi, lane, o, lsum);
    lsum = red32(lsum);
    bf16* cp = a.cb() + tok * 1024 + h * 64;
    uint4 gw[4];
#pragma unroll
    for (int k = 0; k < 4; ++k) gw[k] = *(const uint4*)(cp + 8 * (2 * k + hi));
    if (pm) { const pg8::f32x4 pl = *(const pg8::f32x4*)(a.partL() + (tok * 8 + h) * 4);
        lsum += ((pm & 1u) ? pl[0] : 0.f) + ((pm & 2u) ? pl[1] : 0.f) + ((pm & 4u) ? pl[2] : 0.f); }
    for (int s = 0; s < 3; ++s) {
        if (!((pm >> s) & 1u)) continue;
        const size_t pidx = (tok * 8 + h) * 3 + s;
        const bf16* po = a.partO() + pidx * 64;
#pragma unroll
        for (int dh = 0; dh < 2; ++dh)
#pragma unroll
            for (int g2 = 0; g2 < 2; ++g2) { const uint4 w = *(const uint4*)(po + 32 * hi + 16 * dh + 8 * g2); const unsigned ww[4] = {w.x, w.y, w.z, w.w};
#pragma unroll
                for (int e = 0; e < 4; ++e) { o[dh][8 * g2 + 2 * e] += __uint_as_float(ww[e] << 16); o[dh][8 * g2 + 2 * e + 1] += __uint_as_float(ww[e] & 0xffff0000u); } }
    }
    const float inv = __builtin_amdgcn_rcpf(lsum);
    uint2 gt[8];
#pragma unroll
    for (int k = 0; k < 4; ++k) {
        const auto s0 = __builtin_amdgcn_permlane32_swap(gw[k].x, gw[k].z, false, false), s1 = __builtin_amdgcn_permlane32_swap(gw[k].y, gw[k].w, false, false);
        gt[2 * k] = make_uint2(s0[0], s1[0]); gt[2 * k + 1] = make_uint2(s0[1], s1[1]); }
#pragma unroll
    for (int c = 0; c < 8; ++c) { const int dh = c >> 2, g4 = c & 3; uint2 w;
        w.x = cvtpk(o[dh][4 * g4] * inv * __uint_as_float(gt[c].x << 16), o[dh][4 * g4 + 1] * inv * __uint_as_float(gt[c].x & 0xffff0000u));
        w.y = cvtpk(o[dh][4 * g4 + 2] * inv * __uint_as_float(gt[c].y << 16), o[dh][4 * g4 + 3] * inv * __uint_as_float(gt[c].y & 0xffff0000u));
        gt[c] = w; }
    if (!dry) row_store_pieces(cp, hi, gt); else asm volatile("" :: "v"(gt[0].x), "v"(gt[3].y), "v"(gt[7].x));
}
__device__ __forceinline__ void moba_own_pair(const Args& a, int uA, int uB, LAS unsigned char* L, int wv, float Mref, int dry = 0) {
    const int tid = wv * 64 + lane_id_opaque(), lane = tid & 63, wid = wv, hi = lane >> 5;
    const int bhA = uA >> 6, iA = uA & 63, bA = bhA >> 3, hA = bhA & 7, bhB = uB >> 6, iB = uB & 63, bB = bhB >> 3, hB = bhB & 7;
    __syncthreads();
    load_kv_tiles(L, a.ka() + hm_off(bA, hA, iA * 256), a.va() + hm_off(bA, hA, iA * 256), 64, tid);
    const bool single = (uA == uB);
    if (!single) load_kv_tiles(L + ATT_LDS_END, a.ka() + hm_off(bB, hB, iB * 256), a.va() + hm_off(bB, hB, iB * 256), 64, tid);
    s16x8 qfA[4], qfB[4];
    load_qfrag(qfA, a.qa() + hm_off(bA, hA, iA * 256 + wid * 32 + (lane & 31)), hi);
    load_qfrag(qfB, a.qa() + hm_off(bB, hB, iB * 256 + (7 - wid) * 32 + (lane & 31)), hi);
    const unsigned pmA = iA > 0 ? (unsigned)a.pmask()[((size_t)bA * SEQ + iA * 256 + wid * 32 + (lane & 31)) * 8 + hA] : 0u;
    const unsigned pmB = iB > 0 ? (unsigned)a.pmask()[((size_t)bB * SEQ + iB * 256 + (7 - wid) * 32 + (lane & 31)) * 8 + hB] : 0u;
    __syncthreads();
    own_tile(a, L, qfA, pmA, bA, hA, iA, wid, lane, Mref, dry);
    own_tile(a, single ? L : L + ATT_LDS_END, qfB, pmB, bB, hB, iB, 7 - wid, lane, Mref, dry);
}

__device__ __forceinline__ void mem_attn_phase(const Args& a, int l, LAS unsigned char* L, int wv, int bid, int G, float Mref, int dry) {
    const int NU = BATCH * 4 * 64;
    int unit = bid;
    KVRegs kvr; s16x8 qf[4], qfn[4];
    if (unit < NU) {
        const int tid = wv * 64 + lane_id_opaque(), lane = tid & 63;
        const int bhm = unit >> 6, qt = unit & 63, b = bhm >> 2, hm = bhm & 3;
        const size_t kvoff = ((size_t)l * TM + b * MEM_LEN) * 256 + hm * 64;
        kv_issue(kvr, a.memk() + kvoff, a.memv() + kvoff, 256, tid);
        load_qfrag(qf, a.qm() + ((size_t)b * SEQ + qt * 256 + wv * 32 + (lane & 31)) * 256 + hm * 64, lane >> 5);
    }
    while (unit < NU) {
        const int tid = wv * 64 + lane_id_opaque(), lane = tid & 63, r32 = lane & 31, hi = lane >> 5;
        const int bhm = unit >> 6, qt = unit & 63, b = bhm >> 2, hm = bhm & 3;
        const int nunit = unit + G;
        __syncthreads();
        kv_commit(L, kvr, tid);
        if (nunit < NU) {
            const int nbhm = nunit >> 6, nqt = nunit & 63, nb = nbhm >> 2, nhm = nbhm & 3;
            const size_t kvoff = ((size_t)l * TM + nb * MEM_LEN) * 256 + nhm * 64;
            kv_issue(kvr, a.memk() + kvoff, a.memv() + kvoff, 256, tid);
            load_qfrag(qfn, a.qm() + ((size_t)nb * SEQ + nqt * 256 + wv * 32 + r32) * 256 + nhm * 64, hi);
        }
        const size_t tok = (size_t)b * SEQ + qt * 256 + wv * 32 + r32;
        bf16* cp = a.cb() + tok * 1024 + 768 + hm * 64;
        uint2 gt[8]; row_load_pieces(cp, hi, gt);
        __syncthreads();
        f32x16 cin;
#pragma unroll
        for (int r = 0; r < 16; ++r) cin[r] = -Mref;
        f32x16 o[2]; float lsum = 0.f;
#pragma unroll
        for (int r = 0; r < 16; ++r) { o[0][r] = 0.f; o[1][r] = 0.f; }
        attn_tiles(L, qf, cin, 0.f, 0, 8, -1, r32, hi, lane, o, lsum);
        lsum = red32(lsum);
        const float inv = __builtin_amdgcn_rcpf(lsum);
#pragma unroll
        for (int c = 0; c < 8; ++c) { const int dh = c >> 2, g4 = c & 3; const uint2 g2 = gt[c]; uint2 w;
            w.x = cvtpk(o[dh][4 * g4] * inv * __uint_as_float(g2.x << 16), o[dh][4 * g4 + 1] * inv * __uint_as_float(g2.x & 0xffff0000u));
            w.y = cvtpk(o[dh][4 * g4 + 2] * inv * __uint_as_float(g2.y << 16), o[dh][4 * g4 + 3] * inv * __uint_as_float(g2.y & 0xffff0000u));
            gt[c] = w; }
        if (!dry) row_store_pieces(cp, hi, gt); else asm volatile("" :: "v"(gt[0].x), "v"(gt[3].y), "v"(gt[7].x));
#pragma unroll
        for (int d0 = 0; d0 < 4; ++d0) qf[d0] = qfn[d0];
        unit = nunit;
    }
    __syncthreads();
}

__device__ __forceinline__ void gla_load_cumsum(const Args& a, LAS float* sb, size_t tok0, int h, int tid, int lane, int wid) {
    for (int e = tid; e < 64 * 32; e += NTHREADS) { const int t = e >> 5, d = e & 31; sb[t * 33 + d] = a.la()[(tok0 + t) * 128 + h * 32 + d]; }
    __syncthreads();
#pragma unroll
    for (int cc = 0; cc < 4; ++cc) { const int d = wid * 4 + cc; float v = sb[lane * 33 + d];
#pragma unroll
        for (int o = 1; o < 64; o <<= 1) { const float t = shup(v, o, lane); if (lane >= o) v += t; }
        sb[lane * 33 + d] = v; }
    __syncthreads();
}
struct GlaRaw1 { pg8::f32x4 la[2]; uint4 k, v[2]; };
__device__ __forceinline__ void gla_raw1_issue(const Args& a, GlaRaw1& r, int unit, int lt) {
    const int c = unit & 255, h = (unit >> 8) & 3, b = unit >> 10;
    const size_t tok0 = (size_t)b * SEQ + c * 64; const int row = lt >> 2, q4 = lt & 3;
    const float* lp = a.la() + (tok0 + row) * 128 + h * 32 + 8 * q4;
    r.la[0] = *(const pg8::f32x4*)lp; r.la[1] = *(const pg8::f32x4*)(lp + 4);
    r.k = *(const uint4*)(a.qbkb() + (tok0 + row) * 256 + 128 + h * 32 + 8 * q4);
    const bf16* vp = a.vb() + (tok0 + row) * 256 + h * 64 + 16 * q4;
    r.v[0] = *(const uint4*)vp; r.v[1] = *(const uint4*)(vp + 8);
}
__device__ __forceinline__ void gla_p1_phase(const Args& a, LAS unsigned char* L, int wv, int bid, int G) {
    constexpr int GB = 8448 + 4608 + 9216;
    const int NU = BATCH * 4 * NCH;
    const int grp = wv >> 2, lw = wv & 3;
    LAS unsigned char* gb = L + grp * GB;
    LAS float* sb = (LAS float*)gb; LAS unsigned char* kT = gb + 8448; LAS unsigned char* vT = kT + 4608;
    int unit = bid + grp * G;
    GlaRaw1 R;
    { const int lt = lw * 64 + lane_id_opaque(); if (unit < NU) gla_raw1_issue(a, R, unit, lt); }
    while (unit - grp * G < NU) {
        const int lane = lane_id_opaque(), lt = lw * 64 + lane, r16 = lane & 15, g = lane >> 4;
        const bool act = unit < NU;
        const int row = lt >> 2, q4 = lt & 3;
        if (act) { LAS float* p = sb + row * 33 + 8 * q4;
#pragma unroll
            for (int e = 0; e < 4; ++e) { p[e] = R.la[0][e]; p[4 + e] = R.la[1][e]; } }
        __syncthreads();
        if (act) {
#pragma unroll
            for (int cc = 0; cc < 8; ++cc) { const int d = lw * 8 + cc; float v = sb[lane * 33 + d];
#pragma unroll
                for (int o = 1; o < 64; o <<= 1) { const float t = shup(v, o, lane); if (lane >= o) v += t; }
                sb[lane * 33 + d] = v; }
        }
        __syncthreads();
        float dlast = 0.f;
        if (act) {
            const int d0 = 8 * q4;
            const unsigned ww[4] = {R.k.x, R.k.y, R.k.z, R.k.w};
#pragma unroll
            for (int e = 0; e < 4; ++e) {
                *(LAS unsigned short*)(kT + (d0 + 2 * e) * 144 + row * 2) = (unsigned short)f2bf(__uint_as_float(ww[e] << 16) * __expf(sb[63 * 33 + d0 + 2 * e] - sb[row * 33 + d0 + 2 * e]));
                *(LAS unsigned short*)(kT + (d0 + 2 * e + 1) * 144 + row * 2) = (unsigned short)f2bf(__uint_as_float(ww[e] & 0xffff0000u) * __expf(sb[63 * 33 + d0 + 2 * e + 1] - sb[row * 33 + d0 + 2 * e + 1]));
            }
#pragma unroll
            for (int hh = 0; hh < 2; ++hh) { const unsigned vw[4] = {R.v[hh].x, R.v[hh].y, R.v[hh].z, R.v[hh].w};
#pragma unroll
                for (int k = 0; k < 4; ++k) { const int e = 16 * q4 + 8 * hh + 2 * k;
                    *(LAS unsigned short*)(vT + e * 144 + row * 2) = (unsigned short)(vw[k] & 0xffffu); *(LAS unsigned short*)(vT + (e + 1) * 144 + row * 2) = (unsigned short)(vw[k] >> 16); } }
            if (lt < 32) dlast = __expf(sb[63 * 33 + lt]);
        }
        const int cur = unit, nunit = unit + 2 * G;
        if (nunit < NU) gla_raw1_issue(a, R, nunit, lt);
        __syncthreads();
        if (act) {
            const s16x8 v0 = *(const LAS s16x8*)(vT + (16 * lw + r16) * 144 + 16 * g), v1 = *(const LAS s16x8*)(vT + (16 * lw + r16) * 144 + 64 + 16 * g);
#pragma unroll
            for (int db = 0; db < 2; ++db) {
                pg8::f32x4 acc = __builtin_amdgcn_mfma_f32_16x16x32_bf16(*(const LAS s16x8*)(kT + (16 * db + r16) * 144 + 16 * g), v0, (pg8::f32x4){0.f, 0.f, 0.f, 0.f}, 0, 0, 0);
                acc = __builtin_amdgcn_mfma_f32_16x16x32_bf16(*(const LAS s16x8*)(kT + (16 * db + r16) * 144 + 64 + 16 * g), v1, acc, 0, 0, 0);
#pragma unroll
                for (int r = 0; r < 4; ++r) a.U()[(size_t)cur * 2048 + (16 * db + 4 * g + r) * 64 + 16 * lw + r16] = acc[r];
            }
            if (lt < 32) a.Dc()[(size_t)cur * 32 + lt] = dlast;
        }
        unit = nunit;
        __syncthreads();
    }
}
__device__ __forceinline__ void gla_scan_slice(const Args& a, int slice, LAS unsigned char* L, int wv) {
    const int tid = wv * 64 + lane_id_opaque();
    const int e = tid & 63, sg = tid >> 6, bh = slice >> 5, d = slice & 31;
    LAS float* sS = (LAS float*)L; LAS float* sP = sS + 512;
    float Uv[32], Dv[32];
    const size_t unit0 = (size_t)bh * 256 + sg * 32;
#pragma unroll
    for (int c = 0; c < 32; ++c) { Dv[c] = a.Dc()[(unit0 + c) * 32 + d]; Uv[c] = a.U()[(unit0 + c) * 2048 + d * 64 + e]; }
    float S = 0.f, P = 1.f;
#pragma unroll
    for (int c = 0; c < 32; ++c) { S = Dv[c] * S + Uv[c]; P *= Dv[c]; }
    sS[sg * 64 + e] = S; sP[sg * 64 + e] = P;
    __syncthreads();
    float S0 = 0.f;
    for (int s2 = 0; s2 < sg; ++s2) S0 = sP[s2 * 64 + e] * S0 + sS[s2 * 64 + e];
    S = S0;
#pragma unroll
    for (int c = 0; c < 32; ++c) { a.Sst()[(unit0 + c) * 2048 + d * 64 + e] = S; S = Dv[c] * S + Uv[c]; }
    __syncthreads();
}
struct GlaRaw { pg8::f32x4 la[2], st[2]; uint4 q, k, v[2]; };
__device__ __forceinline__ void gla_raw_issue(const Args& a, GlaRaw& r, int unit, int lt) {
    const int c = unit & 255, h = (unit >> 8) & 3, b = unit >> 10;
    const size_t tok0 = (size_t)b * SEQ + c * 64; const int row = lt >> 2, q4 = lt & 3;
    const float* lp = a.la() + (tok0 + row) * 128 + h * 32 + 8 * q4;
    r.la[0] = *(const pg8::f32x4*)lp; r.la[1] = *(const pg8::f32x4*)(lp + 4);
    r.q = *(const uint4*)(a.qbkb() + (tok0 + row) * 256 + h * 32 + 8 * q4);
    r.k = *(const uint4*)(a.qbkb() + (tok0 + row) * 256 + 128 + h * 32 + 8 * q4);
    const bf16* vp = a.vb() + (tok0 + row) * 256 + h * 64 + 16 * q4;
    r.v[0] = *(const uint4*)vp; r.v[1] = *(const uint4*)(vp + 8);
    const float* sp = a.Sst() + (size_t)unit * 2048 + 8 * lt;
    r.st[0] = *(const pg8::f32x4*)sp; r.st[1] = *(const pg8::f32x4*)(sp + 4);
}
__device__ __forceinline__ void gla_p3_phase(const Args& a, int l, LAS unsigned char* L, int wv, int bid, int G, int dry) {
    constexpr int GB = 18688 + 9216 + 9216 + 5120;
    const int NU = BATCH * 4 * NCH;
    const int grp = wv >> 2, lw = wv & 3;
    LAS unsigned char* gb = L + grp * GB;
    LAS float* sb = (LAS float*)gb; LAS float* so = (LAS float*)gb;
    LAS unsigned char* qb = gb + 8448; LAS unsigned char* kb = qb + 5120; LAS unsigned char* ab = gb + 18688; LAS unsigned char* vT = ab + 9216; LAS unsigned char* sT = vT + 9216;
    int unit = bid + grp * G;
    GlaRaw R;
    { const int lt = lw * 64 + lane_id_opaque(); if (unit < NU) gla_raw_issue(a, R, unit, lt); }
    while (unit - grp * G < NU) {
        const int lane = lane_id_opaque(), lt = lw * 64 + lane, r16 = lane & 15, g = lane >> 4;
        const bool act = unit < NU;
        const int uc = act ? unit : 0;
        const int c = uc & 255, h = (uc >> 8) & 3, b = uc >> 10;
        const size_t tok0 = (size_t)b * SEQ + c * 64;
        const int row = lt >> 2, q4 = lt & 3;
        uint4* gptr = (uint4*)(a.cb() + (tok0 + row) * 1024 + 512 + h * 64 + 16 * q4);
        uint4 gate[2] = {make_uint4(0, 0, 0, 0), make_uint4(0, 0, 0, 0)};
        if (act) { gate[0] = gptr[0]; gate[1] = gptr[1]; }
        if (act) { LAS float* p = sb + row * 33 + 8 * q4;
#pragma unroll
            for (int e = 0; e < 4; ++e) { p[e] = R.la[0][e]; p[4 + e] = R.la[1][e]; } }
        __syncthreads();
        if (act) {
#pragma unroll
            for (int cc = 0; cc < 8; ++cc) { const int d = lw * 8 + cc; float v = sb[lane * 33 + d];
#pragma unroll
                for (int o = 1; o < 64; o <<= 1) { const float t = shup(v, o, lane); if (lane >= o) v += t; }
                sb[lane * 33 + d] = v; }
        }
        __syncthreads();
        if (act) {
            const int d0 = 8 * q4;
            const unsigned qw[4] = {R.q.x, R.q.y, R.q.z, R.q.w}, kw[4] = {R.k.x, R.k.y, R.k.z, R.k.w};
            unsigned qo[4], ko[4];
#pragma unroll
            for (int e = 0; e < 4; ++e) {
                const float d0v = sb[row * 33 + d0 + 2 * e] - sb[31 * 33 + d0 + 2 * e], d1v = sb[row * 33 + d0 + 2 * e + 1] - sb[31 * 33 + d0 + 2 * e + 1];
                const float e0 = __expf(d0v), e1 = __expf(d1v);
                qo[e] = cvtpk(__uint_as_float(qw[e] << 16) * e0, __uint_as_float(qw[e] & 0xffff0000u) * e1);
                ko[e] = cvtpk(__uint_as_float(kw[e] << 16) * __builtin_amdgcn_rcpf(e0), __uint_as_float(kw[e] & 0xffff0000u) * __builtin_amdgcn_rcpf(e1));
            }
            *(LAS pg8::u32x4*)(qb + row * 80 + 16 * q4) = (pg8::u32x4){qo[0], qo[1], qo[2], qo[3]};
            *(LAS pg8::u32x4*)(kb + row * 80 + 16 * q4) = (pg8::u32x4){ko[0], ko[1], ko[2], ko[3]};
#pragma unroll
            for (int hh = 0; hh < 2; ++hh) { const unsigned vw[4] = {R.v[hh].x, R.v[hh].y, R.v[hh].z, R.v[hh].w};
#pragma unroll
                for (int k = 0; k < 4; ++k) { const int e = 16 * q4 + 8 * hh + 2 * k;
                    *(LAS unsigned short*)(vT + e * 144 + row * 2) = (unsigned short)(vw[k] & 0xffffu); *(LAS unsigned short*)(vT + (e + 1) * 144 + row * 2) = (unsigned short)(vw[k] >> 16); } }
            const int sd = (8 * lt) >> 6, se = (8 * lt) & 63; const float em = __expf(sb[31 * 33 + sd]);
#pragma unroll
            for (int e = 0; e < 4; ++e) { *(LAS unsigned short*)(sT + (se + e) * 80 + sd * 2) = (unsigned short)f2bf(R.st[0][e] * em); *(LAS unsigned short*)(sT + (se + 4 + e) * 80 + sd * 2) = (unsigned short)f2bf(R.st[1][e] * em); }
        }
        const int nunit = unit + 2 * G;
        if (nunit < NU) gla_raw_issue(a, R, nunit, lt);
        __syncthreads();
        if (act) {
            for (int tt = lw; tt < 10; tt += 4) {
                const int rb = tt >= 6 ? 3 : tt >= 3 ? 2 : tt >= 1 ? 1 : 0, cb = tt - (rb * (rb + 1)) / 2;
                const s16x8 af = *(const LAS s16x8*)(qb + (16 * rb + r16) * 80 + 16 * g), bf = *(const LAS s16x8*)(kb + (16 * cb + r16) * 80 + 16 * g);
                const pg8::f32x4 acc = __builtin_amdgcn_mfma_f32_16x16x32_bf16(af, bf, (pg8::f32x4){0.f, 0.f, 0.f, 0.f}, 0, 0, 0);
#pragma unroll
                for (int r = 0; r < 4; ++r) { const int i = 16 * rb + 4 * g + r, j = 16 * cb + r16; *(LAS unsigned short*)(ab + i * 144 + j * 2) = (unsigned short)f2bf((j <= i) ? acc[r] : 0.f); }
            }
            if (lw == 0) {
#pragma unroll
                for (int r = 0; r < 4; ++r) { *(LAS unsigned short*)(ab + (4 * g + r) * 144 + (16 + r16) * 2) = 0; *(LAS unsigned short*)(ab + (32 + 4 * g + r) * 144 + (48 + r16) * 2) = 0; }
            }
        }
        __syncthreads();
        pg8::f32x4 oacc[4];
        if (act) {
            const s16x8 sf = *(const LAS s16x8*)(sT + (16 * lw + r16) * 80 + 16 * g);
            const s16x8 v0 = *(const LAS s16x8*)(vT + (16 * lw + r16) * 144 + 16 * g), v1 = *(const LAS s16x8*)(vT + (16 * lw + r16) * 144 + 64 + 16 * g);
#pragma unroll
            for (int rb = 0; rb < 4; ++rb) {
                const s16x8 qf_ = *(const LAS s16x8*)(qb + (16 * rb + r16) * 80 + 16 * g);
                pg8::f32x4 acc = __builtin_amdgcn_mfma_f32_16x16x32_bf16(qf_, sf, (pg8::f32x4){0.f, 0.f, 0.f, 0.f}, 0, 0, 0);
                acc = __builtin_amdgcn_mfma_f32_16x16x32_bf16(*(const LAS s16x8*)(ab + (16 * rb + r16) * 144 + 16 * g), v0, acc, 0, 0, 0);
                if (rb >= 2) acc = __builtin_amdgcn_mfma_f32_16x16x32_bf16(*(const LAS s16x8*)(ab + (16 * rb + r16) * 144 + 64 + 16 * g), v1, acc, 0, 0, 0);
                oacc[rb] = acc;
            }
        }
        __syncthreads();
        if (act) {
#pragma unroll
            for (int rb = 0; rb < 4; ++rb)
#pragma unroll
                for (int r = 0; r < 4; ++r) so[(16 * rb + 4 * g + r) * 65 + 16 * lw + r16] = oacc[rb][r];
        }
        __syncthreads();
        if (act) {
            const LAS float* orow = so + row * 65 + 16 * q4;
            float ov[16]; float ss = 0.f;
#pragma unroll
            for (int e = 0; e < 16; ++e) { ov[e] = orow[e]; ss += ov[e] * ov[e]; }
            ss += shx(ss, 1, lane); ss += shx(ss, 2, lane);
            const float inv = pg8::rsq_f(ss * (1.f / 64.f) + EPS);
            const float* gg = a.g_gla_out() + l * 64 + 16 * q4;
            unsigned ow[8];
#pragma unroll
            for (int e = 0; e < 8; ++e) { const unsigned gw = (e < 4) ? ((e == 0) ? gate[0].x : (e == 1) ? gate[0].y : (e == 2) ? gate[0].z : gate[0].w) : ((e == 4) ? gate[1].x : (e == 5) ? gate[1].y : (e == 6) ? gate[1].z : gate[1].w);
                ow[e] = cvtpk(ov[2 * e] * inv * gg[2 * e] * __uint_as_float(gw << 16), ov[2 * e + 1] * inv * gg[2 * e + 1] * __uint_as_float(gw & 0xffff0000u)); }
            if (!dry) { gptr[0] = make_uint4(ow[0], ow[1], ow[2], ow[3]); gptr[1] = make_uint4(ow[4], ow[5], ow[6], ow[7]); } else asm volatile("" :: "v"(ow[0]), "v"(ow[3]), "v"(ow[7]));
        }
        unit = nunit;
        __syncthreads();
    }
}

__device__ __forceinline__ int src_col_in(int R) {
    const int tile = R >> 8, loc = R & 255, bj = loc >> 7, wc = (loc >> 5) & 3, j = loc & 31;
    switch (tile) {
        case 0: case 1: return C_QA + (4 * tile + wc) * 64 + 32 * bj + j;
        case 2: case 3: return C_KA + (4 * (tile - 2) + wc) * 64 + 32 * bj + j;
        case 4: case 5: return C_VA + 256 * (tile - 4) + loc;
        case 6: case 7: return C_GA + 256 * (tile - 6) + loc;
        case 8: return C_QB + loc;
        case 9: return C_VB + loc;
        case 10: return C_GB + loc;
        case 11: return C_QM + wc * 64 + 32 * bj + j;
        case 12: return C_GM + loc;
        default: return loc < 128 ? -(loc + 2) : -1;
    }
}

__device__ __forceinline__ void conv_item(const float* W, int ldw, int sc0, const float* g, bf16* WT, int R0, int k0, LAS float* scr, int lane) {
    float wv_[32];
#pragma unroll
    for (int i = 0; i < 32; ++i) { const int kk = 2 * i + (lane >> 5); wv_[i] = W[(size_t)(k0 + kk) * ldw + sc0 + (lane & 31)]; }
#pragma unroll
    for (int i = 0; i < 32; ++i) { const int kk = 2 * i + (lane >> 5); scr[kk * 33 + (lane & 31)] = wv_[i] * (g ? g[k0 + kk] : 1.f); }
    asm volatile("s_waitcnt lgkmcnt(0)" ::: "memory");
    const int c = lane & 7;
#pragma unroll
    for (int j = 0; j < 4; ++j) { const int n = (lane >> 3) + 8 * j; const LAS float* sp = scr + (8 * c) * 33 + n;
        uint4 o; o.x = pk2(sp[0 * 33], sp[1 * 33]); o.y = pk2(sp[2 * 33], sp[3 * 33]); o.z = pk2(sp[4 * 33], sp[5 * 33]); o.w = pk2(sp[6 * 33], sp[7 * 33]);
        *(uint4*)(WT + (size_t)(R0 + n) * DM + k0 + 8 * c) = o; }
    asm volatile("s_waitcnt lgkmcnt(0)" ::: "memory");
}
__device__ __forceinline__ void p0_prologue(const Args& a, LAS unsigned char* L, int bid, int G, int wv) {
    const int lane = lane_id_opaque(), gtid = bid * NTHREADS + wv * 64 + lane, nthreads = G * NTHREADS, gwave = bid * NWAVES + wv, nwaves = G * NWAVES;
    LAS float* scr = (LAS float*)(L + wv * 16384);
    constexpr int NB_IN = NINP / 32, I_IN = DEPTH * 16 * NB_IN, I_OUT = DEPTH * 16 * (DM / 32), I_MEM = DEPTH * 16 * 16;
    for (int it = gwave; it < I_IN + I_OUT + I_MEM; it += nwaves) {
        if (it < I_IN) {
            const int nb = it % NB_IN, kb = (it / NB_IN) % 16, l = it / (NB_IN * 16);
            const int sc = src_col_in(32 * nb);
            if (sc >= 0) conv_item(a.w_in() + (size_t)l * DM * NIN, NIN, sc, a.g_pre() + l * DM, a.wt_in() + (size_t)l * NINP * DM, 32 * nb, 64 * kb, scr, lane);
            else {
                const int R = 32 * nb + (lane & 31), kq = 64 * kb + 32 * (lane >> 5);
                const float* W = a.w_in() + (size_t)l * DM * NIN; const float* g = a.g_pre() + l * DM;
                const float* wg = a.w_gate_up() + (size_t)l * 16 * 128 + (R & 127);
                for (int k8 = 0; k8 < 4; ++k8) {
                    float v[8];
#pragma unroll
                    for (int kk = 0; kk < 8; ++kk) { float sacc = 0.f;
                        if (sc != -1) { const float* wr = W + (size_t)(kq + 8 * k8 + kk) * NIN + C_RB;
#pragma unroll
                            for (int r = 0; r < 16; ++r) sacc += wr[r] * wg[r * 128]; }
                        v[kk] = sacc * g[kq + 8 * k8 + kk]; }
                    uint4 o; o.x = pk2(v[0], v[1]); o.y = pk2(v[2], v[3]); o.z = pk2(v[4], v[5]); o.w = pk2(v[6], v[7]);
                    *(uint4*)(a.wt_in() + ((size_t)l * NINP + R) * DM + kq + 8 * k8) = o;
                }
            }
        } else if (it < I_IN + I_OUT) {
            const int r = it - I_IN, nb = r % 32, kb = (r / 32) % 16, l = r / 512;
            conv_item(a.w_out() + (size_t)l * DM * DM, DM, 32 * nb, nullptr, a.wt_out() + (size_t)l * DM * DM, 32 * nb, 64 * kb, scr, lane);
        } else {
            const int r = it - I_IN - I_OUT, nb = r % 16, kb = (r / 16) % 16, l = r / 256;
            const int loc = 32 * nb; int sc;
            if (loc < 256) { const int bj = loc >> 7, wc = (loc >> 5) & 3; sc = wc * 64 + 32 * bj; } else sc = loc;
            conv_item(a.w_mem_kv() + (size_t)l * DM * 512, 512, sc, a.g_mem() + l * DM, a.wt_mem() + (size_t)l * 512 * DM, loc, 64 * kb, scr, lane);
        }
    }
    for (int row = gwave; row < TM; row += nwaves) {
        const float4* xr = (const float4*)(a.mem() + (size_t)row * DM) + lane;
        float s = 0.f;
#pragma unroll
        for (int j = 0; j < 4; ++j) {
            const float4 v = xr[64 * j]; s += (v.x * v.x + v.y * v.y) + (v.z * v.z + v.w * v.w);
            uint2 o; o.x = pk2(v.x, v.y); o.y = pk2(v.z, v.w);
            *((uint2*)(a.membf() + (size_t)row * DM) + lane + 64 * j) = o;
        }
        s = wave_sum(s, lane);
        if (lane < 16) a.ssqm()[(size_t)row * 16 + lane] = (lane == 0) ? s : 0.f;
    }
    for (int row0 = gwave * 4; row0 < T; row0 += nwaves * 4) {
        float4 v[4][4];
#pragma unroll
        for (int rr = 0; rr < 4; ++rr)
#pragma unroll
            for (int j = 0; j < 4; ++j) v[rr][j] = ((const float4*)(a.x() + (size_t)(row0 + rr) * DM) + lane)[64 * j];
#pragma unroll
        for (int rr = 0; rr < 4; ++rr) {
            float sacc = 0.f;
#pragma unroll
            for (int j = 0; j < 4; ++j) {
                const float4 w = v[rr][j]; sacc += (w.x * w.x + w.y * w.y) + (w.z * w.z + w.w * w.w);
                uint2 o; o.x = pk2(w.x, w.y); o.y = pk2(w.z, w.w);
                *((uint2*)(a.xb() + (size_t)(row0 + rr) * DM) + lane + 64 * j) = o;
            }
            sacc = wave_sum(sacc, lane);
            if (lane < 16) a.ssq()[(size_t)(row0 + rr) * 16 + lane] = (lane == 0) ? sacc : 0.f;
        }
    }
}

constexpr int N_STEPS = 2 + 5 * DEPTH;
constexpr int CW_BAR = 4096;
#ifndef MK_SPLIT
#define MK_SPLIT 0
#endif
#ifndef PROBE
#define PROBE 0
#endif
__global__ void __launch_bounds__(NTHREADS, 2) mk_fwd(KArgs aa) {
    extern __shared__ __attribute__((aligned(16))) unsigned char lds[];
    const int G = gridDim.x;
    PG8_LAS unsigned char* L = (PG8_LAS unsigned char*)lds;
    const int wave_s = __builtin_amdgcn_readfirstlane(threadIdx.x >> 6);
    {
        const int tid0 = wave_s * 64 + (int)__builtin_amdgcn_mbcnt_hi(~0u, __builtin_amdgcn_mbcnt_lo(~0u, 0u));
        for (int u = tid0; u < 512 / 4; u += NTHREADS) ((LAS unsigned*)(L + MISC_OFF))[u] = 0u;
        __syncthreads();
    }
    unsigned* barw = (unsigned*)(aa.ws + O_CTL) + CW_BAR;
    XcdBarrier bar; bar.bar = barw; bar.x = 0; bar.st = nullptr;
    if (!MK_SPLIT) bar = xcd_barrier_post(barw, (volatile LAS unsigned*)(L + MISC_OFF) + 8, wave_s * 64 + (int)__builtin_amdgcn_mbcnt_hi(~0u, __builtin_amdgcn_mbcnt_lo(~0u, 0u)));
    const int ph_lo = aa.ph_lo, ph_hi = aa.ph_hi;
    for (int st = ph_lo; st < ph_hi; ++st) {
        int bid_o = blockIdx.x, wv_o = wave_s;
        asm volatile("" : "+s"(bid_o)); asm volatile("" : "+s"(wv_o));
        Args a; a.kp = (const __attribute__((address_space(4))) KArgs*)__builtin_amdgcn_kernarg_segment_ptr();
        asm volatile("" : "+s"(a.kp));
        const int wave = wv_o, bid = bid_o;
        if (st == 0) {
            p0_prologue(a, L, bid, G, wave);
            if (PROBE == 11) p0_prologue(a, L, bid, G, wave);
        } else if (st == 1) {
            pg8::Gemm g{a.membf(), a.wt_mem(), TM, DEPTH * 512, DM}; pg8::StaticOrder S; S.init(TM, DEPTH * 512, G, bid);
            pg8::EpiMem E{a.memk(), a.memv(), a.ssqm(), a.g_k_mem(), TM};
            pg8::gemm_phase<pg8::EpiMem, pg8::StaticOrder, false, true>(L, g, S, E, wave);
        } else {
            const int l = (st - 2) / 5, k = (st - 2) % 5;
            for (int rep = 0; rep < ((PROBE == k + 1) ? 2 : 1); ++rep) {
            const int dry = (PROBE == k + 1 && rep == 0 && (k == 3 || k == 4 || k == 1)) ? 1 : 0;
            if (k == 0) {
                if (bid == 0) { const int t0 = wave * 64 + lane_id_opaque(); a.gcnt()[t0] = 0u; a.gcnt()[t0 + 512] = 0u; }
                pg8::Gemm g{a.xb(), a.wt_in() + (size_t)l * NINP * DM, T, NINP, DM}; pg8::StaticOrder S; S.init(T, NINP, G, bid);
                pg8::EpiIn E{a.qa(), a.ka(), a.va(), a.cb(), a.qbkb(), a.vb(), a.qm(), a.la(), a.kmp(), a.ssq(), a.g_q_moba() + l * 64, a.g_k_moba() + l * 64, a.g_q_mem() + l * 64, a.b_gate_up() + l * 128};
                if (PROBE == 13) { pg8::EpiDry ED; pg8::gemm_phase<pg8::EpiDry, pg8::StaticOrder, true, true>(L, g, S, ED, wave); }
                pg8::gemm_phase<pg8::EpiIn, pg8::StaticOrder, true, true>(L, g, S, E, wave);
            } else if (k == 1) {
                const float zthr = zero_thr(softmax_ref(a.g_q_moba() + l * 64, a.g_k_moba() + l * 64));
                moba_route_phase(a, L, wave, bid, G, zthr, dry);
                gla_p1_phase(a, L, wave, bid, G);
            } else if (k == 2) {
                for (int sl = bid; sl < 256; sl += G) gla_scan_slice(a, sl, L, wave);
                if (PROBE == 9) moba_pairs_phase(a, l, L, wave, bid, G, 1);
                if (PROBE == 10) for (int sl = bid; sl < 256; sl += G) gla_scan_slice(a, sl, L, wave);
                moba_pairs_phase(a, l, L, wave, bid, G);
            } else if (k == 3) {
                const float Mref = softmax_ref(a.g_q_moba() + l * 64, a.g_k_moba() + l * 64);
                if (PROBE >= 6) {
                    if (PROBE == 6) for (int u = bid; u < BATCH * 8 * 64; u += 2 * G) moba_own_pair(a, u, (u + G < BATCH * 8 * 64) ? u + G : u, L, wave, Mref, 1);
                    const float Mm0 = softmax_ref(a.g_q_mem() + l * 64, a.g_k_mem() + l * 64);
                    if (PROBE == 7) mem_attn_phase(a, l, L, wave, bid, G, Mm0, 1);
                    if (PROBE == 8) gla_p3_phase(a, l, L, wave, bid, G, 1);
                }
                for (int u = bid; u < BATCH * 8 * 64; u += 2 * G) moba_own_pair(a, u, (u + G < BATCH * 8 * 64) ? u + G : u, L, wave, Mref, dry);
                const float Mm = softmax_ref(a.g_q_mem() + l * 64, a.g_k_mem() + l * 64);
                mem_attn_phase(a, l, L, wave, bid, G, Mm, dry);
                gla_p3_phase(a, l, L, wave, bid, G, dry);
            } else {
                pg8::Gemm g{a.cb(), a.wt_out() + (size_t)l * DM * DM, T, DM, DM}; pg8::StaticOrder S; S.init(T, DM, G, bid);
                if (l == 0) { pg8::EpiOut<1, 0> E{a.x(), a.out(), a.xb(), a.ssq()}; pg8::gemm_phase<pg8::EpiOut<1, 0>, pg8::StaticOrder, true, true>(L, g, S, E, wave); }
                else if (l == DEPTH - 1) { pg8::EpiOut<0, 1> E{a.x(), a.out(), a.xb(), a.ssq()}; pg8::gemm_phase<pg8::EpiOut<0, 1>, pg8::StaticOrder, true, true>(L, g, S, E, wave); }
                else { pg8::EpiOut<0, 0> E{a.x(), a.out(), a.xb(), a.ssq()}; pg8::gemm_phase<pg8::EpiOut<0, 0>, pg8::StaticOrder, true, true>(L, g, S, E, wave); }
            }
            }
        }
        if (!MK_SPLIT && st + 1 < ph_hi && st != 1) {
            XcdBarrier b2 = bar; unsigned* bp = b2.bar; unsigned bx = b2.x;
            asm volatile("" : "+s"(bp)); asm volatile("" : "+s"(bx));
            b2.bar = bp; b2.x = bx;
            xcd_barrier(b2, wave);
            if (PROBE == 12) xcd_barrier(b2, wave);
        }
    }
}

extern "C" void kernel_launch(void* const* d_in, const int* in_sizes, int n_in, void* d_out, int out_size, void* d_ws, size_t ws_size, hipStream_t stream) {
    static int grid = 0;
    if (grid == 0) {
        int dev = 0, cus = 0;
        if (hipGetDevice(&dev) != hipSuccess || hipDeviceGetAttribute(&cus, hipDeviceAttributeMultiprocessorCount, dev) != hipSuccess) { grid = -1; return; }
        if (hipFuncSetAttribute((const void*)mk_fwd, hipFuncAttributeMaxDynamicSharedMemorySize, LDS_BYTES) != hipSuccess) { fprintf(stderr, "hipFuncSetAttribute failed\n"); grid = -1; return; }
        grid = cus;
    }
    if (grid < 0) return;
    KArgs a{};
    a.x = (const float*)d_in[0]; a.mem = (const float*)d_in[1]; a.g_pre = (const float*)d_in[2]; a.w_in = (const float*)d_in[3];
    a.g_q_moba = (const float*)d_in[4]; a.g_k_moba = (const float*)d_in[5]; a.w_gate_up = (const float*)d_in[6]; a.b_gate_up = (const float*)d_in[7];
    a.g_gla_out = (const float*)d_in[8]; a.g_mem = (const float*)d_in[9]; a.w_mem_kv = (const float*)d_in[10]; a.g_q_mem = (const float*)d_in[11];
    a.g_k_mem = (const float*)d_in[12]; a.w_out = (const float*)d_in[13];
    a.out = (float*)d_out;
    a.ws = (unsigned char*)d_ws;
    (void)ws_size; (void)in_sizes; (void)n_in; (void)out_size;
    (void)hipMemsetAsync((char*)d_ws + O_CTL, 0, 1 << 16, stream);
#if MK_SPLIT
    for (int st = 0; st < N_STEPS; ++st) { a.ph_lo = st; a.ph_hi = st + 1; hipLaunchKernelGGL(mk_fwd, dim3(grid), dim3(NTHREADS), LDS_BYTES, stream, a); }
#else
    a.ph_lo = 0; a.ph_hi = N_STEPS;
    hipLaunchKernelGGL(mk_fwd, dim3(grid), dim3(NTHREADS), LDS_BYTES, stream, a);
#endif
}
```

```cpp
#include <hip/hip_runtime.h>
#include <cstdio>
#include <cstdint>
#include <cstddef>

constexpr int BATCH = 2, SEQ = 16384, DM = 1024, DEPTH = 4, T = BATCH * SEQ;
constexpr int MEM_LEN = 256, TM = BATCH * MEM_LEN;
constexpr int NIN = 3344;
constexpr int C_QA = 0, C_KA = 512, C_VA = 1024, C_GA = 1536, C_QB = 2048, C_KB = 2176, C_VB = 2304, C_GB = 2560, C_RB = 2816, C_QM = 2832, C_GM = 3088;
constexpr int NB = SEQ / 256;
constexpr int NCH = SEQ / 64;
constexpr float EPS = 1e-6f;
constexpr int NINP = 14 * 256;
constexpr float LOG2E = 1.4426950408889634f;
constexpr float QSCALE = 0.125f * LOG2E;

__device__ __forceinline__ int lane_id_opaque() { int l; asm volatile("v_mbcnt_lo_u32_b32 %0, -1, 0\n\tv_mbcnt_hi_u32_b32 %0, -1, %0" : "=v"(l)); return l; }
__device__ __forceinline__ float red16(float v) { const auto r = __builtin_amdgcn_permlane16_swap(__float_as_uint(v), __float_as_uint(v), false, false); return __uint_as_float(r[0]) + __uint_as_float(r[1]); }
__device__ __forceinline__ float red32(float v) { const auto r = __builtin_amdgcn_permlane32_swap(__float_as_uint(v), __float_as_uint(v), false, false); return __uint_as_float(r[0]) + __uint_as_float(r[1]); }
template <int CTRL> __device__ __forceinline__ float dppmov(float v) { return __int_as_float(__builtin_amdgcn_update_dpp(0, __float_as_int(v), CTRL, 0xF, 0xF, false)); }
__device__ __forceinline__ float row16_sum(float v) { v += dppmov<0x128>(v); v += dppmov<0x124>(v); v += dppmov<0x4E>(v); v += dppmov<0xB1>(v); return v; }
__device__ __forceinline__ float shx(float v, int mask, int lane) { return __int_as_float(__builtin_amdgcn_ds_bpermute((lane ^ mask) << 2, __float_as_int(v))); }
__device__ __forceinline__ int shx_i(int v, int mask, int lane) { return __builtin_amdgcn_ds_bpermute((lane ^ mask) << 2, v); }
__device__ __forceinline__ float shup(float v, int o, int lane) { return __int_as_float(__builtin_amdgcn_ds_bpermute((lane >= o ? lane - o : lane) << 2, __float_as_int(v))); }
__device__ __forceinline__ int shup_i(int v, int o, int lane) { return __builtin_amdgcn_ds_bpermute((lane >= o ? lane - o : lane) << 2, v); }

namespace pg8 {
#define PG8_LAS __attribute__((address_space(3)))
typedef unsigned short bf16_t;
typedef short bf16x8 __attribute__((ext_vector_type(8)));
typedef float f32x4 __attribute__((ext_vector_type(4)));
typedef unsigned u32x4 __attribute__((ext_vector_type(4)));
constexpr int BM = 256, BK = 64, HALF = 128, HTB = HALF * BK * 2  , STAGE_BYTES = 8 * HTB, NXCD = 8, WGM = 8;

__host__ __device__ __forceinline__ int lds_byte(int r, int c) { const int st = (r >> 4) * 2 + (c >> 5), rr = r & 15, cc = c & 31, ob = rr * 64 + cc * 2; return st * 1024 + (ob ^ (((ob >> 9) & 1) << 5)); }
__host__ __device__ __forceinline__ void stage_rc(int b, int& R, int& C) { const int st = b / 1024, sb = b % 1024, swz = sb ^ (((sb >> 9) & 1) << 5); R = (st >> 1) * 16 + swz / 64; C = (st & 1) * 32 + (swz % 64) / 2; }
__host__ __device__ __forceinline__ int perm32(int rho) { const int n = rho >> 4, i = rho & 15; return 8 * (i >> 2) + 4 * n + (i & 3); }

struct Unit { int pm, pn; };
struct Gemm { const bf16_t* A; const bf16_t* Bt; int M, N, K; };

struct StaticOrder {
    int nM, nN, nwg, G, c;
    __host__ __device__ void init(int M, int N, int G_, int c_) { nM = M / BM; nN = N / BM; nwg = nM * nN; G = G_; c = c_; }
    __host__ __device__ bool next(int i, Unit& u) const {
        const long L = (long)i * G + c; if (L >= nwg) return false;
        int wgid = (int)L; { const int q = nwg / NXCD, r = nwg % NXCD, xcd = wgid % NXCD, off = wgid / NXCD; wgid = (xcd < r ? xcd * (q + 1) : r * (q + 1) + (xcd - r) * q) + off; }
        const int nig = WGM * nN, gid = wgid / nig, fm = gid * WGM, gsz = (nM - fm) < WGM ? (nM - fm) : WGM;
        u.pm = fm + ((wgid % nig) % gsz); u.pn = (wgid % nig) / gsz; return true;
    }
    __device__ __forceinline__ void a_ready(const Unit&) const {}
    __device__ __forceinline__ void done(const Unit&) const {}
};

__device__ __forceinline__ unsigned cvt_pk_bf16(float lo, float hi) { unsigned r; asm volatile("v_cvt_pk_bf16_f32 %0, %1, %2" : "=v"(r) : "v"(lo), "v"(hi)); return r; }
__device__ __forceinline__ float silu_f(float g) { return g * __builtin_amdgcn_rcpf(1.f + __builtin_amdgcn_exp2f(-1.4426950408889634f * g)); }
__device__ __forceinline__ float rsq_f(float x) { return __builtin_amdgcn_rsqf(x); }
typedef unsigned u32x2 __attribute__((ext_vector_type(2)));

struct EpiIn {
    static constexpr bool PERM = true, AFTER_DRAIN = false;
    bf16_t *qa, *ka, *va, *cb, *qbkb, *vb, *qm; float *la, *kmp; const float *ssq, *gq, *gk, *gqm, *bgu;
    __device__ __forceinline__ void operator()(const f32x4 (&acc)[2][2][4][2], const Unit& u, int wr, int wc, int fr, int fq) const {
        const int row0 = u.pm * BM + wr * 64 + fr, lane = fq * 16 + fr;
        float rs[2][4];
        {
            f32x4 pp[2][4];
#pragma unroll
            for (int ai = 0; ai < 2; ++ai)
#pragma unroll
                for (int m = 0; m < 4; ++m) pp[ai][m] = *(const f32x4*)(ssq + (size_t)(row0 + ai * HALF + m * 16) * 16 + fq * 4);
            asm volatile("" : "+v"(pp[0][0]), "+v"(pp[0][1]), "+v"(pp[0][2]), "+v"(pp[0][3]), "+v"(pp[1][0]), "+v"(pp[1][1]), "+v"(pp[1][2]), "+v"(pp[1][3]));
#pragma unroll
            for (int ai = 0; ai < 2; ++ai)
#pragma unroll
                for (int m = 0; m < 4; ++m) {
                    const f32x4 p = pp[ai][m];
                    float s = (p[0] + p[1]) + (p[2] + p[3]);
                    s = red16(s); s = red32(s);
                    rs[ai][m] = rsq_f(s * (1.f / 1024.f) + EPS);
                }
        }
        const int pn = u.pn;
        if (pn <= 3 || pn == 11) {
            bf16_t* dst; const float* g; float qs; int head, ld;
            if (pn <= 1) { dst = qa; g = gq; qs = QSCALE; head = 4 * pn + wc; ld = 512; }
            else if (pn <= 3) { dst = ka; g = gk; qs = 1.f; head = 4 * (pn - 2) + wc; ld = 512; }
            else { dst = qm; g = gqm; qs = QSCALE; head = wc; ld = 256; }
            f32x4 gv[2][2];
#pragma unroll
            for (int bj = 0; bj < 2; ++bj)
#pragma unroll
                for (int n = 0; n < 2; ++n) gv[bj][n] = *(const f32x4*)(g + 32 * bj + 8 * fq + 4 * n);
            f32x4 ksum[2][2];
#pragma unroll
            for (int bj = 0; bj < 2; ++bj)
#pragma unroll
                for (int n = 0; n < 2; ++n) ksum[bj][n] = (f32x4){0.f, 0.f, 0.f, 0.f};
#pragma unroll
            for (int ai = 0; ai < 2; ++ai)
#pragma unroll
                for (int m = 0; m < 4; ++m) {
                    f32x4 v[2][2]; float ss = 0.f;
#pragma unroll
                    for (int bj = 0; bj < 2; ++bj)
#pragma unroll
                        for (int n = 0; n < 2; ++n) { v[bj][n] = acc[ai][bj][m][n] * rs[ai][m]; const f32x4 t = v[bj][n]; ss += (t[0] * t[0] + t[1] * t[1]) + (t[2] * t[2] + t[3] * t[3]); }
                    ss = red16(ss); ss = red32(ss);
                    const float inv = rsq_f(ss * (1.f / 64.f) + EPS);
                    const int grow = row0 + ai * HALF + m * 16;
                    bf16_t* rowp = (pn <= 3) ? dst + (((size_t)((u.pm >> 6) * 8 + head)) * SEQ + (grow & (SEQ - 1))) * 64 + 8 * fq : dst + (size_t)grow * ld + head * 64 + 8 * fq;
#pragma unroll
                    for (int bj = 0; bj < 2; ++bj) {
                        const f32x4 a = v[bj][0] * inv * gv[bj][0], b = v[bj][1] * inv * gv[bj][1];
                        ksum[bj][0] += a; ksum[bj][1] += b;
                        u32x4 w; w.x = cvt_pk_bf16(a[0] * qs, a[1] * qs); w.y = cvt_pk_bf16(a[2] * qs, a[3] * qs); w.z = cvt_pk_bf16(b[0] * qs, b[1] * qs); w.w = cvt_pk_bf16(b[2] * qs, b[3] * qs);
                        *(u32x4*)(rowp + 32 * bj) = w;
                    }
                }
            if (pn == 2 || pn == 3) {
#pragma unroll
                for (int bj = 0; bj < 2; ++bj)
#pragma unroll
                    for (int n = 0; n < 2; ++n)
#pragma unroll
                        for (int e = 0; e < 4; ++e) ksum[bj][n][e] = row16_sum(ksum[bj][n][e]);
                if (fr == 0) {
                    const int b = u.pm >> 6, blk = u.pm & 63;
                    float* kp = kmp + ((((size_t)(b * 8 + head) * 64 + blk) * 2 + wr) * 64) + 8 * fq;
#pragma unroll
                    for (int bj = 0; bj < 2; ++bj)
#pragma unroll
                        for (int n = 0; n < 2; ++n) *(f32x4*)(kp + 32 * bj + 4 * n) = ksum[bj][n];
                }
            }
        } else if (pn == 13) {
            f32x4 bv[2];
#pragma unroll
            for (int n = 0; n < 2; ++n) bv[n] = *(const f32x4*)(bgu + 32 * wc + 8 * fq + 4 * n);
#pragma unroll
            for (int ai = 0; ai < 2; ++ai)
#pragma unroll
                for (int m = 0; m < 4; ++m) {
                    float* rowp = la + (size_t)(row0 + ai * HALF + m * 16) * 128 + 32 * wc + 8 * fq;
#pragma unroll
                    for (int n = 0; n < 2; ++n) {
                        const f32x4 z = acc[ai][0][m][n] * rs[ai][m] + bv[n]; f32x4 o;
#pragma unroll
                        for (int e = 0; e < 4; ++e) o[e] = (fminf(z[e], 0.f) - 0.6931471805599453f * __builtin_amdgcn_logf(1.f + __builtin_amdgcn_exp2f(-1.4426950408889634f * fabsf(z[e])))) * (1.f / 16.f);
                        *(f32x4*)(rowp + 4 * n) = o;
                    }
                }
        } else {
            const int b = u.pm >> 6;
            if (pn == 4 || pn == 5) {
                bf16_t* base = va + (((size_t)(b * 8 + 4 * (pn - 4) + (wc >> 1))) * SEQ + (row0 & (SEQ - 1))) * 64 + 32 * (wc & 1) + 8 * fq;
                plain_rows<64, (long)2 * SEQ * 64, false>(acc, rs, base, 1.f);
            } else if (pn == 6 || pn == 7) plain_rows<1024, HALF, true>(acc, rs, cb + (size_t)row0 * 1024 + 256 * (pn - 6) + 32 * wc + 8 * fq, 1.f);
            else if (pn == 8) plain_rows<256, HALF, false>(acc, rs, qbkb + (size_t)row0 * 256 + 32 * wc + 8 * fq, 0.17677669529663687f);
            else if (pn == 9) plain_rows<256, HALF, false>(acc, rs, vb + (size_t)row0 * 256 + 32 * wc + 8 * fq, 1.f);
            else if (pn == 10) plain_rows<1024, HALF, true>(acc, rs, cb + (size_t)row0 * 1024 + 512 + 32 * wc + 8 * fq, 1.f);
            else plain_rows<1024, HALF, true>(acc, rs, cb + (size_t)row0 * 1024 + 768 + 32 * wc + 8 * fq, 1.f);
        }
    }
    template <int LD, long BJ, bool GATE> static __device__ __forceinline__ void plain_rows(const f32x4 (&acc)[2][2][4][2], const float (&rs)[2][4], bf16_t* base, float sc0) {
#pragma unroll
        for (int ai = 0; ai < 2; ++ai)
#pragma unroll
            for (int m = 0; m < 4; ++m) {
                bf16_t* rowp = base + (size_t)(ai * HALF + m * 16) * LD;
#pragma unroll
                for (int bj = 0; bj < 2; ++bj) {
                    const float sc = rs[ai][m] * (bj == 0 ? sc0 : 1.f);
                    f32x4 a = acc[ai][bj][m][0] * sc, b = acc[ai][bj][m][1] * sc;
                    if (GATE) {
#pragma unroll
                        for (int e = 0; e < 4; ++e) { a[e] = silu_f(a[e]); b[e] = silu_f(b[e]); }
                    }
                    u32x4 w; w.x = cvt_pk_bf16(a[0], a[1]); w.y = cvt_pk_bf16(a[2], a[3]); w.z = cvt_pk_bf16(b[0], b[1]); w.w = cvt_pk_bf16(b[2], b[3]);
                    *(u32x4*)(rowp + BJ * bj) = w;
                }
            }
    }
};
struct EpiDry {
    static constexpr bool PERM = true, AFTER_DRAIN = false;
    __device__ __forceinline__ void operator()(const f32x4 (&acc)[2][2][4][2], const Unit& u, int wr, int wc, int fr, int fq) const {
        f32x4 t = {0.f, 0.f, 0.f, 0.f};
#pragma unroll
        for (int ai = 0; ai < 2; ++ai)
#pragma unroll
            for (int bj = 0; bj < 2; ++bj)
#pragma unroll
                for (int m = 0; m < 4; ++m) t += acc[ai][bj][m][0] + acc[ai][bj][m][1];
        asm volatile("" :: "v"(t));
    }
};
template <int FIRST, int LAST> struct EpiOut {
    static constexpr bool PERM = true, AFTER_DRAIN = false;
    const float* xin; float* xout; bf16_t* xb; float* ssq;
    __device__ __forceinline__ void operator()(const f32x4 (&acc)[2][2][4][2], const Unit& u, int wr, int wc, int fr, int fq) const {
        const int row0 = u.pm * BM + wr * 64 + fr, col0 = u.pn * BM + wc * 32 + 8 * fq;
#pragma unroll
        for (int ai = 0; ai < 2; ++ai)
#pragma unroll
            for (int mh = 0; mh < 2; ++mh) {
                f32x4 xr[2][2][2];
                if (FIRST) {
#pragma unroll
                    for (int mm = 0; mm < 2; ++mm)
#pragma unroll
                        for (int bj = 0; bj < 2; ++bj)
#pragma unroll
                            for (int n = 0; n < 2; ++n) xr[mm][bj][n] = *(const f32x4*)(xin + (size_t)(row0 + ai * HALF + (2 * mh + mm) * 16) * DM + col0 + bj * HALF + 4 * n);
                } else {
                    u32x4 xw[2][2];
#pragma unroll
                    for (int mm = 0; mm < 2; ++mm)
#pragma unroll
                        for (int bj = 0; bj < 2; ++bj) xw[mm][bj] = *(const u32x4*)(xb + (size_t)(row0 + ai * HALF + (2 * mh + mm) * 16) * DM + col0 + bj * HALF);
                    asm volatile("" : "+v"(xw[0][0]), "+v"(xw[0][1]), "+v"(xw[1][0]), "+v"(xw[1][1]));
#pragma unroll
                    for (int mm = 0; mm < 2; ++mm)
#pragma unroll
                        for (int bj = 0; bj < 2; ++bj) { const u32x4 w = xw[mm][bj];
                            xr[mm][bj][0] = (f32x4){__uint_as_float(w.x << 16), __uint_as_float(w.x & 0xffff0000u), __uint_as_float(w.y << 16), __uint_as_float(w.y & 0xffff0000u)};
                            xr[mm][bj][1] = (f32x4){__uint_as_float(w.z << 16), __uint_as_float(w.z & 0xffff0000u), __uint_as_float(w.w << 16), __uint_as_float(w.w & 0xffff0000u)}; }
                }
#pragma unroll
                for (int mm = 0; mm < 2; ++mm) {
                    const int m = 2 * mh + mm, row = row0 + ai * HALF + m * 16; float ss = 0.f;
#pragma unroll
                    for (int bj = 0; bj < 2; ++bj) {
                        const size_t off = (size_t)row * DM + col0 + bj * HALF;
                        const f32x4 v0 = xr[mm][bj][0] + acc[ai][bj][m][0], v1 = xr[mm][bj][1] + acc[ai][bj][m][1];
                        if (LAST) { *(f32x4*)(xout + off) = v0; *(f32x4*)(xout + off + 4) = v1; }
                        else { u32x4 w; w.x = cvt_pk_bf16(v0[0], v0[1]); w.y = cvt_pk_bf16(v0[2], v0[3]); w.z = cvt_pk_bf16(v1[0], v1[1]); w.w = cvt_pk_bf16(v1[2], v1[3]); *(u32x4*)(xb + off) = w;
#pragma unroll
                               for (int e = 0; e < 4; ++e) { const unsigned ww = (e == 0) ? w.x : (e == 1) ? w.y : (e == 2) ? w.z : w.w; const float r0 = __uint_as_float(ww << 16), r1 = __uint_as_float(ww & 0xffff0000u); ss += r0 * r0 + r1 * r1; } }
                    }
                    if (!LAST) { ss = red16(ss); ss = red32(ss); if (fq == 0) ssq[(size_t)row * 16 + 4 * u.pn + wc] = ss; }
                }
                asm volatile("" ::: "memory");
            }
    }
};

struct EpiMem {
    static constexpr bool PERM = true, AFTER_DRAIN = false;
    bf16_t *memk, *memv; const float *ssqm, *gkm; int tm;
    __device__ __forceinline__ void operator()(const f32x4 (&acc)[2][2][4][2], const Unit& u, int wr, int wc, int fr, int fq) const {
        const int row0 = u.pm * BM + wr * 64 + fr, lane = fq * 16 + fr;
        float rs[2][4];
#pragma unroll
        for (int ai = 0; ai < 2; ++ai)
#pragma unroll
            for (int m = 0; m < 4; ++m) {
                const int row = row0 + ai * HALF + m * 16;
                const f32x4 p = *(const f32x4*)(ssqm + (size_t)row * 16 + fq * 4);
                float s = (p[0] + p[1]) + (p[2] + p[3]);
                s = red16(s); s = red32(s);
                rs[ai][m] = rsq_f(s * (1.f / 1024.f) + EPS);
            }
        const int layer = u.pn >> 1;
        if ((u.pn & 1) == 0) {
            bf16_t* dst = memk + (size_t)layer * tm * 256; const float* g = gkm + layer * 64;
            f32x4 gv[2][2];
#pragma unroll
            for (int bj = 0; bj < 2; ++bj)
#pragma unroll
                for (int n = 0; n < 2; ++n) gv[bj][n] = *(const f32x4*)(g + 32 * bj + 8 * fq + 4 * n);
#pragma unroll
            for (int ai = 0; ai < 2; ++ai)
#pragma unroll
                for (int m = 0; m < 4; ++m) {
                    f32x4 v[2][2]; float ss = 0.f;
#pragma unroll
                    for (int bj = 0; bj < 2; ++bj)
#pragma unroll
                        for (int n = 0; n < 2; ++n) { v[bj][n] = acc[ai][bj][m][n] * rs[ai][m]; const f32x4 t = v[bj][n]; ss += (t[0] * t[0] + t[1] * t[1]) + (t[2] * t[2] + t[3] * t[3]); }
                    ss = red16(ss); ss = red32(ss);
                    const float inv = rsq_f(ss * (1.f / 64.f) + EPS);
                    bf16_t* rowp = dst + (size_t)(row0 + ai * HALF + m * 16) * 256 + wc * 64 + 8 * fq;
#pragma unroll
                    for (int bj = 0; bj < 2; ++bj) {
                        const f32x4 a = v[bj][0] * inv * gv[bj][0], b = v[bj][1] * inv * gv[bj][1];
                        u32x4 w; w.x = cvt_pk_bf16(a[0], a[1]); w.y = cvt_pk_bf16(a[2], a[3]); w.z = cvt_pk_bf16(b[0], b[1]); w.w = cvt_pk_bf16(b[2], b[3]);
                        *(u32x4*)(rowp + 32 * bj) = w;
                    }
                }
        } else {
            bf16_t* dst = memv + (size_t)layer * tm * 256;
#pragma unroll
            for (int ai = 0; ai < 2; ++ai)
#pragma unroll
                for (int m = 0; m < 4; ++m) {
                    bf16_t* rowp = dst + (size_t)(row0 + ai * HALF + m * 16) * 256 + 32 * wc + 8 * fq;
#pragma unroll
                    for (int bj = 0; bj < 2; ++bj) {
                        const f32x4 a = acc[ai][bj][m][0] * rs[ai][m], b = acc[ai][bj][m][1] * rs[ai][m];
                        u32x4 w; w.x = cvt_pk_bf16(a[0], a[1]); w.y = cvt_pk_bf16(a[2], a[3]); w.z = cvt_pk_bf16(b[0], b[1]); w.w = cvt_pk_bf16(b[2], b[3]);
                        *(u32x4*)(rowp + HALF * bj) = w;
                    }
                }
        }
    }
};
template <class Epi, class Sched, bool ALIGN_EPI = false, bool SP2 = false>
__device__ __forceinline__ void gemm_phase(PG8_LAS unsigned char* lds, const Gemm g, const Sched& S, const Epi& E, int wv) {
    const int tid_l = wv * 64 + lane_id_opaque();
    const int tid = tid_l, wid = __builtin_amdgcn_readfirstlane(tid >> 6), lane = tid & 63, wr = wid >> 2, wc = wid & 3, fr = lane & 15, fq = lane >> 4;
    const int K = g.K, nt = K / BK;
    unsigned voffA[2], voffB[2];
#pragma unroll
    for (int i = 0; i < 2; ++i) { int R, C; stage_rc(tid * 16 + i * 8192, R, C); const int Rb = Epi::PERM ? ((R & ~31) + perm32(R & 31)) : R;
        voffA[i] = (unsigned)(R * K + C) * 2u; voffB[i] = (unsigned)(Rb * K + C) * 2u; }
    const size_t kstep = (size_t)(BK * 2);
    const size_t hstep = (size_t)HALF * K * 2;
    const size_t tstep = 2 * hstep;
    const unsigned ldsw = (unsigned)wid * 1024u;
    const int aoff = lds_byte(wr * 64 + fr, fq * 8), boff = lds_byte(wc * 32 + fr, fq * 8);
#define PG8_SA(b, h) (((b) * 2 + (h)) * HTB)
#define PG8_SB(b, h) ((4 + (b) * 2 + (h)) * HTB)
#define PG8_STAGE(bufoff, gbase, voff) do { _Pragma("unroll") for (int _i = 0; _i < 2; ++_i) \
        __builtin_amdgcn_global_load_lds((const unsigned*)((const char*)(gbase) + (voff)[_i]), (PG8_LAS unsigned*)(lds + (bufoff) + ldsw + _i * 8192), 16, 0, 0); } while (0)
#define PG8_LDA(dst, b, h) do { _Pragma("unroll") for (int m = 0; m < 4; ++m) _Pragma("unroll") for (int k = 0; k < 2; ++k) dst[m][k] = *(const PG8_LAS bf16x8*)(lds + PG8_SA(b, h) + aoff + m * 2048 + k * 1024); } while (0)
#define PG8_LDB(dst, b, h) do { _Pragma("unroll") for (int n = 0; n < 2; ++n) _Pragma("unroll") for (int k = 0; k < 2; ++k) dst[n][k] = *(const PG8_LAS bf16x8*)(lds + PG8_SB(b, h) + boff + n * 2048 + k * 1024); } while (0)
#define PG8_MMA(ai, bj, At, Bt) do { __builtin_amdgcn_s_setprio(1); _Pragma("unroll") for (int m = 0; m < 4; ++m) _Pragma("unroll") for (int n = 0; n < 2; ++n) _Pragma("unroll") for (int k = 0; k < 2; ++k) \
        acc[ai][bj][m][n] = __builtin_amdgcn_mfma_f32_16x16x32_bf16(Bt[n][k], At[m][k], acc[ai][bj][m][n], 0, 0, 0); __builtin_amdgcn_s_setprio(0); } while (0)
#define PG8_WAIT_V(n) asm volatile("s_waitcnt vmcnt(" #n ")" ::: "memory")
#define PG8_WAIT_L(n) asm volatile("s_waitcnt lgkmcnt(" #n ")" ::: "memory")
#define PG8_BAR __builtin_amdgcn_s_barrier()
#define PG8_SCHED __builtin_amdgcn_sched_barrier(0)
    Unit cur, nxt; int ui = 0;
    if (!S.next(0, cur)) return;
    f32x4 acc[2][2][4][2];
#pragma unroll
    for (int a = 0; a < 2; ++a)
#pragma unroll
        for (int b = 0; b < 2; ++b)
#pragma unroll
            for (int m = 0; m < 4; ++m)
#pragma unroll
                for (int n = 0; n < 2; ++n) acc[a][b][m][n] = (f32x4){0.f, 0.f, 0.f, 0.f};
    bf16x8 At[4][2], B0[2][2], B1[2][2];
    const char* cA = (const char*)g.A + (size_t)cur.pm * tstep; const char* cB = (const char*)g.Bt + (size_t)cur.pn * tstep;
    S.a_ready(cur);
    if constexpr (SP2) {
        PG8_STAGE(PG8_SB(0, 0), cB, voffB); PG8_STAGE(PG8_SB(0, 1), cB + hstep, voffB); PG8_STAGE(PG8_SA(0, 0), cA, voffA); PG8_STAGE(PG8_SA(0, 1), cA + hstep, voffA);
        if (wr == 1) PG8_BAR;
        PG8_WAIT_V(2); PG8_BAR;
        PG8_STAGE(PG8_SB(1, 0), cB + kstep, voffB); PG8_STAGE(PG8_SA(1, 0), cA + kstep, voffA); PG8_STAGE(PG8_SB(1, 1), cB + hstep + kstep, voffB);
        PG8_WAIT_V(6); PG8_BAR;
    } else {
        PG8_STAGE(PG8_SB(0, 0), cB, voffB); PG8_STAGE(PG8_SA(0, 0), cA, voffA); PG8_STAGE(PG8_SB(0, 1), cB + hstep, voffB); PG8_STAGE(PG8_SA(0, 1), cA + hstep, voffA);
        if (wr == 1) PG8_BAR;
        PG8_WAIT_V(4); PG8_BAR;
        PG8_STAGE(PG8_SB(1, 0), cB + kstep, voffB); PG8_STAGE(PG8_SA(1, 0), cA + kstep, voffA); PG8_STAGE(PG8_SB(1, 1), cB + hstep + kstep, voffB);
        PG8_WAIT_V(6); PG8_BAR;
    }
    for (;;) {
        const bool has_next = S.next(ui + 1, nxt);
        const char* nA = has_next ? (const char*)g.A + (size_t)nxt.pm * tstep : cA; const char* nB = has_next ? (const char*)g.Bt + (size_t)nxt.pn * tstep : cB;
        for (int t = 0; t < nt; t += 2) {
            const bool last = (t == nt - 2);
            const char* a1 = cA + (size_t)(t + 1) * kstep;
            const char* a2 = last ? nA : cA + (size_t)(t + 2) * kstep; const char* b2 = last ? nB : cB + (size_t)(t + 2) * kstep;
            const char* a3 = a2 + kstep; const char* b3 = b2 + kstep;
            if (last && has_next) S.a_ready(nxt);
            if constexpr (SP2) {
            PG8_LDB(B0, 0, 0); PG8_LDB(B1, 0, 1); PG8_SCHED; PG8_LDA(At, 0, 0); PG8_STAGE(PG8_SA(1, 1), a1 + hstep, voffA);
            PG8_WAIT_V(8); PG8_WAIT_L(0); PG8_BAR; PG8_MMA(0, 0, At, B0); PG8_MMA(0, 1, At, B1); PG8_BAR; PG8_SCHED;
            PG8_LDA(At, 0, 1); PG8_STAGE(PG8_SB(0, 0), b2, voffB); PG8_STAGE(PG8_SB(0, 1), b2 + hstep, voffB); PG8_STAGE(PG8_SA(0, 0), a2, voffA);
            PG8_WAIT_V(8); PG8_WAIT_L(0); PG8_BAR; PG8_MMA(1, 0, At, B0); PG8_MMA(1, 1, At, B1); PG8_BAR; PG8_SCHED;
            PG8_LDB(B0, 1, 0); PG8_LDB(B1, 1, 1); PG8_SCHED; PG8_LDA(At, 1, 0); PG8_STAGE(PG8_SA(0, 1), a2 + hstep, voffA);
            PG8_WAIT_V(8); PG8_WAIT_L(0); PG8_BAR; PG8_MMA(0, 0, At, B0); PG8_MMA(0, 1, At, B1); PG8_BAR; PG8_SCHED;
            PG8_LDA(At, 1, 1); PG8_STAGE(PG8_SB(1, 0), b3, voffB); PG8_STAGE(PG8_SB(1, 1), b3 + hstep, voffB); PG8_STAGE(PG8_SA(1, 0), a3, voffA);
            PG8_WAIT_V(8); PG8_WAIT_L(0); PG8_BAR; PG8_MMA(1, 0, At, B0); PG8_MMA(1, 1, At, B1); PG8_BAR; PG8_SCHED;
            } else {
            PG8_LDB(B0, 0, 0); PG8_SCHED; PG8_LDA(At, 0, 0); PG8_STAGE(PG8_SA(1, 1), a1 + hstep, voffA);
            PG8_WAIT_L(8); PG8_BAR; PG8_WAIT_L(0); PG8_MMA(0, 0, At, B0); PG8_BAR; PG8_SCHED;
            PG8_LDB(B1, 0, 1); PG8_STAGE(PG8_SB(0, 0), b2, voffB);
            PG8_BAR; PG8_WAIT_L(0); PG8_MMA(0, 1, At, B1); PG8_BAR;
            PG8_LDA(At, 0, 1); PG8_STAGE(PG8_SA(0, 0), a2, voffA);
            PG8_BAR; PG8_WAIT_L(0); PG8_MMA(1, 0, At, B0); PG8_BAR; PG8_SCHED;
            PG8_STAGE(PG8_SB(0, 1), b2 + hstep, voffB);
            PG8_WAIT_V(6); PG8_BAR; PG8_MMA(1, 1, At, B1); PG8_BAR;
            PG8_LDB(B0, 1, 0); PG8_SCHED; PG8_LDA(At, 1, 0); PG8_STAGE(PG8_SA(0, 1), a2 + hstep, voffA);
            PG8_WAIT_L(8); PG8_BAR; PG8_WAIT_L(0); PG8_MMA(0, 0, At, B0); PG8_BAR; PG8_SCHED;
            PG8_LDB(B1, 1, 1); PG8_STAGE(PG8_SB(1, 0), b3, voffB);
            PG8_BAR; PG8_WAIT_L(0); PG8_MMA(0, 1, At, B1); PG8_BAR;
            PG8_LDA(At, 1, 1); PG8_STAGE(PG8_SA(1, 0), a3, voffA);
            PG8_BAR; PG8_WAIT_L(0); PG8_MMA(1, 0, At, B0); PG8_BAR; PG8_SCHED;
            PG8_STAGE(PG8_SB(1, 1), b3 + hstep, voffB);
            PG8_WAIT_V(6); PG8_BAR; PG8_MMA(1, 1, At, B1); PG8_BAR;
            }
        }
        if constexpr (ALIGN_EPI) { if (wr == 0) PG8_BAR; }
        if constexpr (!Epi::AFTER_DRAIN) { E(acc, cur, wr, wc, fr, fq); S.done(cur); }
        if (!has_next) break;
#pragma unroll
        for (int a = 0; a < 2; ++a)
#pragma unroll
            for (int b = 0; b < 2; ++b)
#pragma unroll
                for (int m = 0; m < 4; ++m)
#pragma unroll
                    for (int n = 0; n < 2; ++n) acc[a][b][m][n] = (f32x4){0.f, 0.f, 0.f, 0.f};
        cur = nxt; cA = nA; cB = nB; ++ui;
        if constexpr (ALIGN_EPI) { if (wr == 1) PG8_BAR; }
    }
    PG8_WAIT_V(0);
    if constexpr (!ALIGN_EPI) { if (wr == 0) PG8_BAR; }
    PG8_BAR;
    if constexpr (Epi::AFTER_DRAIN) { E.fused(acc, cur, wr, wc, fr, fq, lds, wid, lane); S.done(cur); }
#undef PG8_SA
#undef PG8_SB
#undef PG8_STAGE
#undef PG8_LDA
#undef PG8_LDB
#undef PG8_MMA
#undef PG8_WAIT_V
#undef PG8_WAIT_L
#undef PG8_BAR
#undef PG8_SCHED
}
}

#define LAS __attribute__((address_space(3)))
typedef unsigned short bf16;
#define XB_TMO      128
#define XB_XCNT(j)  (256  + 64 * (j))
#define XB_XSUB(j)  (1280 + 64 * (j))
#define XB_XGEN(j)  (2304 + 64 * (j))
#define XB_TOP      3328
#define XB_TOPGEN   3392
#define XCD_BAR_WORDS 3456
#define XB_SPIN_CAP (1u << 18)

__device__ __forceinline__ unsigned xb_ld(unsigned* p)              { return __hip_atomic_load(p, __ATOMIC_RELAXED, __HIP_MEMORY_SCOPE_AGENT); }
__device__ __forceinline__ unsigned xb_add(unsigned* p, unsigned v) { return __hip_atomic_fetch_add(p, v, __ATOMIC_RELAXED, __HIP_MEMORY_SCOPE_AGENT); }
__device__ __forceinline__ unsigned xb_xcc_id() { return (unsigned)__builtin_amdgcn_s_getreg((3 << 11) | 20) & 0xFu; }
#define XB_SPIN(cond, bar) do { unsigned _sp = 0; while (cond) { __builtin_amdgcn_s_sleep(1); \
    if ((++_sp & 255u) == 0u) { if (xb_ld(&(bar)[XB_TMO])) break; if (_sp > XB_SPIN_CAP) { atomicAdd(&(bar)[XB_TMO], 1u); break; } } } } while (0)

struct XcdBarrier {
    unsigned* bar; unsigned x;
    volatile LAS unsigned* st;
};

__device__ __forceinline__ XcdBarrier xcd_barrier_post(unsigned* bar, volatile LAS unsigned* st, int tid) {
    XcdBarrier b; b.bar = bar; b.x = xb_xcc_id(); b.st = st;
    if (tid == 0) (void)xb_add(&bar[XB_XCNT(b.x)], 1u);
    return b;
}
__device__ __forceinline__ void xcd_barrier_complete(unsigned* bar, unsigned x, unsigned& nloc, unsigned& nx) {
    const unsigned G = gridDim.x * gridDim.y * gridDim.z;
    unsigned sum, cnt, mine, sp = 0u;
    for (;;) {
        sum = 0u; cnt = 0u; mine = 0u;
#pragma unroll
        for (unsigned j = 0; j < 16; ++j) { const unsigned c = xb_ld(&bar[XB_XCNT(j)]); sum += c; cnt += (c > 0u) ? 1u : 0u; mine = (j == x) ? c : mine; }
        if (sum == G) break;
        __builtin_amdgcn_s_sleep(1);
        if ((++sp & 255u) == 0u) { if (xb_ld(&bar[XB_TMO])) break; if (sp > XB_SPIN_CAP) { atomicAdd(&bar[XB_TMO], 1u); break; } }
    }
    nloc = mine > 0u ? mine : 1u; nx = cnt > 0u ? cnt : 1u;
}

__device__ __forceinline__ void xcd_barrier(const XcdBarrier& b, int wv) {
    const int tid = wv * 64 + lane_id_opaque();
    asm volatile("s_waitcnt vmcnt(0)" ::: "memory");
    __syncthreads();
    if (tid == 0) {
        unsigned* bar = b.bar;
        __builtin_amdgcn_s_waitcnt(0);
        unsigned nloc = b.st[0], nx = b.st[1];
        if (nloc == 0u) { xcd_barrier_complete(bar, b.x, nloc, nx); b.st[0] = nloc; b.st[1] = nx; }
        const unsigned old = xb_add(&bar[XB_XSUB(b.x)], 1u);
        const unsigned gen = old / nloc;
        if (old + 1u == (gen + 1u) * nloc) {
            __builtin_amdgcn_fence(__ATOMIC_RELEASE, "agent");
            asm volatile("s_waitcnt vmcnt(0)" ::: "memory");
            const unsigned og = xb_add(&bar[XB_TOP], 1u);
            const unsigned tg = og / nx;
            if (og + 1u == (tg + 1u) * nx) xb_add(&bar[XB_TOPGEN], 1u);
            else XB_SPIN(xb_ld(&bar[XB_TOPGEN]) == tg, bar);
            __builtin_amdgcn_fence(__ATOMIC_ACQUIRE, "agent");
            xb_add(&bar[XB_XGEN(b.x)], 1u);
            asm volatile("s_waitcnt vmcnt(0)" ::: "memory");
        } else {
            XB_SPIN(xb_ld(&bar[XB_XGEN(b.x)]) == gen, bar);
            __builtin_amdgcn_fence(__ATOMIC_ACQUIRE, "agent");
            asm volatile("s_waitcnt vmcnt(0)" ::: "memory");
        }
    }
    __syncthreads();
}


#define GAS __attribute__((address_space(1)))
constexpr int NWAVES = 8, NTHREADS = 512;
constexpr int RING_BYTES = 131072, LDS_BYTES = 163840, MISC_OFF = LDS_BYTES - 512;

__device__ __forceinline__ float bf2f(unsigned short b) { return __uint_as_float((unsigned)b << 16); }
__device__ __forceinline__ unsigned f2bf(float f) { unsigned u = __float_as_uint(f); return (u + 0x7fffu + ((u >> 16) & 1u)) >> 16; }
__device__ __forceinline__ unsigned pk2(float lo, float hi) { return f2bf(lo) | (f2bf(hi) << 16); }
__device__ __forceinline__ float wave_sum(float v, int lane) {
#pragma unroll
    for (int o = 1; o < 64; o <<= 1) v += shx(v, o, lane);
    return v;
}
__device__ __forceinline__ float wave_max(float v, int lane) {
#pragma unroll
    for (int o = 1; o < 64; o <<= 1) v = fmaxf(v, shx(v, o, lane));
    return v;
}

constexpr size_t al256(size_t x) { return (x + 255) & ~(size_t)255; }
constexpr size_t O_CTL = 0;
constexpr size_t O_WT_IN = O_CTL + (1 << 16);
constexpr size_t O_WT_OUT = O_WT_IN + al256((size_t)DEPTH * NINP * DM * 2);
constexpr size_t O_WT_MEM = O_WT_OUT + al256((size_t)DEPTH * DM * DM * 2);
constexpr size_t O_XB = O_WT_MEM + al256((size_t)DEPTH * 512 * DM * 2);
constexpr size_t O_QA = O_XB + al256((size_t)T * DM * 2);
constexpr size_t O_KA = O_QA + al256((size_t)T * 512 * 2);
constexpr size_t O_VA = O_KA + al256((size_t)T * 512 * 2);
constexpr size_t O_CB = O_VA + al256((size_t)T * 512 * 2);
constexpr size_t O_QBKB = O_CB + al256((size_t)T * 1024 * 2);
constexpr size_t O_VB = O_QBKB + al256((size_t)T * 256 * 2);
constexpr size_t O_QM = O_VB + al256((size_t)T * 256 * 2);
constexpr size_t O_SSQ = O_QM + al256((size_t)T * 256 * 2);
constexpr size_t O_LA = O_SSQ + al256((size_t)T * 16 * 4);
constexpr size_t O_KMP = O_LA + al256((size_t)T * 128 * 4);
constexpr size_t O_LISTS = O_KMP + al256((size_t)BATCH * 8 * NB * 2 * 64 * 4);
constexpr size_t O_GCNT = O_LISTS + al256((size_t)BATCH * 8 * 256 * 2016 * 2);
constexpr size_t O_PARTO = O_GCNT + al256(1024 * 4);
constexpr size_t O_PARTL = O_PARTO + al256((size_t)T * 8 * 3 * 64 * 2);
constexpr size_t O_MEMK = O_PARTL + al256((size_t)T * 8 * 4 * 4);
constexpr size_t O_MEMV = O_MEMK + al256((size_t)DEPTH * TM * 256 * 2);
constexpr size_t O_MEMBF = O_MEMV + al256((size_t)DEPTH * TM * 256 * 2);
constexpr size_t O_SSQM = O_MEMBF + al256((size_t)TM * DM * 2);
constexpr size_t O_U = O_SSQM + al256((size_t)TM * 16 * 4);
constexpr size_t O_SST = O_U + al256((size_t)BATCH * 4 * NCH * 2048 * 4);
constexpr size_t O_DC = O_SST + al256((size_t)BATCH * 4 * NCH * 2048 * 4);
constexpr size_t O_PMASK = O_DC + al256((size_t)BATCH * 4 * NCH * 32 * 4);
constexpr size_t WS_END = O_PMASK + al256((size_t)T * 8);
static_assert(WS_END <= (size_t)536870912, "workspace map exceeds 4 x largest tensor");

struct KArgs {
    const float *x, *mem, *g_pre, *w_in, *g_q_moba, *g_k_moba, *w_gate_up, *b_gate_up, *g_gla_out, *g_mem, *w_mem_kv, *g_q_mem, *g_k_mem, *w_out;
    float* out;
    unsigned char* ws;
    int ph_lo, ph_hi;
};
struct Args {
    const __attribute__((address_space(4))) KArgs* kp;
    __device__ __forceinline__ const float* x() const { return kp->x; }
    __device__ __forceinline__ const float* mem() const { return kp->mem; }
    __device__ __forceinline__ const float* g_pre() const { return kp->g_pre; }
    __device__ __forceinline__ const float* w_in() const { return kp->w_in; }
    __device__ __forceinline__ const float* g_q_moba() const { return kp->g_q_moba; }
    __device__ __forceinline__ const float* g_k_moba() const { return kp->g_k_moba; }
    __device__ __forceinline__ const float* w_gate_up() const { return kp->w_gate_up; }
    __device__ __forceinline__ const float* b_gate_up() const { return kp->b_gate_up; }
    __device__ __forceinline__ const float* g_gla_out() const { return kp->g_gla_out; }
    __device__ __forceinline__ const float* g_mem() const { return kp->g_mem; }
    __device__ __forceinline__ const float* w_mem_kv() const { return kp->w_mem_kv; }
    __device__ __forceinline__ const float* g_q_mem() const { return kp->g_q_mem; }
    __device__ __forceinline__ const float* g_k_mem() const { return kp->g_k_mem; }
    __device__ __forceinline__ const float* w_out() const { return kp->w_out; }
    __device__ __forceinline__ float* out() const { return kp->out; }
    __device__ __forceinline__ unsigned char* ws() const { return kp->ws; }
    __device__ __forceinline__ unsigned* ctl() const { return (unsigned*)(kp->ws + O_CTL); }
    __device__ __forceinline__ bf16* wt_in() const { return (bf16*)(kp->ws + O_WT_IN); }
    __device__ __forceinline__ bf16* wt_out() const { return (bf16*)(kp->ws + O_WT_OUT); }
    __device__ __forceinline__ bf16* wt_mem() const { return (bf16*)(kp->ws + O_WT_MEM); }
    __device__ __forceinline__ bf16* xb() const { return (bf16*)(kp->ws + O_XB); }
    __device__ __forceinline__ bf16* qa() const { return (bf16*)(kp->ws + O_QA); }
    __device__ __forceinline__ bf16* ka() const { return (bf16*)(kp->ws + O_KA); }
    __device__ __forceinline__ bf16* va() const { return (bf16*)(kp->ws + O_VA); }
    __device__ __forceinline__ bf16* cb() const { return (bf16*)(kp->ws + O_CB); }
    __device__ __forceinline__ bf16* qbkb() const { return (bf16*)(kp->ws + O_QBKB); }
    __device__ __forceinline__ bf16* vb() const { return (bf16*)(kp->ws + O_VB); }
    __device__ __forceinline__ bf16* qm() const { return (bf16*)(kp->ws + O_QM); }
    __device__ __forceinline__ float* ssq() const { return (float*)(kp->ws + O_SSQ); }
    __device__ __forceinline__ float* la() const { return (float*)(kp->ws + O_LA); }
    __device__ __forceinline__ float* kmp() const { return (float*)(kp->ws + O_KMP); }
    __device__ __forceinline__ unsigned short* lists() const { return (unsigned short*)(kp->ws + O_LISTS); }
    __device__ __forceinline__ unsigned* gcnt() const { return (unsigned*)(kp->ws + O_GCNT); }
    __device__ __forceinline__ bf16* partO() const { return (bf16*)(kp->ws + O_PARTO); }
    __device__ __forceinline__ float* partL() const { return (float*)(kp->ws + O_PARTL); }
    __device__ __forceinline__ bf16* memk() const { return (bf16*)(kp->ws + O_MEMK); }
    __device__ __forceinline__ bf16* memv() const { return (bf16*)(kp->ws + O_MEMV); }
    __device__ __forceinline__ bf16* membf() const { return (bf16*)(kp->ws + O_MEMBF); }
    __device__ __forceinline__ float* ssqm() const { return (float*)(kp->ws + O_SSQM); }
    __device__ __forceinline__ float* U() const { return (float*)(kp->ws + O_U); }
    __device__ __forceinline__ float* Sst() const { return (float*)(kp->ws + O_SST); }
    __device__ __forceinline__ float* Dc() const { return (float*)(kp->ws + O_DC); }
    __device__ __forceinline__ unsigned char* pmask() const { return (unsigned char*)(kp->ws + O_PMASK); }
};


typedef short s16x8 __attribute__((ext_vector_type(8)));
typedef short s16x4 __attribute__((ext_vector_type(4)));
typedef float f32x16 __attribute__((ext_vector_type(16)));
typedef float f32x2_t __attribute__((ext_vector_type(2)));
typedef __bf16 bf16x2_t __attribute__((ext_vector_type(2)));
constexpr int KIMG_CH = 4112;
constexpr int VIMG_DH = 16448;
constexpr int KIMG_OFF = 0, VIMG_OFF = 8 * KIMG_CH, ATT_LDS_END = VIMG_OFF + 2 * VIMG_DH;
constexpr int LIST_PER_BH = 256 * 2016;
__device__ __forceinline__ int list_off(int j) { return 256 * (63 * j - (j * (j - 1)) / 2); }
__device__ __forceinline__ int crow(int r, int hi) { return (r & 3) + 8 * (r >> 2) + 4 * hi; }
__device__ __forceinline__ unsigned cvtpk(float lo, float hi) { f32x2_t v = {lo, hi}; bf16x2_t b = __builtin_convertvector(v, bf16x2_t); return __builtin_bit_cast(unsigned, b); }
__device__ __forceinline__ s16x4 vtr(const LAS unsigned char* p) { typedef short v4i16_t __attribute__((ext_vector_type(4))); return __builtin_bit_cast(s16x4, __builtin_amdgcn_ds_read_tr16_b64_v4i16((LAS v4i16_t*)p)); }

struct KVRegs { uint4 k[4], v[4]; };
__device__ __forceinline__ void kv_issue(KVRegs& r, const bf16* kg, const bf16* vg, int stride, int tid) {
    const int c = tid & 7, k0 = tid >> 3;
#pragma unroll
    for (int i = 0; i < 4; ++i) { const size_t o = (size_t)(k0 + 64 * i) * stride + c * 8; r.k[i] = *(const uint4*)(kg + o); r.v[i] = *(const uint4*)(vg + o); }
}
__device__ __forceinline__ void kv_commit(LAS unsigned char* L, const KVRegs& r, int tid) {
    const int c = tid & 7, k0 = tid >> 3;
#pragma unroll
    for (int i = 0; i < 4; ++i) { const int key = k0 + 64 * i;
        *(LAS pg8::u32x4*)(L + KIMG_OFF + c * KIMG_CH + key * 16) = (pg8::u32x4){r.k[i].x, r.k[i].y, r.k[i].z, r.k[i].w};
        *(LAS pg8::u32x4*)(L + VIMG_OFF + (c >> 2) * VIMG_DH + key * 64 + (c & 3) * 16) = (pg8::u32x4){r.v[i].x, r.v[i].y, r.v[i].z, r.v[i].w}; }
}
__device__ __forceinline__ void load_kv_tiles(LAS unsigned char* L, const bf16* kg, const bf16* vg, int stride, int tid) { KVRegs r; kv_issue(r, kg, vg, stride, tid); kv_commit(L, r, tid); }
__device__ __forceinline__ void attn_tiles(const LAS unsigned char* L, const s16x8 (&qf)[4], f32x16& cin, float cstep, int kt0, int kt1, int mask_kt, int r32, int hi, int lane, f32x16 (&o)[2], float& lsum) {
    const LAS unsigned char* kp = L + KIMG_OFF + hi * KIMG_CH + r32 * 16;
    const LAS unsigned char* vp = L + VIMG_OFF + ((lane >> 4) & 1) * 32 + (lane & 3) * 8 + (4 * hi + ((lane & 15) >> 2)) * 64;
    for (int kt = kt0; kt < kt1; ++kt) {
        f32x16 s = cin;
#pragma unroll
        for (int d0 = 0; d0 < 4; ++d0) { const s16x8 kf = *(const LAS s16x8*)(kp + 2 * d0 * KIMG_CH + kt * 512); s = __builtin_amdgcn_mfma_f32_32x32x16_bf16(kf, qf[d0], s, 0, 0, 0); }
        if (kt == mask_kt) {
#pragma unroll
            for (int r = 0; r < 16; ++r) if (crow(r, hi) > r32) s[r] = -INFINITY;
        }
        float ps = 0.f;
#pragma unroll
        for (int r = 0; r < 16; ++r) { s[r] = __builtin_amdgcn_exp2f(s[r]); ps += s[r]; }
        lsum += ps;
        union { unsigned w[4]; s16x8 v; } p0, p1;
#pragma unroll
        for (int e = 0; e < 4; ++e) { p0.w[e] = cvtpk(s[2 * e], s[2 * e + 1]); p1.w[e] = cvtpk(s[8 + 2 * e], s[8 + 2 * e + 1]); }
#pragma unroll
        for (int dh = 0; dh < 2; ++dh) {
            const LAS unsigned char* vq = vp + dh * VIMG_DH + kt * 2048;
            const s16x4 a0 = vtr(vq), a1 = vtr(vq + 512), a2 = vtr(vq + 1024), a3 = vtr(vq + 1536);
            const s16x8 f0 = {a0[0], a0[1], a0[2], a0[3], a1[0], a1[1], a1[2], a1[3]}, f1 = {a2[0], a2[1], a2[2], a2[3], a3[0], a3[1], a3[2], a3[3]};
            o[dh] = __builtin_amdgcn_mfma_f32_32x32x16_bf16(f0, p0.v, o[dh], 0, 0, 0);
            o[dh] = __builtin_amdgcn_mfma_f32_32x32x16_bf16(f1, p1.v, o[dh], 0, 0, 0);
        }
#pragma unroll
        for (int r = 0; r < 16; ++r) cin[r] += cstep;
    }
}
__device__ __forceinline__ void load_qfrag(s16x8 (&qf)[4], const bf16* qrow, int hi) {
#pragma unroll
    for (int d0 = 0; d0 < 4; ++d0) qf[d0] = *(const s16x8*)(qrow + 16 * d0 + 8 * hi);
}
__device__ __forceinline__ float softmax_ref(const float* gq, const float* gk) {
    const int lane = lane_id_opaque();
    const float a = wave_max(fabsf(gq[lane]), lane), b = wave_max(fabsf(gk[lane]), lane);
    return 64.f * QSCALE * a * b * 1.01f;
}

__device__ __forceinline__ float zero_thr(float Mref) { return 104.f + 2.f * Mref * 0.6931471805599453f + 1.f; }

__device__ __forceinline__ size_t hm_off(int b, int h, int t) { return (((size_t)(b * 8 + h)) * SEQ + t) * 64; }
struct RouteRaw { s16x8 q[4]; float km[16]; };
__device__ __forceinline__ void route_decode(int p, int& bh, int& i) { i = 63 - (p >> 4); bh = p & 15; }
__device__ __forceinline__ void route_raw_issue(const Args& a, RouteRaw& r, int unit, int tid) {
    int bh, i; route_decode(unit, bh, i); const int b = bh >> 3, h = bh & 7;
    load_qfrag(r.q, a.qa() + hm_off(b, h, i * 256 + (tid >> 6) * 32 + (tid & 31)), (tid >> 5) & 1);
#pragma unroll
    for (int k = 0; k < 8; ++k) { const int e = tid + NTHREADS * k;
        if (e < i * 64) { const float* p = a.kmp() + (((size_t)bh * 64 + (e >> 6)) * 2) * 64 + (e & 63); r.km[2 * k] = p[0]; r.km[2 * k + 1] = p[64]; } }
}
__device__ __forceinline__ void top3_insert(float s, int j, float& v0, float& v1, float& v2, int& i0, int& i1, int& i2) {
    const bool g0 = s > v0, g1 = s > v1, g2 = s > v2;
    v2 = g1 ? v1 : (g2 ? s : v2); i2 = g1 ? i1 : (g2 ? j : i2);
    v1 = g0 ? v0 : (g1 ? s : v1); i1 = g0 ? i0 : (g1 ? j : i1);
    v0 = g0 ? s : v0; i0 = g0 ? j : i0;
}
__device__ __forceinline__ void moba_route_phase(const Args& a, LAS unsigned char* L, int wv, int bid, int G, float zthr, int dry) {
    constexpr int KMP = 64 * 16 + 16;
    LAS unsigned short* kmh = (LAS unsigned short*)L; LAS unsigned short* kml = (LAS unsigned short*)(L + 8 * KMP);
    LAS int* cnt = (LAS int*)(L + 16 * KMP);
    LAS int* basep = cnt + 64;
    const int NU = BATCH * 8 * 63;
    int rnd = 0;
    int unit = bid;
    RouteRaw R;
    if (unit < NU) route_raw_issue(a, R, unit, wv * 64 + lane_id_opaque());
    while (unit < NU) {
        const int tid = wv * 64 + lane_id_opaque(), lane = tid & 63, r32 = lane & 31, hi = lane >> 5;
        int bh, i; route_decode(unit, bh, i); const int b = bh >> 3, h = bh & 7;
#pragma unroll
        for (int k = 0; k < 8; ++k) { const int e = tid + NTHREADS * k; if (e < i * 64) { const int j = e >> 6, d = e & 63; const float v = R.km[2 * k] + R.km[2 * k + 1];
                const unsigned hb = f2bf(v); const float vh = __uint_as_float(hb << 16); const unsigned lb = f2bf(v - vh);
                const int off = (d >> 3) * (KMP / 2) + j * 8 + (d & 7); kmh[off] = (unsigned short)hb; kml[off] = (unsigned short)lb; } }
        if (tid < 64) cnt[tid] = 0;
        const int t = i * 256 + wv * 32 + r32;
        s16x8 qf[4];
#pragma unroll
        for (int c = 0; c < 4; ++c) qf[c] = R.q[c];
        ++rnd;
        const int nunit = rnd * G + ((rnd & 1) ? (G - 1 - bid) : bid);
        if (nunit < NU) route_raw_issue(a, R, nunit, tid);
        __syncthreads();
        float v0 = -INFINITY, v1 = -INFINITY, v2 = -INFINITY; int i0 = 1 << 20, i1 = 1 << 20, i2 = 1 << 20;
        const int njt = i > 32 ? 2 : 1;
        for (int jt = 0; jt < njt; ++jt) {
            f32x16 g;
#pragma unroll
            for (int r = 0; r < 16; ++r) g[r] = 0.f;
            const LAS unsigned char* kh = (const LAS unsigned char*)kmh + hi * KMP + (32 * jt + r32) * 16;
            const LAS unsigned char* kl = (const LAS unsigned char*)kml + hi * KMP + (32 * jt + r32) * 16;
#pragma unroll
            for (int ks = 0; ks < 4; ++ks) {
                g = __builtin_amdgcn_mfma_f32_32x32x16_bf16(*(const LAS s16x8*)(kh + 2 * ks * KMP), qf[ks], g, 0, 0, 0);
                g = __builtin_amdgcn_mfma_f32_32x32x16_bf16(*(const LAS s16x8*)(kl + 2 * ks * KMP), qf[ks], g, 0, 0, 0);
            }
#pragma unroll
            for (int r = 0; r < 16; ++r) { const int j = 32 * jt + crow(r, hi); const float sv = (j < i) ? g[r] : -INFINITY; top3_insert(sv, j, v0, v1, v2, i0, i1, i2); }
        }
        {
            const auto x0 = __builtin_amdgcn_permlane32_swap(__float_as_uint(v0), __float_as_uint(v0), false, false), x1 = __builtin_amdgcn_permlane32_swap(__float_as_uint(v1), __float_as_uint(v1), false, false), x2 = __builtin_amdgcn_permlane32_swap(__float_as_uint(v2), __float_as_uint(v2), false, false);
            const auto y0 = __builtin_amdgcn_permlane32_swap((unsigned)i0, (unsigned)i0, false, false), y1 = __builtin_amdgcn_permlane32_swap((unsigned)i1, (unsigned)i1, false, false), y2 = __builtin_amdgcn_permlane32_swap((unsigned)i2, (unsigned)i2, false, false);
            const float pv[3] = {__uint_as_float(hi ? x0[0] : x0[1]), __uint_as_float(hi ? x1[0] : x1[1]), __uint_as_float(hi ? x2[0] : x2[1])};
            const int pi[3] = {(int)(hi ? y0[0] : y0[1]), (int)(hi ? y1[0] : y1[1]), (int)(hi ? y2[0] : y2[1])};
#pragma unroll
            for (int c = 0; c < 3; ++c) {
                const float sv = pv[c]; const int j = pi[c];
                const bool g0 = sv > v0 || (sv == v0 && j < i0), g1 = sv > v1 || (sv == v1 && j < i1), g2 = sv > v2 || (sv == v2 && j < i2);
                v2 = g1 ? v1 : (g2 ? sv : v2); i2 = g1 ? i1 : (g2 ? j : i2);
                v1 = g0 ? v0 : (g1 ? sv : v1); i1 = g0 ? i0 : (g1 ? j : i1);
                v0 = g0 ? sv : v0; i0 = g0 ? j : i0;
            }
        }
        int rk0 = 0, rk1 = 0, rk2 = 0; const int nsel = i < 3 ? i : 3; bool k0 = false, k1 = false, k2 = false;
        if (hi == 0) {
            if (dry) asm volatile("" :: "v"(i0), "v"(i1), "v"(i2));
            const float slope = exp2f(-(float)(h + 1));
            k0 = nsel > 0 && !(slope * (float)(t - 256 * i0 - 255) > zthr);
            k1 = nsel > 1 && !(slope * (float)(t - 256 * i1 - 255) > zthr);
            k2 = nsel > 2 && !(slope * (float)(t - 256 * i2 - 255) > zthr);
            if (!dry) a.pmask()[((size_t)(b * SEQ + t)) * 8 + h] = (unsigned char)((k0 ? 1 : 0) | (k1 ? 2 : 0) | (k2 ? 4 : 0));
            if (!dry && k0) rk0 = __hip_atomic_fetch_add(cnt + i0, 1, __ATOMIC_RELAXED, __HIP_MEMORY_SCOPE_WORKGROUP);
            if (!dry && k1) rk1 = __hip_atomic_fetch_add(cnt + i1, 1, __ATOMIC_RELAXED, __HIP_MEMORY_SCOPE_WORKGROUP);
            if (!dry && k2) rk2 = __hip_atomic_fetch_add(cnt + i2, 1, __ATOMIC_RELAXED, __HIP_MEMORY_SCOPE_WORKGROUP);
        }
        __syncthreads();
        if (!dry && tid < i) { const int c = cnt[tid]; basep[tid] = c > 0 ? (int)atomicAdd(a.gcnt() + bh * 64 + tid, (unsigned)c) : 0; }
        __syncthreads();
        if (!dry && hi == 0) {
            unsigned short* lst = a.lists() + (size_t)bh * LIST_PER_BH;
            if (k0) lst[list_off(i0) + basep[i0] + rk0] = (unsigned short)(t | (0 << 14));
            if (k1) lst[list_off(i1) + basep[i1] + rk1] = (unsigned short)(t | (1 << 14));
            if (k2) lst[list_off(i2) + basep[i2] + rk2] = (unsigned short)(t | (2 << 14));
        }
        unit = nunit;
        __syncthreads();
    }
}

__device__ __forceinline__ void moba_pairs_phase(const Args& a, int l, LAS unsigned char* L, int wv, int bid, int G, int dry = 0) {
    const int tid = wv * 64 + lane_id_opaque(), lane = tid & 63, wid = wv;
    LAS int* pre = (LAS int*)(L + ATT_LDS_END);
    LAS int* cntl = pre + 1028;
    LAS int* wtot = cntl + 1024;
    {
        const int c0 = (int)a.gcnt()[2 * tid], c1 = (int)a.gcnt()[2 * tid + 1];
        cntl[2 * tid] = c0; cntl[2 * tid + 1] = c1;
        const int n0 = (c0 + 255) >> 8, n1 = (c1 + 255) >> 8;
        int s = n0 + n1;
#pragma unroll
        for (int o = 1; o < 64; o <<= 1) { const int v = shup_i(s, o, lane); if (lane >= o) s += v; }
        if (lane == 63) wtot[wid] = s;
        __syncthreads();
        int wb = 0;
        for (int w = 0; w < wid; ++w) wb += wtot[w];
        const int excl = wb + s - (n0 + n1);
        pre[2 * tid] = excl; pre[2 * tid + 1] = excl + n0;
        if (tid == NTHREADS - 1) pre[1024] = excl + n0 + n1;
        __syncthreads();
    }
    const int total = pre[1024];
    LAS int* itab = wtot + 8;
    if (tid < 64) { const int it = bid + tid * G; int lo = 0, hh = 1023;
        if (it < total) { while (lo < hh) { const int mid = (lo + hh + 1) >> 1; if (pre[mid] <= it) lo = mid; else hh = mid - 1; } }
        itab[tid] = lo; }
    __syncthreads();
    const float Mref = softmax_ref(a.g_q_moba() + l * 64, a.g_k_moba() + l * 64);
    KVRegs kvr; s16x8 qf[4], qfn[4]; int tq = 0, slot = 0, cb_ = 0, ch_ = 0, cj_ = 0; bool valid = false;
    int ntq = 0, nslot = 0, nb_ = 0, nh_ = 0, nj_ = 0; bool nvalid = false; unsigned ne = 0;
    int item = bid;
#define PAIR_META(IT, B_, H_, J_, VALID_, E_) do { \
        const int tid2 = wv * 64 + lane_id_opaque(), lane2 = tid2 & 63; \
        const int bhj = itab[((IT) - bid) / G], chunk = (IT) - pre[bhj], n = cntl[bhj], bh = bhj >> 6; \
        J_ = bhj & 63; B_ = bh >> 3; H_ = bh & 7; \
        kv_issue(kvr, a.ka() + hm_off(B_, H_, J_ * 256), a.va() + hm_off(B_, H_, J_ * 256), 64, tid2); \
        int idx = chunk * 256 + wv * 32 + (lane2 & 31); VALID_ = idx < n; if (!VALID_) idx = n - 1; \
        E_ = a.lists()[(size_t)bh * LIST_PER_BH + list_off(J_) + idx]; } while (0)
    if (item < total) {
        unsigned e0; PAIR_META(item, cb_, ch_, cj_, valid, e0);
        tq = e0 & 0x3fff; slot = e0 >> 14;
        load_qfrag(qf, a.qa() + hm_off(cb_, ch_, tq), (lane_id_opaque() >> 5));
    }
    while (item < total) {
        const int tid2 = wv * 64 + lane_id_opaque(), lane = tid2 & 63, r32 = lane & 31, hi = lane >> 5;
        const int nitem = item + G; const bool has_next = nitem < total;
        __syncthreads();
        kv_commit(L, kvr, tid2);
        if (has_next) PAIR_META(nitem, nb_, nh_, nj_, nvalid, ne);
        __syncthreads();
        const size_t tok = (size_t)cb_ * SEQ + tq;
        const float slope2 = exp2f(-(float)(ch_ + 1)) * LOG2E;
        f32x16 cin;
#pragma unroll
        for (int r = 0; r < 16; ++r) cin[r] = fmaf(-slope2, (float)(tq - 256 * cj_ - crow(r, hi)), -Mref);
        f32x16 o[2]; float lsum = 0.f;
#pragma unroll
        for (int r = 0; r < 16; ++r) { o[0][r] = 0.f; o[1][r] = 0.f; }
        attn_tiles(L, qf, cin, 32.f * slope2, 0, 4, -1, r32, hi, lane, o, lsum);
        if (has_next) { ntq = ne & 0x3fff; nslot = ne >> 14; load_qfrag(qfn, a.qa() + hm_off(nb_, nh_, ntq), hi); }
        attn_tiles(L, qf, cin, 32.f * slope2, 4, 8, -1, r32, hi, lane, o, lsum);
        lsum = red32(lsum);
        if (dry) asm volatile("" :: "v"(o[0]), "v"(o[1]), "v"(lsum));
        if (valid && !dry) {
            const size_t pidx = (tok * 8 + ch_) * 3 + slot;
            bf16* po = a.partO() + pidx * 64;
#pragma unroll
            for (int dh = 0; dh < 2; ++dh)
#pragma unroll
                for (int g2 = 0; g2 < 2; ++g2) { uint4 w;
                    w.x = cvtpk(o[dh][8 * g2], o[dh][8 * g2 + 1]); w.y = cvtpk(o[dh][8 * g2 + 2], o[dh][8 * g2 + 3]); w.z = cvtpk(o[dh][8 * g2 + 4], o[dh][8 * g2 + 5]); w.w = cvtpk(o[dh][8 * g2 + 6], o[dh][8 * g2 + 7]);
                    *(uint4*)(po + 32 * hi + 16 * dh + 8 * g2) = w; }
            if (hi == 0) a.partL()[(tok * 8 + ch_) * 4 + slot] = lsum;
        }
#pragma unroll
        for (int d0 = 0; d0 < 4; ++d0) qf[d0] = qfn[d0];
        tq = ntq; slot = nslot; cb_ = nb_; ch_ = nh_; cj_ = nj_; valid = nvalid;
        item = nitem;
    }
#undef PAIR_META
    __syncthreads();
}

__device__ __forceinline__ void row_load_pieces(const bf16* row, int hi, uint2 (&pc)[8]) {
#pragma unroll
    for (int k = 0; k < 4; ++k) {
        const uint4 w = *(const uint4*)(row + 8 * (2 * k + hi));
        const auto s0 = __builtin_amdgcn_permlane32_swap(w.x, w.z, false, false), s1 = __builtin_amdgcn_permlane32_swap(w.y, w.w, false, false);
        pc[2 * k] = make_uint2(s0[0], s1[0]); pc[2 * k + 1] = make_uint2(s0[1], s1[1]);
    }
}
__device__ __forceinline__ void row_store_pieces(bf16* row, int hi, const uint2 (&pc)[8]) {
#pragma unroll
    for (int k = 0; k < 4; ++k) {
        const auto s0 = __builtin_amdgcn_permlane32_swap(pc[2 * k].x, pc[2 * k + 1].x, false, false), s1 = __builtin_amdgcn_permlane32_swap(pc[2 * k].y, pc[2 * k + 1].y, false, false);
        *(uint4*)(row + 8 * (2 * k + hi)) = make_uint4(s0[0], s1[0], s0[1], s1[1]);
    }
}
__device__ __forceinline__ void own_tile(const Args& a, const LAS unsigned char* Lt, const s16x8 (&qf)[4], unsigned pm, int b, int h, int i, int qt, int lane, float Mref, int dry) {
    const int r32 = lane & 31, hi = lane >> 5;
    const size_t tok = (size_t)b * SEQ + i * 256 + qt * 32 + r32;
    const float slope2 = exp2f(-(float)(h + 1)) * LOG2E;
    f32x16 cin;
#pragma unroll
    for (int r = 0; r < 16; ++r) cin[r] = fmaf(-slope2, (float)(32 * qt + r32 - crow(r, hi)), -Mref);
    f32x16 o[2]; float lsum = 0.f;
#pragma unroll
    for (int r = 0; r < 16; ++r) { o[0][r] = 0.f; o[1][r] = 0.f; }
    attn_tiles(Lt, qf, cin, 32.f * slope2, 0, qt + 1, qt, r32, hi, lane, o, lsum);
    lsum = red32(lsum);
    bf16* cp = a.cb() + tok * 1024 + h * 64;
    uint4 gw[4];
#pragma unroll
    for (int k = 0; k < 4; ++k) gw[k] = *(const uint4*)(cp + 8 * (2 * k + hi));
    if (pm) { const pg8::f32x4 pl = *(const pg8::f32x4*)(a.partL() + (tok * 8 + h) * 4);
        lsum += ((pm & 1u) ? pl[0] : 0.f) + ((pm & 2u) ? pl[1] : 0.f) + ((pm & 4u) ? pl[2] : 0.f); }
    for (int s = 0; s < 3; ++s) {
        if (!((pm >> s) & 1u)) continue;
        const size_t pidx = (tok * 8 + h) * 3 + s;
        const bf16* po = a.partO() + pidx * 64;
#pragma unroll
        for (int dh = 0; dh < 2; ++dh)
#pragma unroll
            for (int g2 = 0; g2 < 2; ++g2) { const uint4 w = *(const uint4*)(po + 32 * hi + 16 * dh + 8 * g2); const unsigned ww[4] = {w.x, w.y, w.z, w.w};
#pragma unroll
                for (int e = 0; e < 4; ++e) { o[dh][8 * g2 + 2 * e] += __uint_as_float(ww[e] << 16); o[dh][8 * g2 + 2 * e + 1] += __uint_as_float(ww[e] & 0xffff0000u); } }
    }
    const float inv = __builtin_amdgcn_rcpf(lsum);
    uint2 gt[8];
#pragma unroll
    for (int k = 0; k < 4; ++k) {
        const auto s0 = __builtin_amdgcn_permlane32_swap(gw[k].x, gw[k].z, false, false), s1 = __builtin_amdgcn_permlane32_swap(gw[k].y, gw[k].w, false, false);
        gt[2 * k] = make_uint2(s0[0], s1[0]); gt[2 * k + 1] = make_uint2(s0[1], s1[1]); }
#pragma unroll
    for (int c = 0; c < 8; ++c) { const int dh = c >> 2, g4 = c & 3; uint2 w;
        w.x = cvtpk(o[dh][4 * g4] * inv * __uint_as_float(gt[c].x << 16), o[dh][4 * g4 + 1] * inv * __uint_as_float(gt[c].x & 0xffff0000u));
        w.y = cvtpk(o[dh][4 * g4 + 2] * inv * __uint_as_float(gt[c].y << 16), o[dh][4 * g4 + 3] * inv * __uint_as_float(gt[c].y & 0xffff0000u));
        gt[c] = w; }
    if (!dry) row_store_pieces(cp, hi, gt); else asm volatile("" :: "v"(gt[0].x), "v"(gt[3].y), "v"(gt[7].x));
}
__device__ __forceinline__ void moba_own_pair(const Args& a, int uA, int uB, LAS unsigned char* L, int wv, float Mref, int dry = 0) {
    const int tid = wv * 64 + lane_id_opaque(), lane = tid & 63, wid = wv, hi = lane >> 5;
    const int bhA = uA >> 6, iA = uA & 63, bA = bhA >> 3, hA = bhA & 7, bhB = uB >> 6, iB = uB & 63, bB = bhB >> 3, hB = bhB & 7;
    __syncthreads();
    load_kv_tiles(L, a.ka() + hm_off(bA, hA, iA * 256), a.va() + hm_off(bA, hA, iA * 256), 64, tid);
    const bool single = (uA == uB);
    if (!single) load_kv_tiles(L + ATT_LDS_END, a.ka() + hm_off(bB, hB, iB * 256), a.va() + hm_off(bB, hB, iB * 256), 64, tid);
    s16x8 qfA[4], qfB[4];
    load_qfrag(qfA, a.qa() + hm_off(bA, hA, iA * 256 + wid * 32 + (lane & 31)), hi);
    load_qfrag(qfB, a.qa() + hm_off(bB, hB, iB * 256 + (7 - wid) * 32 + (lane & 31)), hi);
    const unsigned pmA = iA > 0 ? (unsigned)a.pmask()[((size_t)bA * SEQ + iA * 256 + wid * 32 + (lane & 31)) * 8 + hA] : 0u;
    const unsigned pmB = iB > 0 ? (unsigned)a.pmask()[((size_t)bB * SEQ + iB * 256 + (7 - wid) * 32 + (lane & 31)) * 8 + hB] : 0u;
    __syncthreads();
    own_tile(a, L, qfA, pmA, bA, hA, iA, wid, lane, Mref, dry);
    own_tile(a, single ? L : L + ATT_LDS_END, qfB, pmB, bB, hB, iB, 7 - wid, lane, Mref, dry);
}

__device__ __forceinline__ void mem_attn_phase(const Args& a, int l, LAS unsigned char* L, int wv, int bid, int G, float Mref, int dry) {
    const int NU = BATCH * 4 * 64;
    int unit = bid;
    KVRegs kvr; s16x8 qf[4], qfn[4];
    if (unit < NU) {
        const int tid = wv * 64 + lane_id_opaque(), lane = tid & 63;
        const int bhm = unit >> 6, qt = unit & 63, b = bhm >> 2, hm = bhm & 3;
        const size_t kvoff = ((size_t)l * TM + b * MEM_LEN) * 256 + hm * 64;
        kv_issue(kvr, a.memk() + kvoff, a.memv() + kvoff, 256, tid);
        load_qfrag(qf, a.qm() + ((size_t)b * SEQ + qt * 256 + wv * 32 + (lane & 31)) * 256 + hm * 64, lane >> 5);
    }
    while (unit < NU) {
        const int tid = wv * 64 + lane_id_opaque(), lane = tid & 63, r32 = lane & 31, hi = lane >> 5;
        const int bhm = unit >> 6, qt = unit & 63, b = bhm >> 2, hm = bhm & 3;
        const int nunit = unit + G;
        __syncthreads();
        kv_commit(L, kvr, tid);
        if (nunit < NU) {
            const int nbhm = nunit >> 6, nqt = nunit & 63, nb = nbhm >> 2, nhm = nbhm & 3;
            const size_t kvoff = ((size_t)l * TM + nb * MEM_LEN) * 256 + nhm * 64;
            kv_issue(kvr, a.memk() + kvoff, a.memv() + kvoff, 256, tid);
            load_qfrag(qfn, a.qm() + ((size_t)nb * SEQ + nqt * 256 + wv * 32 + r32) * 256 + nhm * 64, hi);
        }
        const size_t tok = (size_t)b * SEQ + qt * 256 + wv * 32 + r32;
        bf16* cp = a.cb() + tok * 1024 + 768 + hm * 64;
        uint2 gt[8]; row_load_pieces(cp, hi, gt);
        __syncthreads();
        f32x16 cin;
#pragma unroll
        for (int r = 0; r < 16; ++r) cin[r] = -Mref;
        f32x16 o[2]; float lsum = 0.f;
#pragma unroll
        for (int r = 0; r < 16; ++r) { o[0][r] = 0.f; o[1][r] = 0.f; }
        attn_tiles(L, qf, cin, 0.f, 0, 8, -1, r32, hi, lane, o, lsum);
        lsum = red32(lsum);
        const float inv = __builtin_amdgcn_rcpf(lsum);
#pragma unroll
        for (int c = 0; c < 8; ++c) { const int dh = c >> 2, g4 = c & 3; const uint2 g2 = gt[c]; uint2 w;
            w.x = cvtpk(o[dh][4 * g4] * inv * __uint_as_float(g2.x << 16), o[dh][4 * g4 + 1] * inv * __uint_as_float(g2.x & 0xffff0000u));
            w.y = cvtpk(o[dh][4 * g4 + 2] * inv * __uint_as_float(g2.y << 16), o[dh][4 * g4 + 3] * inv * __uint_as_float(g2.y & 0xffff0000u));
            gt[c] = w; }
        if (!dry) row_store_pieces(cp, hi, gt); else asm volatile("" :: "v"(gt[0].x), "v"(gt[3].y), "v"(gt[7].x));
#pragma unroll
        for (int d0 = 0; d0 < 4; ++d0) qf[d0] = qfn[d0];
        unit = nunit;
    }
    __syncthreads();
}

__device__ __forceinline__ void gla_load_cumsum(const Args& a, LAS float* sb, size_t tok0, int h, int tid, int lane, int wid) {
    for (int e = tid; e < 64 * 32; e += NTHREADS) { const int t = e >> 5, d = e & 31; sb[t * 33 + d] = a.la()[(tok0 + t) * 128 + h * 32 + d]; }
    __syncthreads();
#pragma unroll
    for (int cc = 0; cc < 4; ++cc) { const int d = wid * 4 + cc; float v = sb[lane * 33 + d];
#pragma unroll
        for (int o = 1; o < 64; o <<= 1) { const float t = shup(v, o, lane); if (lane >= o) v += t; }
        sb[lane * 33 + d] = v; }
    __syncthreads();
}
struct GlaRaw1 { pg8::f32x4 la[2]; uint4 k, v[2]; };
__device__ __forceinline__ void gla_raw1_issue(const Args& a, GlaRaw1& r, int unit, int lt) {
    const int c = unit & 255, h = (unit >> 8) & 3, b = unit >> 10;
    const size_t tok0 = (size_t)b * SEQ + c * 64; const int row = lt >> 2, q4 = lt & 3;
    const float* lp = a.la() + (tok0 + row) * 128 + h * 32 + 8 * q4;
    r.la[0] = *(const pg8::f32x4*)lp; r.la[1] = *(const pg8::f32x4*)(lp + 4);
    r.k = *(const uint4*)(a.qbkb() + (tok0 + row) * 256 + 128 + h * 32 + 8 * q4);
    const bf16* vp = a.vb() + (tok0 + row) * 256 + h * 64 + 16 * q4;
    r.v[0] = *(const uint4*)vp; r.v[1] = *(const uint4*)(vp + 8);
}
__device__ __forceinline__ void gla_p1_phase(const Args& a, LAS unsigned char* L, int wv, int bid, int G) {
    constexpr int GB = 8448 + 4608 + 9216;
    const int NU = BATCH * 4 * NCH;
    const int grp = wv >> 2, lw = wv & 3;
    LAS unsigned char* gb = L + grp * GB;
    LAS float* sb = (LAS float*)gb; LAS unsigned char* kT = gb + 8448; LAS unsigned char* vT = kT + 4608;
    int unit = bid + grp * G;
    GlaRaw1 R;
    { const int lt = lw * 64 + lane_id_opaque(); if (unit < NU) gla_raw1_issue(a, R, unit, lt); }
    while (unit - grp * G < NU) {
        const int lane = lane_id_opaque(), lt = lw * 64 + lane, r16 = lane & 15, g = lane >> 4;
        const bool act = unit < NU;
        const int row = lt >> 2, q4 = lt & 3;
        if (act) { LAS float* p = sb + row * 33 + 8 * q4;
#pragma unroll
            for (int e = 0; e < 4; ++e) { p[e] = R.la[0][e]; p[4 + e] = R.la[1][e]; } }
        __syncthreads();
        if (act) {
#pragma unroll
            for (int cc = 0; cc < 8; ++cc) { const int d = lw * 8 + cc; float v = sb[lane * 33 + d];
#pragma unroll
                for (int o = 1; o < 64; o <<= 1) { const float t = shup(v, o, lane); if (lane >= o) v += t; }
                sb[lane * 33 + d] = v; }
        }
        __syncthreads();
        float dlast = 0.f;
        if (act) {
            const int d0 = 8 * q4;
            const unsigned ww[4] = {R.k.x, R.k.y, R.k.z, R.k.w};
#pragma unroll
            for (int e = 0; e < 4; ++e) {
                *(LAS unsigned short*)(kT + (d0 + 2 * e) * 144 + row * 2) = (unsigned short)f2bf(__uint_as_float(ww[e] << 16) * __expf(sb[63 * 33 + d0 + 2 * e] - sb[row * 33 + d0 + 2 * e]));
                *(LAS unsigned short*)(kT + (d0 + 2 * e + 1) * 144 + row * 2) = (unsigned short)f2bf(__uint_as_float(ww[e] & 0xffff0000u) * __expf(sb[63 * 33 + d0 + 2 * e + 1] - sb[row * 33 + d0 + 2 * e + 1]));
            }
#pragma unroll
            for (int hh = 0; hh < 2; ++hh) { const unsigned vw[4] = {R.v[hh].x, R.v[hh].y, R.v[hh].z, R.v[hh].w};
#pragma unroll
                for (int k = 0; k < 4; ++k) { const int e = 16 * q4 + 8 * hh + 2 * k;
                    *(LAS unsigned short*)(vT + e * 144 + row * 2) = (unsigned short)(vw[k] & 0xffffu); *(LAS unsigned short*)(vT + (e + 1) * 144 + row * 2) = (unsigned short)(vw[k] >> 16); } }
            if (lt < 32) dlast = __expf(sb[63 * 33 + lt]);
        }
        const int cur = unit, nunit = unit + 2 * G;
        if (nunit < NU) gla_raw1_issue(a, R, nunit, lt);
        __syncthreads();
        if (act) {
            const s16x8 v0 = *(const LAS s16x8*)(vT + (16 * lw + r16) * 144 + 16 * g), v1 = *(const LAS s16x8*)(vT + (16 * lw + r16) * 144 + 64 + 16 * g);
#pragma unroll
            for (int db = 0; db < 2; ++db) {
                pg8::f32x4 acc = __builtin_amdgcn_mfma_f32_16x16x32_bf16(*(const LAS s16x8*)(kT + (16 * db + r16) * 144 + 16 * g), v0, (pg8::f32x4){0.f, 0.f, 0.f, 0.f}, 0, 0, 0);
                acc = __builtin_amdgcn_mfma_f32_16x16x32_bf16(*(const LAS s16x8*)(kT + (16 * db + r16) * 144 + 64 + 16 * g), v1, acc, 0, 0, 0);
#pragma unroll
                for (int r = 0; r < 4; ++r) a.U()[(size_t)cur * 2048 + (16 * db + 4 * g + r) * 64 + 16 * lw + r16] = acc[r];
            }
            if (lt < 32) a.Dc()[(size_t)cur * 32 + lt] = dlast;
        }
        unit = nunit;
        __syncthreads();
    }
}
__device__ __forceinline__ void gla_scan_slice(const Args& a, int slice, LAS unsigned char* L, int wv) {
    const int tid = wv * 64 + lane_id_opaque();
    const int e = tid & 63, sg = tid >> 6, bh = slice >> 5, d = slice & 31;
    LAS float* sS = (LAS float*)L; LAS float* sP = sS + 512;
    float Uv[32], Dv[32];
    const size_t unit0 = (size_t)bh * 256 + sg * 32;
#pragma unroll
    for (int c = 0; c < 32; ++c) { Dv[c] = a.Dc()[(unit0 + c) * 32 + d]; Uv[c] = a.U()[(unit0 + c) * 2048 + d * 64 + e]; }
    float S = 0.f, P = 1.f;
#pragma unroll
    for (int c = 0; c < 32; ++c) { S = Dv[c] * S + Uv[c]; P *= Dv[c]; }
    sS[sg * 64 + e] = S; sP[sg * 64 + e] = P;
    __syncthreads();
    float S0 = 0.f;
    for (int s2 = 0; s2 < sg; ++s2) S0 = sP[s2 * 64 + e] * S0 + sS[s2 * 64 + e];
    S = S0;
#pragma unroll
    for (int c = 0; c < 32; ++c) { a.Sst()[(unit0 + c) * 2048 + d * 64 + e] = S; S = Dv[c] * S + Uv[c]; }
    __syncthreads();
}
struct GlaRaw { pg8::f32x4 la[2], st[2]; uint4 q, k, v[2]; };
__device__ __forceinline__ void gla_raw_issue(const Args& a, GlaRaw& r, int unit, int lt) {
    const int c = unit & 255, h = (unit >> 8) & 3, b = unit >> 10;
    const size_t tok0 = (size_t)b * SEQ + c * 64; const int row = lt >> 2, q4 = lt & 3;
    const float* lp = a.la() + (tok0 + row) * 128 + h * 32 + 8 * q4;
    r.la[0] = *(const pg8::f32x4*)lp; r.la[1] = *(const pg8::f32x4*)(lp + 4);
    r.q = *(const uint4*)(a.qbkb() + (tok0 + row) * 256 + h * 32 + 8 * q4);
    r.k = *(const uint4*)(a.qbkb() + (tok0 + row) * 256 + 128 + h * 32 + 8 * q4);
    const bf16* vp = a.vb() + (tok0 + row) * 256 + h * 64 + 16 * q4;
    r.v[0] = *(const uint4*)vp; r.v[1] = *(const uint4*)(vp + 8);
    const float* sp = a.Sst() + (size_t)unit * 2048 + 8 * lt;
    r.st[0] = *(const pg8::f32x4*)sp; r.st[1] = *(const pg8::f32x4*)(sp + 4);
}
__device__ __forceinline__ void gla_p3_phase(const Args& a, int l, LAS unsigned char* L, int wv, int bid, int G, int dry) {
    constexpr int GB = 18688 + 9216 + 9216 + 5120;
    const int NU = BATCH * 4 * NCH;
    const int grp = wv >> 2, lw = wv & 3;
    LAS unsigned char* gb = L + grp * GB;
    LAS float* sb = (LAS float*)gb; LAS float* so = (LAS float*)gb;
    LAS unsigned char* qb = gb + 8448; LAS unsigned char* kb = qb + 5120; LAS unsigned char* ab = gb + 18688; LAS unsigned char* vT = ab + 9216; LAS unsigned char* sT = vT + 9216;
    int unit = bid + grp * G;
    GlaRaw R;
    { const int lt = lw * 64 + lane_id_opaque(); if (unit < NU) gla_raw_issue(a, R, unit, lt); }
    while (unit - grp * G < NU) {
        const int lane = lane_id_opaque(), lt = lw * 64 + lane, r16 = lane & 15, g = lane >> 4;
        const bool act = unit < NU;
        const int uc = act ? unit : 0;
        const int c = uc & 255, h = (uc >> 8) & 3, b = uc >> 10;
        const size_t tok0 = (size_t)b * SEQ + c * 64;
        const int row = lt >> 2, q4 = lt & 3;
        uint4* gptr = (uint4*)(a.cb() + (tok0 + row) * 1024 + 512 + h * 64 + 16 * q4);
        uint4 gate[2] = {make_uint4(0, 0, 0, 0), make_uint4(0, 0, 0, 0)};
        if (act) { gate[0] = gptr[0]; gate[1] = gptr[1]; }
        if (act) { LAS float* p = sb + row * 33 + 8 * q4;
#pragma unroll
            for (int e = 0; e < 4; ++e) { p[e] = R.la[0][e]; p[4 + e] = R.la[1][e]; } }
        __syncthreads();
        if (act) {
#pragma unroll
            for (int cc = 0; cc < 8; ++cc) { const int d = lw * 8 + cc; float v = sb[lane * 33 + d];
#pragma unroll
                for (int o = 1; o < 64; o <<= 1) { const float t = shup(v, o, lane); if (lane >= o) v += t; }
                sb[lane * 33 + d] = v; }
        }
        __syncthreads();
        if (act) {
            const int d0 = 8 * q4;
            const unsigned qw[4] = {R.q.x, R.q.y, R.q.z, R.q.w}, kw[4] = {R.k.x, R.k.y, R.k.z, R.k.w};
            unsigned qo[4], ko[4];
#pragma unroll
            for (int e = 0; e < 4; ++e) {
                const float d0v = sb[row * 33 + d0 + 2 * e] - sb[31 * 33 + d0 + 2 * e], d1v = sb[row * 33 + d0 + 2 * e + 1] - sb[31 * 33 + d0 + 2 * e + 1];
                const float e0 = __expf(d0v), e1 = __expf(d1v);
                qo[e] = cvtpk(__uint_as_float(qw[e] << 16) * e0, __uint_as_float(qw[e] & 0xffff0000u) * e1);
                ko[e] = cvtpk(__uint_as_float(kw[e] << 16) * __builtin_amdgcn_rcpf(e0), __uint_as_float(kw[e] & 0xffff0000u) * __builtin_amdgcn_rcpf(e1));
            }
            *(LAS pg8::u32x4*)(qb + row * 80 + 16 * q4) = (pg8::u32x4){qo[0], qo[1], qo[2], qo[3]};
            *(LAS pg8::u32x4*)(kb + row * 80 + 16 * q4) = (pg8::u32x4){ko[0], ko[1], ko[2], ko[3]};
#pragma unroll
            for (int hh = 0; hh < 2; ++hh) { const unsigned vw[4] = {R.v[hh].x, R.v[hh].y, R.v[hh].z, R.v[hh].w};
#pragma unroll
                for (int k = 0; k < 4; ++k) { const int e = 16 * q4 + 8 * hh + 2 * k;
                    *(LAS unsigned short*)(vT + e * 144 + row * 2) = (unsigned short)(vw[k] & 0xffffu); *(LAS unsigned short*)(vT + (e + 1) * 144 + row * 2) = (unsigned short)(vw[k] >> 16); } }
            const int sd = (8 * lt) >> 6, se = (8 * lt) & 63; const float em = __expf(sb[31 * 33 + sd]);
#pragma unroll
            for (int e = 0; e < 4; ++e) { *(LAS unsigned short*)(sT + (se + e) * 80 + sd * 2) = (unsigned short)f2bf(R.st[0][e] * em); *(LAS unsigned short*)(sT + (se + 4 + e) * 80 + sd * 2) = (unsigned short)f2bf(R.st[1][e] * em); }
        }
        const int nunit = unit + 2 * G;
        if (nunit < NU) gla_raw_issue(a, R, nunit, lt);
        __syncthreads();
        if (act) {
            for (int tt = lw; tt < 10; tt += 4) {
                const int rb = tt >= 6 ? 3 : tt >= 3 ? 2 : tt >= 1 ? 1 : 0, cb = tt - (rb * (rb + 1)) / 2;
                const s16x8 af = *(const LAS s16x8*)(qb + (16 * rb + r16) * 80 + 16 * g), bf = *(const LAS s16x8*)(kb + (16 * cb + r16) * 80 + 16 * g);
                const pg8::f32x4 acc = __builtin_amdgcn_mfma_f32_16x16x32_bf16(af, bf, (pg8::f32x4){0.f, 0.f, 0.f, 0.f}, 0, 0, 0);
#pragma unroll
                for (int r = 0; r < 4; ++r) { const int i = 16 * rb + 4 * g + r, j = 16 * cb + r16; *(LAS unsigned short*)(ab + i * 144 + j * 2) = (unsigned short)f2bf((j <= i) ? acc[r] : 0.f); }
            }
            if (lw == 0) {
#pragma unroll
                for (int r = 0; r < 4; ++r) { *(LAS unsigned short*)(ab + (4 * g + r) * 144 + (16 + r16) * 2) = 0; *(LAS unsigned short*)(ab + (32 + 4 * g + r) * 144 + (48 + r16) * 2) = 0; }
            }
        }
        __syncthreads();
        pg8::f32x4 oacc[4];
        if (act) {
            const s16x8 sf = *(const LAS s16x8*)(sT + (16 * lw + r16) * 80 + 16 * g);
            const s16x8 v0 = *(const LAS s16x8*)(vT + (16 * lw + r16) * 144 + 16 * g), v1 = *(const LAS s16x8*)(vT + (16 * lw + r16) * 144 + 64 + 16 * g);
#pragma unroll
            for (int rb = 0; rb < 4; ++rb) {
                const s16x8 qf_ = *(const LAS s16x8*)(qb + (16 * rb + r16) * 80 + 16 * g);
                pg8::f32x4 acc = __builtin_amdgcn_mfma_f32_16x16x32_bf16(qf_, sf, (pg8::f32x4){0.f, 0.f, 0.f, 0.f}, 0, 0, 0);
                acc = __builtin_amdgcn_mfma_f32_16x16x32_bf16(*(const LAS s16x8*)(ab + (16 * rb + r16) * 144 + 16 * g), v0, acc, 0, 0, 0);
                if (rb >= 2) acc = __builtin_amdgcn_mfma_f32_16x16x32_bf16(*(const LAS s16x8*)(ab + (16 * rb + r16) * 144 + 64 + 16 * g), v1, acc, 0, 0, 0);
                oacc[rb] = acc;
            }
        }
        __syncthreads();
        if (act) {
#pragma unroll
            for (int rb = 0; rb < 4; ++rb)
#pragma unroll
                for (int r = 0; r < 4; ++r) so[(16 * rb + 4 * g + r) * 65 + 16 * lw + r16] = oacc[rb][r];
        }
        __syncthreads();
        if (act) {
            const LAS float* orow = so + row * 65 + 16 * q4;
            float ov[16]; float ss = 0.f;
#pragma unroll
            for (int e = 0; e < 16; ++e) { ov[e] = orow[e]; ss += ov[e] * ov[e]; }
            ss += shx(ss, 1, lane); ss += shx(ss, 2, lane);
            const float inv = pg8::rsq_f(ss * (1.f / 64.f) + EPS);
            const float* gg = a.g_gla_out() + l * 64 + 16 * q4;
            unsigned ow[8];
#pragma unroll
            for (int e = 0; e < 8; ++e) { const unsigned gw = (e < 4) ? ((e == 0) ? gate[0].x : (e == 1) ? gate[0].y : (e == 2) ? gate[0].z : gate[0].w) : ((e == 4) ? gate[1].x : (e == 5) ? gate[1].y : (e == 6) ? gate[1].z : gate[1].w);
                ow[e] = cvtpk(ov[2 * e] * inv * gg[2 * e] * __uint_as_float(gw << 16), ov[2 * e + 1] * inv * gg[2 * e + 1] * __uint_as_float(gw & 0xffff0000u)); }
            if (!dry) { gptr[0] = make_uint4(ow[0], ow[1], ow[2], ow[3]); gptr[1] = make_uint4(ow[4], ow[5], ow[6], ow[7]); } else asm volatile("" :: "v"(ow[0]), "v"(ow[3]), "v"(ow[7]));
        }
        unit = nunit;
        __syncthreads();
    }
}

__device__ __forceinline__ int src_col_in(int R) {
    const int tile = R >> 8, loc = R & 255, bj = loc >> 7, wc = (loc >> 5) & 3, j = loc & 31;
    switch (tile) {
        case 0: case 1: return C_QA + (4 * tile + wc) * 64 + 32 * bj + j;
        case 2: case 3: return C_KA + (4 * (tile - 2) + wc) * 64 + 32 * bj + j;
        case 4: case 5: return C_VA + 256 * (tile - 4) + loc;
        case 6: case 7: return C_GA + 256 * (tile - 6) + loc;
        case 8: return C_QB + loc;
        case 9: return C_VB + loc;
        case 10: return C_GB + loc;
        case 11: return C_QM + wc * 64 + 32 * bj + j;
        case 12: return C_GM + loc;
        default: return loc < 128 ? -(loc + 2) : -1;
    }
}

__device__ __forceinline__ void conv_item(const float* W, int ldw, int sc0, const float* g, bf16* WT, int R0, int k0, LAS float* scr, int lane) {
    float wv_[32];
#pragma unroll
    for (int i = 0; i < 32; ++i) { const int kk = 2 * i + (lane >> 5); wv_[i] = W[(size_t)(k0 + kk) * ldw + sc0 + (lane & 31)]; }
#pragma unroll
    for (int i = 0; i < 32; ++i) { const int kk = 2 * i + (lane >> 5); scr[kk * 33 + (lane & 31)] = wv_[i] * (g ? g[k0 + kk] : 1.f); }
    asm volatile("s_waitcnt lgkmcnt(0)" ::: "memory");
    const int c = lane & 7;
#pragma unroll
    for (int j = 0; j < 4; ++j) { const int n = (lane >> 3) + 8 * j; const LAS float* sp = scr + (8 * c) * 33 + n;
        uint4 o; o.x = pk2(sp[0 * 33], sp[1 * 33]); o.y = pk2(sp[2 * 33], sp[3 * 33]); o.z = pk2(sp[4 * 33], sp[5 * 33]); o.w = pk2(sp[6 * 33], sp[7 * 33]);
        *(uint4*)(WT + (size_t)(R0 + n) * DM + k0 + 8 * c) = o; }
    asm volatile("s_waitcnt lgkmcnt(0)" ::: "memory");
}
__device__ __forceinline__ void p0_prologue(const Args& a, LAS unsigned char* L, int bid, int G, int wv) {
    const int lane = lane_id_opaque(), gtid = bid * NTHREADS + wv * 64 + lane, nthreads = G * NTHREADS, gwave = bid * NWAVES + wv, nwaves = G * NWAVES;
    LAS float* scr = (LAS float*)(L + wv * 16384);
    constexpr int NB_IN = NINP / 32, I_IN = DEPTH * 16 * NB_IN, I_OUT = DEPTH * 16 * (DM / 32), I_MEM = DEPTH * 16 * 16;
    for (int it = gwave; it < I_IN + I_OUT + I_MEM; it += nwaves) {
        if (it < I_IN) {
            const int nb = it % NB_IN, kb = (it / NB_IN) % 16, l = it / (NB_IN * 16);
            const int sc = src_col_in(32 * nb);
            if (sc >= 0) conv_item(a.w_in() + (size_t)l * DM * NIN, NIN, sc, a.g_pre() + l * DM, a.wt_in() + (size_t)l * NINP * DM, 32 * nb, 64 * kb, scr, lane);
            else {
                const int R = 32 * nb + (lane & 31), kq = 64 * kb + 32 * (lane >> 5);
                const float* W = a.w_in() + (size_t)l * DM * NIN; const float* g = a.g_pre() + l * DM;
                const float* wg = a.w_gate_up() + (size_t)l * 16 * 128 + (R & 127);
                for (int k8 = 0; k8 < 4; ++k8) {
                    float v[8];
#pragma unroll
                    for (int kk = 0; kk < 8; ++kk) { float sacc = 0.f;
                        if (sc != -1) { const float* wr = W + (size_t)(kq + 8 * k8 + kk) * NIN + C_RB;
#pragma unroll
                            for (int r = 0; r < 16; ++r) sacc += wr[r] * wg[r * 128]; }
                        v[kk] = sacc * g[kq + 8 * k8 + kk]; }
                    uint4 o; o.x = pk2(v[0], v[1]); o.y = pk2(v[2], v[3]); o.z = pk2(v[4], v[5]); o.w = pk2(v[6], v[7]);
                    *(uint4*)(a.wt_in() + ((size_t)l * NINP + R) * DM + kq + 8 * k8) = o;
                }
            }
        } else if (it < I_IN + I_OUT) {
            const int r = it - I_IN, nb = r % 32, kb = (r / 32) % 16, l = r / 512;
            conv_item(a.w_out() + (size_t)l * DM * DM, DM, 32 * nb, nullptr, a.wt_out() + (size_t)l * DM * DM, 32 * nb, 64 * kb, scr, lane);
        } else {
            const int r = it - I_IN - I_OUT, nb = r % 16, kb = (r / 16) % 16, l = r / 256;
            const int loc = 32 * nb; int sc;
            if (loc < 256) { const int bj = loc >> 7, wc = (loc >> 5) & 3; sc = wc * 64 + 32 * bj; } else sc = loc;
            conv_item(a.w_mem_kv() + (size_t)l * DM * 512, 512, sc, a.g_mem() + l * DM, a.wt_mem() + (size_t)l * 512 * DM, loc, 64 * kb, scr, lane);
        }
    }
    for (int row = gwave; row < TM; row += nwaves) {
        const float4* xr = (const float4*)(a.mem() + (size_t)row * DM) + lane;
        float s = 0.f;
#pragma unroll
        for (int j = 0; j < 4; ++j) {
            const float4 v = xr[64 * j]; s += (v.x * v.x + v.y * v.y) + (v.z * v.z + v.w * v.w);
            uint2 o; o.x = pk2(v.x, v.y); o.y = pk2(v.z, v.w);
            *((uint2*)(a.membf() + (size_t)row * DM) + lane + 64 * j) = o;
        }
        s = wave_sum(s, lane);
        if (lane < 16) a.ssqm()[(size_t)row * 16 + lane] = (lane == 0) ? s : 0.f;
    }
    for (int row0 = gwave * 4; row0 < T; row0 += nwaves * 4) {
        float4 v[4][4];
#pragma unroll
        for (int rr = 0; rr < 4; ++rr)
#pragma unroll
            for (int j = 0; j < 4; ++j) v[rr][j] = ((const float4*)(a.x() + (size_t)(row0 + rr) * DM) + lane)[64 * j];
#pragma unroll
        for (int rr = 0; rr < 4; ++rr) {
            float sacc = 0.f;
#pragma unroll
            for (int j = 0; j < 4; ++j) {
                const float4 w = v[rr][j]; sacc += (w.x * w.x + w.y * w.y) + (w.z * w.z + w.w * w.w);
                uint2 o; o.x = pk2(w.x, w.y); o.y = pk2(w.z, w.w);
                *((uint2*)(a.xb() + (size_t)(row0 + rr) * DM) + lane + 64 * j) = o;
            }
            sacc = wave_sum(sacc, lane);
            if (lane < 16) a.ssq()[(size_t)(row0 + rr) * 16 + lane] = (lane == 0) ? sacc : 0.f;
        }
    }
}

constexpr int N_STEPS = 2 + 5 * DEPTH;
constexpr int CW_BAR = 4096;
#ifndef MK_SPLIT
#define MK_SPLIT 0
#endif
#ifndef PROBE
#define PROBE 0
#endif
__global__ void __launch_bounds__(NTHREADS, 2) mk_fwd(KArgs aa) {
    extern __shared__ __attribute__((aligned(16))) unsigned char lds[];
    const int G = gridDim.x;
    PG8_LAS unsigned char* L = (PG8_LAS unsigned char*)lds;
    const int wave_s = __builtin_amdgcn_readfirstlane(threadIdx.x >> 6);
    {
        const int tid0 = wave_s * 64 + (int)__builtin_amdgcn_mbcnt_hi(~0u, __builtin_amdgcn_mbcnt_lo(~0u, 0u));
        for (int u = tid0; u < 512 / 4; u += NTHREADS) ((LAS unsigned*)(L + MISC_OFF))[u] = 0u;
        __syncthreads();
    }
    unsigned* barw = (unsigned*)(aa.ws + O_CTL) + CW_BAR;
    XcdBarrier bar; bar.bar = barw; bar.x = 0; bar.st = nullptr;
    if (!MK_SPLIT) bar = xcd_barrier_post(barw, (volatile LAS unsigned*)(L + MISC_OFF) + 8, wave_s * 64 + (int)__builtin_amdgcn_mbcnt_hi(~0u, __builtin_amdgcn_mbcnt_lo(~0u, 0u)));
    const int ph_lo = aa.ph_lo, ph_hi = aa.ph_hi;
    for (int st = ph_lo; st < ph_hi; ++st) {
        int bid_o = blockIdx.x, wv_o = wave_s;
        asm volatile("" : "+s"(bid_o)); asm volatile("" : "+s"(wv_o));
        Args a; a.kp = (const __attribute__((address_space(4))) KArgs*)__builtin_amdgcn_kernarg_segment_ptr();
        asm volatile("" : "+s"(a.kp));
        const int wave = wv_o, bid = bid_o;
        if (st == 0) {
            p0_prologue(a, L, bid, G, wave);
            if (PROBE == 11) p0_prologue(a, L, bid, G, wave);
        } else if (st == 1) {
            pg8::Gemm g{a.membf(), a.wt_mem(), TM, DEPTH * 512, DM}; pg8::StaticOrder S; S.init(TM, DEPTH * 512, G, bid);
            pg8::EpiMem E{a.memk(), a.memv(), a.ssqm(), a.g_k_mem(), TM};
            pg8::gemm_phase<pg8::EpiMem, pg8::StaticOrder, false, true>(L, g, S, E, wave);
        } else {
            const int l = (st - 2) / 5, k = (st - 2) % 5;
            for (int rep = 0; rep < ((PROBE == k + 1) ? 2 : 1); ++rep) {
            const int dry = (PROBE == k + 1 && rep == 0 && (k == 3 || k == 4 || k == 1)) ? 1 : 0;
            if (k == 0) {
                if (bid == 0) { const int t0 = wave * 64 + lane_id_opaque(); a.gcnt()[t0] = 0u; a.gcnt()[t0 + 512] = 0u; }
                pg8::Gemm g{a.xb(), a.wt_in() + (size_t)l * NINP * DM, T, NINP, DM}; pg8::StaticOrder S; S.init(T, NINP, G, bid);
                pg8::EpiIn E{a.qa(), a.ka(), a.va(), a.cb(), a.qbkb(), a.vb(), a.qm(), a.la(), a.kmp(), a.ssq(), a.g_q_moba() + l * 64, a.g_k_moba() + l * 64, a.g_q_mem() + l * 64, a.b_gate_up() + l * 128};
                if (PROBE == 13) { pg8::EpiDry ED; pg8::gemm_phase<pg8::EpiDry, pg8::StaticOrder, true, true>(L, g, S, ED, wave); }
                pg8::gemm_phase<pg8::EpiIn, pg8::StaticOrder, true, true>(L, g, S, E, wave);
            } else if (k == 1) {
                const float zthr = zero_thr(softmax_ref(a.g_q_moba() + l * 64, a.g_k_moba() + l * 64));
                moba_route_phase(a, L, wave, bid, G, zthr, dry);
                gla_p1_phase(a, L, wave, bid, G);
            } else if (k == 2) {
                for (int sl = bid; sl < 256; sl += G) gla_scan_slice(a, sl, L, wave);
                if (PROBE == 9) moba_pairs_phase(a, l, L, wave, bid, G, 1);
                if (PROBE == 10) for (int sl = bid; sl < 256; sl += G) gla_scan_slice(a, sl, L, wave);
                moba_pairs_phase(a, l, L, wave, bid, G);
            } else if (k == 3) {
                const float Mref = softmax_ref(a.g_q_moba() + l * 64, a.g_k_moba() + l * 64);
                if (PROBE >= 6) {
                    if (PROBE == 6) for (int u = bid; u < BATCH * 8 * 64; u += 2 * G) moba_own_pair(a, u, (u + G < BATCH * 8 * 64) ? u + G : u, L, wave, Mref, 1);
                    const float Mm0 = softmax_ref(a.g_q_mem() + l * 64, a.g_k_mem() + l * 64);
                    if (PROBE == 7) mem_attn_phase(a, l, L, wave, bid, G, Mm0, 1);
                    if (PROBE == 8) gla_p3_phase(a, l, L, wave, bid, G, 1);
                }
                for (int u = bid; u < BATCH * 8 * 64; u += 2 * G) moba_own_pair(a, u, (u + G < BATCH * 8 * 64) ? u + G : u, L, wave, Mref, dry);
                const float Mm = softmax_ref(a.g_q_mem() + l * 64, a.g_k_mem() + l * 64);
                mem_attn_phase(a, l, L, wave, bid, G, Mm, dry);
                gla_p3_phase(a, l, L, wave, bid, G, dry);
            } else {
                pg8::Gemm g{a.cb(), a.wt_out() + (size_t)l * DM * DM, T, DM, DM}; pg8::StaticOrder S; S.init(T, DM, G, bid);
                if (l == 0) { pg8::EpiOut<1, 0> E{a.x(), a.out(), a.xb(), a.ssq()}; pg8::gemm_phase<pg8::EpiOut<1, 0>, pg8::StaticOrder, true, true>(L, g, S, E, wave); }
                else if (l == DEPTH - 1) { pg8::EpiOut<0, 1> E{a.x(), a.out(), a.xb(), a.ssq()}; pg8::gemm_phase<pg8::EpiOut<0, 1>, pg8::StaticOrder, true, true>(L, g, S, E, wave); }
                else { pg8::EpiOut<0, 0> E{a.x(), a.out(), a.xb(), a.ssq()}; pg8::gemm_phase<pg8::EpiOut<0, 0>, pg8::StaticOrder, true, true>(L, g, S, E, wave); }
            }
            }
        }
        if (!MK_SPLIT && st + 1 < ph_hi && st != 1) {
            XcdBarrier b2 = bar; unsigned* bp = b2.bar; unsigned bx = b2.x;
            asm volatile("" : "+s"(bp)); asm volatile("" : "+s"(bx));
            b2.bar = bp; b2.x = bx;
            xcd_barrier(b2, wave);
            if (PROBE == 12) xcd_barrier(b2, wave);
        }
    }
}

extern "C" void kernel_launch(void* const* d_in, const int* in_sizes, int n_in, void* d_out, int out_size, void* d_ws, size_t ws_size, hipStream_t stream) {
    static int grid = 0;
    if (grid == 0) {
        int dev = 0, cus = 0;
        if (hipGetDevice(&dev) != hipSuccess || hipDeviceGetAttribute(&cus, hipDeviceAttributeMultiprocessorCount, dev) != hipSuccess) { grid = -1; return; }
        if (hipFuncSetAttribute((const void*)mk_fwd, hipFuncAttributeMaxDynamicSharedMemorySize, LDS_BYTES) != hipSuccess) { fprintf(stderr, "hipFuncSetAttribute failed\n"); grid = -1; return; }
        grid = cus;
    }
    if (grid < 0) return;
    KArgs a{};
    a.x = (const float*)d_in[0]; a.mem = (const float*)d_in[1]; a.g_pre = (const float*)d_in[2]; a.w_in = (const float*)d_in[3];
    a.g_q_moba = (const float*)d_in[4]; a.g_k_moba = (const float*)d_in[5]; a.w_gate_up = (const float*)d_in[6]; a.b_gate_up = (const float*)d_in[7];
    a.g_gla_out = (const float*)d_in[8]; a.g_mem = (const float*)d_in[9]; a.w_mem_kv = (const float*)d_in[10]; a.g_q_mem = (const float*)d_in[11];
    a.g_k_mem = (const float*)d_in[12]; a.w_out = (const float*)d_in[13];
    a.out = (float*)d_out;
    a.ws = (unsigned char*)d_ws;
    (void)ws_size; (void)in_sizes; (void)n_in; (void)out_size;
    (void)hipMemsetAsync((char*)d_ws + O_CTL, 0, 1 << 16, stream);
#if MK_SPLIT
    for (int st = 0; st < N_STEPS; ++st) { a.ph_lo = st; a.ph_hi = st + 1; hipLaunchKernelGGL(mk_fwd, dim3(grid), dim3(NTHREADS), LDS_BYTES, stream, a); }
#else
    a.ph_lo = 0; a.ph_hi = N_STEPS;
    hipLaunchKernelGGL(mk_fwd, dim3(grid), dim3(NTHREADS), LDS_BYTES, stream, a);
#endif
}
```

```cpp
#include <hip/hip_runtime.h>
#include <cstdio>
#include <cstdint>
#include <cstddef>

constexpr int BATCH = 2, SEQ = 16384, DM = 1024, DEPTH = 4, T = BATCH * SEQ;
constexpr int MEM_LEN = 256, TM = BATCH * MEM_LEN;
constexpr int NIN = 3344;
constexpr int C_QA = 0, C_KA = 512, C_VA = 1024, C_GA = 1536, C_QB = 2048, C_KB = 2176, C_VB = 2304, C_GB = 2560, C_RB = 2816, C_QM = 2832, C_GM = 3088;
constexpr int NB = SEQ / 256;
constexpr int NCH = SEQ / 64;
constexpr float EPS = 1e-6f;
constexpr int NINP = 14 * 256;
constexpr float LOG2E = 1.4426950408889634f;
constexpr float QSCALE = 0.125f * LOG2E;

__device__ __forceinline__ int lane_id_opaque() { int l; asm volatile("v_mbcnt_lo_u32_b32 %0, -1, 0\n\tv_mbcnt_hi_u32_b32 %0, -1, %0" : "=v"(l)); return l; }
__device__ __forceinline__ float red16(float v) { const auto r = __builtin_amdgcn_permlane16_swap(__float_as_uint(v), __float_as_uint(v), false, false); return __uint_as_float(r[0]) + __uint_as_float(r[1]); }
__device__ __forceinline__ float red32(float v) { const auto r = __builtin_amdgcn_permlane32_swap(__float_as_uint(v), __float_as_uint(v), false, false); return __uint_as_float(r[0]) + __uint_as_float(r[1]); }
template <int CTRL> __device__ __forceinline__ float dppmov(float v) { return __int_as_float(__builtin_amdgcn_update_dpp(0, __float_as_int(v), CTRL, 0xF, 0xF, false)); }
__device__ __forceinline__ float row16_sum(float v) { v += dppmov<0x128>(v); v += dppmov<0x124>(v); v += dppmov<0x4E>(v); v += dppmov<0xB1>(v); return v; }
__device__ __forceinline__ float shx(float v, int mask, int lane) { return __int_as_float(__builtin_amdgcn_ds_bpermute((lane ^ mask) << 2, __float_as_int(v))); }
__device__ __forceinline__ int shx_i(int v, int mask, int lane) { return __builtin_amdgcn_ds_bpermute((lane ^ mask) << 2, v); }
__device__ __forceinline__ float shup(float v, int o, int lane) { return __int_as_float(__builtin_amdgcn_ds_bpermute((lane >= o ? lane - o : lane) << 2, __float_as_int(v))); }
__device__ __forceinline__ int shup_i(int v, int o, int lane) { return __builtin_amdgcn_ds_bpermute((lane >= o ? lane - o : lane) << 2, v); }

namespace pg8 {
#define PG8_LAS __attribute__((address_space(3)))
typedef unsigned short bf16_t;
typedef short bf16x8 __attribute__((ext_vector_type(8)));
typedef float f32x4 __attribute__((ext_vector_type(4)));
typedef unsigned u32x4 __attribute__((ext_vector_type(4)));
constexpr int BM = 256, BK = 64, HALF = 128, HTB = HALF * BK * 2  , STAGE_BYTES = 8 * HTB, NXCD = 8, WGM = 8;

__host__ __device__ __forceinline__ int lds_byte(int r, int c) { const int st = (r >> 4) * 2 + (c >> 5), rr = r & 15, cc = c & 31, ob = rr * 64 + cc * 2; return st * 1024 + (ob ^ (((ob >> 9) & 1) << 5)); }
__host__ __device__ __forceinline__ void stage_rc(int b, int& R, int& C) { const int st = b / 1024, sb = b % 1024, swz = sb ^ (((sb >> 9) & 1) << 5); R = (st >> 1) * 16 + swz / 64; C = (st & 1) * 32 + (swz % 64) / 2; }
__host__ __device__ __forceinline__ int perm32(int rho) { const int n = rho >> 4, i = rho & 15; return 8 * (i >> 2) + 4 * n + (i & 3); }

struct Unit { int pm, pn; };
struct Gemm { const bf16_t* A; const bf16_t* Bt; int M, N, K; };

struct StaticOrder {
    int nM, nN, nwg, G, c;
    __host__ __device__ void init(int M, int N, int G_, int c_) { nM = M / BM; nN = N / BM; nwg = nM * nN; G = G_; c = c_; }
    __host__ __device__ bool next(int i, Unit& u) const {
        const long L = (long)i * G + c; if (L >= nwg) return false;
        int wgid = (int)L; { const int q = nwg / NXCD, r = nwg % NXCD, xcd = wgid % NXCD, off = wgid / NXCD; wgid = (xcd < r ? xcd * (q + 1) : r * (q + 1) + (xcd - r) * q) + off; }
        const int nig = WGM * nN, gid = wgid / nig, fm = gid * WGM, gsz = (nM - fm) < WGM ? (nM - fm) : WGM;
        u.pm = fm + ((wgid % nig) % gsz); u.pn = (wgid % nig) / gsz; return true;
    }
    __device__ __forceinline__ void a_ready(const Unit&) const {}
    __device__ __forceinline__ void done(const Unit&) const {}
};

__device__ __forceinline__ unsigned cvt_pk_bf16(float lo, float hi) { unsigned r; asm volatile("v_cvt_pk_bf16_f32 %0, %1, %2" : "=v"(r) : "v"(lo), "v"(hi)); return r; }
__device__ __forceinline__ float silu_f(float g) { return g * __builtin_amdgcn_rcpf(1.f + __builtin_amdgcn_exp2f(-1.4426950408889634f * g)); }
__device__ __forceinline__ float rsq_f(float x) { return __builtin_amdgcn_rsqf(x); }
typedef unsigned u32x2 __attribute__((ext_vector_type(2)));

struct EpiIn {
    static constexpr bool PERM = true, AFTER_DRAIN = false;
    bf16_t *qa, *ka, *va, *cb, *qbkb, *vb, *qm; float *la, *kmp; const float *ssq, *gq, *gk, *gqm, *bgu;
    __device__ __forceinline__ void operator()(const f32x4 (&acc)[2][2][4][2], const Unit& u, int wr, int wc, int, int) const {
        const int lane = lane_id_opaque(), fr = lane & 15, fq = lane >> 4;
        const int row0 = u.pm * BM + wr * 64 + fr;
        float rs[2][4];
        {
            f32x4 pp[2][4];
#pragma unroll
            for (int ai = 0; ai < 2; ++ai)
#pragma unroll
                for (int m = 0; m < 4; ++m) pp[ai][m] = *(const f32x4*)(ssq + (size_t)(row0 + ai * HALF + m * 16) * 16 + fq * 4);
            asm volatile("s_waitcnt vmcnt(0)" : "+v"(pp[0][0]), "+v"(pp[0][1]), "+v"(pp[0][2]), "+v"(pp[0][3]), "+v"(pp[1][0]), "+v"(pp[1][1]), "+v"(pp[1][2]), "+v"(pp[1][3]) :: "memory");
#pragma unroll
            for (int ai = 0; ai < 2; ++ai)
#pragma unroll
                for (int m = 0; m < 4; ++m) {
                    const f32x4 p = pp[ai][m];
                    float s = (p[0] + p[1]) + (p[2] + p[3]);
                    s = red16(s); s = red32(s);
                    rs[ai][m] = rsq_f(s * (1.f / 1024.f) + EPS);
                }
        }
        const int pn = u.pn;
        if (pn <= 3 || pn == 10) {
            const int b = u.pm >> 6, t0 = row0 & (SEQ - 1);
            if (pn <= 1) head_rows<64, false>(acc, rs, qa + (((size_t)(b * 8 + 4 * pn + wc)) * SEQ + t0) * 64 + 8 * fq, gq + 8 * fq, QSCALE, nullptr, fr);
            else if (pn <= 3) head_rows<64, true>(acc, rs, ka + (((size_t)(b * 8 + 4 * (pn - 2) + wc)) * SEQ + t0) * 64 + 8 * fq, gk + 8 * fq, 1.f,
                                                  kmp + ((((size_t)(b * 8 + 4 * (pn - 2) + wc) * 64 + (u.pm & 63)) * 2 + wr) * 64) + 8 * fq, fr);
            else head_rows<256, false>(acc, rs, qm + (size_t)row0 * 256 + wc * 64 + 8 * fq, gqm + 8 * fq, QSCALE, nullptr, fr);
        } else if (pn == 13) {
            f32x4 bv[2];
#pragma unroll
            for (int n = 0; n < 2; ++n) bv[n] = *(const f32x4*)(bgu + 32 * wc + 8 * fq + 4 * n);
#pragma unroll
            for (int ai = 0; ai < 2; ++ai)
#pragma unroll
                for (int m = 0; m < 4; ++m) {
                    float* rowp = la + (size_t)(row0 + ai * HALF + m * 16) * 128 + 32 * wc + 8 * fq;
#pragma unroll
                    for (int n = 0; n < 2; ++n) {
                        const f32x4 z = acc[ai][0][m][n] * rs[ai][m] + bv[n]; f32x4 o;
#pragma unroll
                        for (int e = 0; e < 4; ++e) o[e] = (fminf(z[e], 0.f) - 0.6931471805599453f * __builtin_amdgcn_logf(1.f + __builtin_amdgcn_exp2f(-1.4426950408889634f * fabsf(z[e])))) * (1.f / 16.f);
                        *(f32x4*)(rowp + 4 * n) = o;
                    }
                }
        } else {
            const int b = u.pm >> 6;
            if (pn == 4 || pn == 5) {
                bf16_t* base = va + (((size_t)(b * 8 + 4 * (pn - 4) + (wc >> 1))) * SEQ + (row0 & (SEQ - 1))) * 64 + 32 * (wc & 1) + 8 * fq;
                plain_rows<64, (long)2 * SEQ * 64, false>(acc, rs, base, 1.f);
            } else if (pn == 6 || pn == 7) plain_rows<1024, HALF, true>(acc, rs, cb + (size_t)row0 * 1024 + 256 * (pn - 6) + 32 * wc + 8 * fq, 1.f);
            else if (pn == 8) plain_rows<256, HALF, false>(acc, rs, qbkb + (size_t)row0 * 256 + 32 * wc + 8 * fq, 0.17677669529663687f);
            else if (pn == 9) plain_rows<256, HALF, false>(acc, rs, vb + (size_t)row0 * 256 + 32 * wc + 8 * fq, 1.f);
            else if (pn == 11) plain_rows<1024, HALF, true>(acc, rs, cb + (size_t)row0 * 1024 + 512 + 32 * wc + 8 * fq, 1.f);
            else plain_rows<1024, HALF, true>(acc, rs, cb + (size_t)row0 * 1024 + 768 + 32 * wc + 8 * fq, 1.f);
        }
    }
    template <int LD, bool KS> static __device__ __forceinline__ void head_rows(const f32x4 (&acc)[2][2][4][2], const float (&rs)[2][4], bf16_t* base, const float* g, float qs, float* kp, int fr) {
        f32x4 gv[2][2], ksum[2][2];
#pragma unroll
        for (int bj = 0; bj < 2; ++bj)
#pragma unroll
            for (int n = 0; n < 2; ++n) { gv[bj][n] = *(const f32x4*)(g + 32 * bj + 4 * n) * qs; ksum[bj][n] = (f32x4){0.f, 0.f, 0.f, 0.f}; }
#pragma unroll
        for (int ai = 0; ai < 2; ++ai)
#pragma unroll
            for (int m = 0; m < 4; ++m) {
                f32x4 s4 = acc[ai][0][m][0] * acc[ai][0][m][0];
                s4 += acc[ai][0][m][1] * acc[ai][0][m][1]; s4 += acc[ai][1][m][0] * acc[ai][1][m][0]; s4 += acc[ai][1][m][1] * acc[ai][1][m][1];
                float ss = (s4[0] + s4[1]) + (s4[2] + s4[3]);
                ss = red16(ss); ss = red32(ss);
                const float r = rs[ai][m], sc = r * rsq_f(ss * (r * r * (1.f / 64.f)) + EPS);
                bf16_t* rowp = base + (size_t)(ai * HALF + m * 16) * LD;
#pragma unroll
                for (int bj = 0; bj < 2; ++bj) {
                    const f32x4 a = acc[ai][bj][m][0] * sc * gv[bj][0], b = acc[ai][bj][m][1] * sc * gv[bj][1];
                    if (KS) { ksum[bj][0] += a; ksum[bj][1] += b; }
                    u32x4 w; w.x = cvt_pk_bf16(a[0], a[1]); w.y = cvt_pk_bf16(a[2], a[3]); w.z = cvt_pk_bf16(b[0], b[1]); w.w = cvt_pk_bf16(b[2], b[3]);
                    *(u32x4*)(rowp + 32 * bj) = w;
                }
            }
        if (KS) {
#pragma unroll
            for (int bj = 0; bj < 2; ++bj)
#pragma unroll
                for (int n = 0; n < 2; ++n)
#pragma unroll
                    for (int e = 0; e < 4; ++e) ksum[bj][n][e] = row16_sum(ksum[bj][n][e]);
            if (fr == 0) {
#pragma unroll
                for (int bj = 0; bj < 2; ++bj)
#pragma unroll
                    for (int n = 0; n < 2; ++n) *(f32x4*)(kp + 32 * bj + 4 * n) = ksum[bj][n];
            }
        }
    }
    static __device__ __forceinline__ f32x4 silu4(f32x4 x, f32x4 t) {
        f32x4 e;
#pragma unroll
        for (int i = 0; i < 4; ++i) e[i] = __builtin_amdgcn_exp2f(t[i]);
        const f32x4 d = e + 1.f; f32x4 r;
#pragma unroll
        for (int i = 0; i < 4; ++i) r[i] = __builtin_amdgcn_rcpf(d[i]);
        return x * r;
    }
    template <int LD, long BJ, bool GATE> static __device__ __forceinline__ void plain_rows(const f32x4 (&acc)[2][2][4][2], const float (&rs)[2][4], bf16_t* base, float sc0) {
#pragma unroll
        for (int ai = 0; ai < 2; ++ai)
#pragma unroll
            for (int m = 0; m < 4; ++m) {
                bf16_t* rowp = base + (size_t)(ai * HALF + m * 16) * LD;
#pragma unroll
                for (int bj = 0; bj < 2; ++bj) {
                    const float sc = rs[ai][m] * (bj == 0 ? sc0 : 1.f);
                    f32x4 a = acc[ai][bj][m][0] * sc, b = acc[ai][bj][m][1] * sc;
                    if (GATE) { const float nsc = sc * -1.4426950408889634f; a = silu4(a, acc[ai][bj][m][0] * nsc); b = silu4(b, acc[ai][bj][m][1] * nsc); }
                    u32x4 w; w.x = cvt_pk_bf16(a[0], a[1]); w.y = cvt_pk_bf16(a[2], a[3]); w.z = cvt_pk_bf16(b[0], b[1]); w.w = cvt_pk_bf16(b[2], b[3]);
                    *(u32x4*)(rowp + BJ * bj) = w;
                }
            }
    }
};
struct EpiDry {
    static constexpr bool PERM = true, AFTER_DRAIN = false;
    __device__ __forceinline__ void operator()(const f32x4 (&acc)[2][2][4][2], const Unit& u, int wr, int wc, int fr, int fq) const {
        f32x4 t = {0.f, 0.f, 0.f, 0.f};
#pragma unroll
        for (int ai = 0; ai < 2; ++ai)
#pragma unroll
            for (int bj = 0; bj < 2; ++bj)
#pragma unroll
                for (int m = 0; m < 4; ++m) t += acc[ai][bj][m][0] + acc[ai][bj][m][1];
        asm volatile("" :: "v"(t));
    }
};
template <int FIRST, int LAST> struct EpiOut {
    static constexpr bool PERM = true, AFTER_DRAIN = false;
    const float* xin; float* xout; bf16_t* xb; float* ssq;
    __device__ __forceinline__ void operator()(const f32x4 (&acc)[2][2][4][2], const Unit& u, int wr, int wc, int fr, int fq) const {
        const int row0 = u.pm * BM + wr * 64 + fr, col0 = u.pn * BM + wc * 32 + 8 * fq;
#pragma unroll
        for (int ai = 0; ai < 2; ++ai)
#pragma unroll
            for (int mh = 0; mh < 2; ++mh) {
                f32x4 xr[2][2][2];
                if (FIRST) {
#pragma unroll
                    for (int mm = 0; mm < 2; ++mm)
#pragma unroll
                        for (int bj = 0; bj < 2; ++bj)
#pragma unroll
                            for (int n = 0; n < 2; ++n) xr[mm][bj][n] = *(const f32x4*)(xin + (size_t)(row0 + ai * HALF + (2 * mh + mm) * 16) * DM + col0 + bj * HALF + 4 * n);
                    if (ai == 0 && mh == 0) asm volatile("s_waitcnt vmcnt(0)" ::: "memory");
                } else {
                    u32x4 xw[2][2];
#pragma unroll
                    for (int mm = 0; mm < 2; ++mm)
#pragma unroll
                        for (int bj = 0; bj < 2; ++bj) xw[mm][bj] = *(const u32x4*)(xb + (size_t)(row0 + ai * HALF + (2 * mh + mm) * 16) * DM + col0 + bj * HALF);
                    if (ai == 0 && mh == 0) asm volatile("s_waitcnt vmcnt(0)" : "+v"(xw[0][0]), "+v"(xw[0][1]), "+v"(xw[1][0]), "+v"(xw[1][1]) :: "memory");
                    else asm volatile("" : "+v"(xw[0][0]), "+v"(xw[0][1]), "+v"(xw[1][0]), "+v"(xw[1][1]));
#pragma unroll
                    for (int mm = 0; mm < 2; ++mm)
#pragma unroll
                        for (int bj = 0; bj < 2; ++bj) { const u32x4 w = xw[mm][bj];
                            xr[mm][bj][0] = (f32x4){__uint_as_float(w.x << 16), __uint_as_float(w.x & 0xffff0000u), __uint_as_float(w.y << 16), __uint_as_float(w.y & 0xffff0000u)};
                            xr[mm][bj][1] = (f32x4){__uint_as_float(w.z << 16), __uint_as_float(w.z & 0xffff0000u), __uint_as_float(w.w << 16), __uint_as_float(w.w & 0xffff0000u)}; }
                }
#pragma unroll
                for (int mm = 0; mm < 2; ++mm) {
                    const int m = 2 * mh + mm, row = row0 + ai * HALF + m * 16; float ss = 0.f;
#pragma unroll
                    for (int bj = 0; bj < 2; ++bj) {
                        const size_t off = (size_t)row * DM + col0 + bj * HALF;
                        const f32x4 v0 = xr[mm][bj][0] + acc[ai][bj][m][0], v1 = xr[mm][bj][1] + acc[ai][bj][m][1];
                        if (LAST) { *(f32x4*)(xout + off) = v0; *(f32x4*)(xout + off + 4) = v1; }
                        else { u32x4 w; w.x = cvt_pk_bf16(v0[0], v0[1]); w.y = cvt_pk_bf16(v0[2], v0[3]); w.z = cvt_pk_bf16(v1[0], v1[1]); w.w = cvt_pk_bf16(v1[2], v1[3]); *(u32x4*)(xb + off) = w;
#pragma unroll
                               for (int e = 0; e < 4; ++e) { const unsigned ww = (e == 0) ? w.x : (e == 1) ? w.y : (e == 2) ? w.z : w.w; const float r0 = __uint_as_float(ww << 16), r1 = __uint_as_float(ww & 0xffff0000u); ss += r0 * r0 + r1 * r1; } }
                    }
                    if (!LAST) { ss = red16(ss); ss = red32(ss); if (fq == 0) ssq[(size_t)row * 16 + 4 * u.pn + wc] = ss; }
                }
                asm volatile("" ::: "memory");
            }
    }
};

struct EpiMem {
    static constexpr bool PERM = true, AFTER_DRAIN = false;
    bf16_t *memk, *memv; const float *ssqm, *gkm; int tm;
    __device__ __forceinline__ void operator()(const f32x4 (&acc)[2][2][4][2], const Unit& u, int wr, int wc, int fr, int fq) const {
        const int row0 = u.pm * BM + wr * 64 + fr, lane = fq * 16 + fr;
        float rs[2][4];
#pragma unroll
        for (int ai = 0; ai < 2; ++ai)
#pragma unroll
            for (int m = 0; m < 4; ++m) {
                const int row = row0 + ai * HALF + m * 16;
                const f32x4 p = *(const f32x4*)(ssqm + (size_t)row * 16 + fq * 4);
                float s = (p[0] + p[1]) + (p[2] + p[3]);
                s = red16(s); s = red32(s);
                rs[ai][m] = rsq_f(s * (1.f / 1024.f) + EPS);
            }
        const int layer = u.pn >> 1;
        if ((u.pn & 1) == 0) {
            bf16_t* dst = memk + (size_t)layer * tm * 256; const float* g = gkm + layer * 64;
            f32x4 gv[2][2];
#pragma unroll
            for (int bj = 0; bj < 2; ++bj)
#pragma unroll
                for (int n = 0; n < 2; ++n) gv[bj][n] = *(const f32x4*)(g + 32 * bj + 8 * fq + 4 * n);
#pragma unroll
            for (int ai = 0; ai < 2; ++ai)
#pragma unroll
                for (int m = 0; m < 4; ++m) {
                    f32x4 v[2][2]; float ss = 0.f;
#pragma unroll
                    for (int bj = 0; bj < 2; ++bj)
#pragma unroll
                        for (int n = 0; n < 2; ++n) { v[bj][n] = acc[ai][bj][m][n] * rs[ai][m]; const f32x4 t = v[bj][n]; ss += (t[0] * t[0] + t[1] * t[1]) + (t[2] * t[2] + t[3] * t[3]); }
                    ss = red16(ss); ss = red32(ss);
                    const float inv = rsq_f(ss * (1.f / 64.f) + EPS);
                    bf16_t* rowp = dst + (size_t)(row0 + ai * HALF + m * 16) * 256 + wc * 64 + 8 * fq;
#pragma unroll
                    for (int bj = 0; bj < 2; ++bj) {
                        const f32x4 a = v[bj][0] * inv * gv[bj][0], b = v[bj][1] * inv * gv[bj][1];
                        u32x4 w; w.x = cvt_pk_bf16(a[0], a[1]); w.y = cvt_pk_bf16(a[2], a[3]); w.z = cvt_pk_bf16(b[0], b[1]); w.w = cvt_pk_bf16(b[2], b[3]);
                        *(u32x4*)(rowp + 32 * bj) = w;
                    }
                }
        } else {
            bf16_t* dst = memv + (size_t)layer * tm * 256;
#pragma unroll
            for (int ai = 0; ai < 2; ++ai)
#pragma unroll
                for (int m = 0; m < 4; ++m) {
                    bf16_t* rowp = dst + (size_t)(row0 + ai * HALF + m * 16) * 256 + 32 * wc + 8 * fq;
#pragma unroll
                    for (int bj = 0; bj < 2; ++bj) {
                        const f32x4 a = acc[ai][bj][m][0] * rs[ai][m], b = acc[ai][bj][m][1] * rs[ai][m];
                        u32x4 w; w.x = cvt_pk_bf16(a[0], a[1]); w.y = cvt_pk_bf16(a[2], a[3]); w.z = cvt_pk_bf16(b[0], b[1]); w.w = cvt_pk_bf16(b[2], b[3]);
                        *(u32x4*)(rowp + HALF * bj) = w;
                    }
                }
        }
    }
};
template <class Epi, class Sched, bool ALIGN_EPI = false, bool SP2 = false, bool RELAX = false>
__device__ __forceinline__ void gemm_phase(PG8_LAS unsigned char* lds, const Gemm g, const Sched& S, const Epi& E, int wv) {
    const int tid_l = wv * 64 + lane_id_opaque();
    const int tid = tid_l, wid = __builtin_amdgcn_readfirstlane(tid >> 6), lane = tid & 63, wr = wid >> 2, wc = wid & 3, fr = lane & 15, fq = lane >> 4;
    const int K = g.K, nt = K / BK;
    unsigned voffA[2], voffB[2];
#pragma unroll
    for (int i = 0; i < 2; ++i) { int R, C; stage_rc(tid * 16 + i * 8192, R, C); const int Rb = Epi::PERM ? ((R & ~31) + perm32(R & 31)) : R;
        voffA[i] = (unsigned)(R * K + C) * 2u; voffB[i] = (unsigned)(Rb * K + C) * 2u; }
    const size_t kstep = (size_t)(BK * 2);
    const size_t hstep = (size_t)HALF * K * 2;
    const size_t tstep = 2 * hstep;
    const unsigned ldsw = (unsigned)wid * 1024u;
    const int aoff = lds_byte(wr * 64 + fr, fq * 8), boff = lds_byte(wc * 32 + fr, fq * 8);
#define PG8_SA(b, h) (((b) * 2 + (h)) * HTB)
#define PG8_SB(b, h) ((4 + (b) * 2 + (h)) * HTB)
#define PG8_STAGE(bufoff, gbase, voff) do { _Pragma("unroll") for (int _i = 0; _i < 2; ++_i) \
        __builtin_amdgcn_global_load_lds((const unsigned*)((const char*)(gbase) + (voff)[_i]), (PG8_LAS unsigned*)(lds + (bufoff) + ldsw + _i * 8192), 16, 0, 0); } while (0)
#define PG8_LDA(dst, b, h) do { _Pragma("unroll") for (int m = 0; m < 4; ++m) _Pragma("unroll") for (int k = 0; k < 2; ++k) dst[m][k] = *(const PG8_LAS bf16x8*)(lds + PG8_SA(b, h) + aoff + m * 2048 + k * 1024); } while (0)
#define PG8_LDB(dst, b, h) do { _Pragma("unroll") for (int n = 0; n < 2; ++n) _Pragma("unroll") for (int k = 0; k < 2; ++k) dst[n][k] = *(const PG8_LAS bf16x8*)(lds + PG8_SB(b, h) + boff + n * 2048 + k * 1024); } while (0)
#define PG8_MMA(ai, bj, At, Bt) do { __builtin_amdgcn_s_setprio(1); _Pragma("unroll") for (int m = 0; m < 4; ++m) _Pragma("unroll") for (int n = 0; n < 2; ++n) _Pragma("unroll") for (int k = 0; k < 2; ++k) \
        acc[ai][bj][m][n] = __builtin_amdgcn_mfma_f32_16x16x32_bf16(Bt[n][k], At[m][k], acc[ai][bj][m][n], 0, 0, 0); __builtin_amdgcn_s_setprio(0); } while (0)
#define PG8_WAIT_V(n) asm volatile("s_waitcnt vmcnt(" #n ")" ::: "memory")
#define PG8_WAIT_L(n) asm volatile("s_waitcnt lgkmcnt(" #n ")" ::: "memory")
#define PG8_WAIT_V8_UNLESS(flag) asm volatile("s_cmp_lg_u32 %0, 0\n\ts_cbranch_scc1 .Lpg8r_%=\n\ts_waitcnt vmcnt(8)\n.Lpg8r_%=:" :: "s"(flag) : "scc", "memory")
#define PG8_BAR __builtin_amdgcn_s_barrier()
#define PG8_SCHED __builtin_amdgcn_sched_barrier(0)
    Unit cur, nxt; int ui = 0;
    if (!S.next(0, cur)) return;
    f32x4 acc[2][2][4][2];
#pragma unroll
    for (int a = 0; a < 2; ++a)
#pragma unroll
        for (int b = 0; b < 2; ++b)
#pragma unroll
            for (int m = 0; m < 4; ++m)
#pragma unroll
                for (int n = 0; n < 2; ++n) acc[a][b][m][n] = (f32x4){0.f, 0.f, 0.f, 0.f};
    bf16x8 At[4][2], B0[2][2], B1[2][2];
    const char* cA = (const char*)g.A + (size_t)cur.pm * tstep; const char* cB = (const char*)g.Bt + (size_t)cur.pn * tstep;
    S.a_ready(cur);
    if constexpr (SP2) {
        PG8_STAGE(PG8_SB(0, 0), cB, voffB); PG8_STAGE(PG8_SB(0, 1), cB + hstep, voffB); PG8_STAGE(PG8_SA(0, 0), cA, voffA); PG8_STAGE(PG8_SA(0, 1), cA + hstep, voffA);
        if (wr == 1) PG8_BAR;
        PG8_WAIT_V(2); PG8_BAR;
        PG8_STAGE(PG8_SB(1, 0), cB + kstep, voffB); PG8_STAGE(PG8_SA(1, 0), cA + kstep, voffA); PG8_STAGE(PG8_SB(1, 1), cB + hstep + kstep, voffB);
        PG8_WAIT_V(6); PG8_BAR;
    } else {
        PG8_STAGE(PG8_SB(0, 0), cB, voffB); PG8_STAGE(PG8_SA(0, 0), cA, voffA); PG8_STAGE(PG8_SB(0, 1), cB + hstep, voffB); PG8_STAGE(PG8_SA(0, 1), cA + hstep, voffA);
        if (wr == 1) PG8_BAR;
        PG8_WAIT_V(4); PG8_BAR;
        PG8_STAGE(PG8_SB(1, 0), cB + kstep, voffB); PG8_STAGE(PG8_SA(1, 0), cA + kstep, voffA); PG8_STAGE(PG8_SB(1, 1), cB + hstep + kstep, voffB);
        PG8_WAIT_V(6); PG8_BAR;
    }
    for (;;) {
        const bool has_next = S.next(ui + 1, nxt);
        const char* nA = has_next ? (const char*)g.A + (size_t)nxt.pm * tstep : cA; const char* nB = has_next ? (const char*)g.Bt + (size_t)nxt.pn * tstep : cB;
        for (int t = 0; t < nt; t += 2) {
            const bool last = (t == nt - 2);
            const char* a1 = cA + (size_t)(t + 1) * kstep;
            const char* a2 = last ? nA : cA + (size_t)(t + 2) * kstep; const char* b2 = last ? nB : cB + (size_t)(t + 2) * kstep;
            const char* a3 = a2 + kstep; const char* b3 = b2 + kstep;
            if (last && has_next) S.a_ready(nxt);
            const int relax = __builtin_amdgcn_readfirstlane((RELAX && SP2 && t == 0 && ui > 0) ? 1 : 0);
            if constexpr (SP2) {
            PG8_LDB(B0, 0, 0); PG8_LDB(B1, 0, 1); PG8_SCHED; PG8_LDA(At, 0, 0); PG8_STAGE(PG8_SA(1, 1), a1 + hstep, voffA);
            PG8_WAIT_V8_UNLESS(relax); PG8_WAIT_L(0); PG8_BAR; PG8_MMA(0, 0, At, B0); PG8_MMA(0, 1, At, B1); PG8_BAR; PG8_SCHED;
            PG8_LDA(At, 0, 1); PG8_STAGE(PG8_SB(0, 0), b2, voffB); PG8_STAGE(PG8_SB(0, 1), b2 + hstep, voffB); PG8_STAGE(PG8_SA(0, 0), a2, voffA);
            PG8_WAIT_V8_UNLESS(relax); PG8_WAIT_L(0); PG8_BAR; PG8_MMA(1, 0, At, B0); PG8_MMA(1, 1, At, B1); PG8_BAR; PG8_SCHED;
            PG8_LDB(B0, 1, 0); PG8_LDB(B1, 1, 1); PG8_SCHED; PG8_LDA(At, 1, 0); PG8_STAGE(PG8_SA(0, 1), a2 + hstep, voffA);
            PG8_WAIT_V(8); PG8_WAIT_L(0); PG8_BAR; PG8_MMA(0, 0, At, B0); PG8_MMA(0, 1, At, B1); PG8_BAR; PG8_SCHED;
            PG8_LDA(At, 1, 1); PG8_STAGE(PG8_SB(1, 0), b3, voffB); PG8_STAGE(PG8_SB(1, 1), b3 + hstep, voffB); PG8_STAGE(PG8_SA(1, 0), a3, voffA);
            PG8_WAIT_V(8); PG8_WAIT_L(0); PG8_BAR; PG8_MMA(1, 0, At, B0); PG8_MMA(1, 1, At, B1); PG8_BAR; PG8_SCHED;
            } else {
            PG8_LDB(B0, 0, 0); PG8_SCHED; PG8_LDA(At, 0, 0); PG8_STAGE(PG8_SA(1, 1), a1 + hstep, voffA);
            PG8_WAIT_L(8); PG8_BAR; PG8_WAIT_L(0); PG8_MMA(0, 0, At, B0); PG8_BAR; PG8_SCHED;
            PG8_LDB(B1, 0, 1); PG8_STAGE(PG8_SB(0, 0), b2, voffB);
            PG8_BAR; PG8_WAIT_L(0); PG8_MMA(0, 1, At, B1); PG8_BAR;
            PG8_LDA(At, 0, 1); PG8_STAGE(PG8_SA(0, 0), a2, voffA);
            PG8_BAR; PG8_WAIT_L(0); PG8_MMA(1, 0, At, B0); PG8_BAR; PG8_SCHED;
            PG8_STAGE(PG8_SB(0, 1), b2 + hstep, voffB);
            PG8_WAIT_V(6); PG8_BAR; PG8_MMA(1, 1, At, B1); PG8_BAR;
            PG8_LDB(B0, 1, 0); PG8_SCHED; PG8_LDA(At, 1, 0); PG8_STAGE(PG8_SA(0, 1), a2 + hstep, voffA);
            PG8_WAIT_L(8); PG8_BAR; PG8_WAIT_L(0); PG8_MMA(0, 0, At, B0); PG8_BAR; PG8_SCHED;
            PG8_LDB(B1, 1, 1); PG8_STAGE(PG8_SB(1, 0), b3, voffB);
            PG8_BAR; PG8_WAIT_L(0); PG8_MMA(0, 1, At, B1); PG8_BAR;
            PG8_LDA(At, 1, 1); PG8_STAGE(PG8_SA(1, 0), a3, voffA);
            PG8_BAR; PG8_WAIT_L(0); PG8_MMA(1, 0, At, B0); PG8_BAR; PG8_SCHED;
            PG8_STAGE(PG8_SB(1, 1), b3 + hstep, voffB);
            PG8_WAIT_V(6); PG8_BAR; PG8_MMA(1, 1, At, B1); PG8_BAR;
            }
        }
        if constexpr (ALIGN_EPI) { if (wr == 0) PG8_BAR; }
        if constexpr (!Epi::AFTER_DRAIN) { E(acc, cur, wr, wc, fr, fq); S.done(cur); }
        if (!has_next) break;
#pragma unroll
        for (int a = 0; a < 2; ++a)
#pragma unroll
            for (int b = 0; b < 2; ++b)
#pragma unroll
                for (int m = 0; m < 4; ++m)
#pragma unroll
                    for (int n = 0; n < 2; ++n) acc[a][b][m][n] = (f32x4){0.f, 0.f, 0.f, 0.f};
        cur = nxt; cA = nA; cB = nB; ++ui;
        if constexpr (ALIGN_EPI) { if (wr == 1) PG8_BAR; }
    }
    PG8_WAIT_V(0);
    if constexpr (!ALIGN_EPI) { if (wr == 0) PG8_BAR; }
    PG8_BAR;
    if constexpr (Epi::AFTER_DRAIN) { E.fused(acc, cur, wr, wc, fr, fq, lds, wid, lane); S.done(cur); }
#undef PG8_SA
#undef PG8_SB
#undef PG8_STAGE
#undef PG8_LDA
#undef PG8_LDB
#undef PG8_MMA
#undef PG8_WAIT_V
#undef PG8_WAIT_L
#undef PG8_WAIT_V8_UNLESS
#undef PG8_BAR
#undef PG8_SCHED
}
}

#define LAS __attribute__((address_space(3)))
typedef unsigned short bf16;
#define XB_TMO      128
#define XB_XCNT(j)  (256  + 64 * (j))
#define XB_XSUB(j)  (1280 + 64 * (j))
#define XB_XGEN(j)  (2304 + 64 * (j))
#define XB_TOP      3328
#define XB_TOPGEN   3392
#define XCD_BAR_WORDS 3456
#define XB_SPIN_CAP (1u << 18)

__device__ __forceinline__ unsigned xb_ld(unsigned* p)              { return __hip_atomic_load(p, __ATOMIC_RELAXED, __HIP_MEMORY_SCOPE_AGENT); }
__device__ __forceinline__ unsigned xb_add(unsigned* p, unsigned v) { return __hip_atomic_fetch_add(p, v, __ATOMIC_RELAXED, __HIP_MEMORY_SCOPE_AGENT); }
__device__ __forceinline__ unsigned xb_xcc_id() { return (unsigned)__builtin_amdgcn_s_getreg((3 << 11) | 20) & 0xFu; }
#define XB_SPIN(cond, bar) do { unsigned _sp = 0; while (cond) { __builtin_amdgcn_s_sleep(1); \
    if ((++_sp & 255u) == 0u) { if (xb_ld(&(bar)[XB_TMO])) break; if (_sp > XB_SPIN_CAP) { atomicAdd(&(bar)[XB_TMO], 1u); break; } } } } while (0)

struct XcdBarrier {
    unsigned* bar; unsigned x;
    volatile LAS unsigned* st;
};

__device__ __forceinline__ XcdBarrier xcd_barrier_post(unsigned* bar, volatile LAS unsigned* st, int tid) {
    XcdBarrier b; b.bar = bar; b.x = xb_xcc_id(); b.st = st;
    if (tid == 0) (void)xb_add(&bar[XB_XCNT(b.x)], 1u);
    return b;
}
__device__ __forceinline__ void xcd_barrier_complete(unsigned* bar, unsigned x, unsigned& nloc, unsigned& nx) {
    const unsigned G = gridDim.x * gridDim.y * gridDim.z;
    unsigned sum, cnt, mine, sp = 0u;
    for (;;) {
        sum = 0u; cnt = 0u; mine = 0u;
#pragma unroll
        for (unsigned j = 0; j < 16; ++j) { const unsigned c = xb_ld(&bar[XB_XCNT(j)]); sum += c; cnt += (c > 0u) ? 1u : 0u; mine = (j == x) ? c : mine; }
        if (sum == G) break;
        __builtin_amdgcn_s_sleep(1);
        if ((++sp & 255u) == 0u) { if (xb_ld(&bar[XB_TMO])) break; if (sp > XB_SPIN_CAP) { atomicAdd(&bar[XB_TMO], 1u); break; } }
    }
    nloc = mine > 0u ? mine : 1u; nx = cnt > 0u ? cnt : 1u;
}

__device__ __forceinline__ void xcd_barrier(const XcdBarrier& b, int wv) {
    const int tid = wv * 64 + lane_id_opaque();
    asm volatile("s_waitcnt vmcnt(0)" ::: "memory");
    __syncthreads();
    if (tid == 0) {
        unsigned* bar = b.bar;
        __builtin_amdgcn_s_waitcnt(0);
        unsigned nloc = b.st[0], nx = b.st[1];
        if (nloc == 0u) { xcd_barrier_complete(bar, b.x, nloc, nx); b.st[0] = nloc; b.st[1] = nx; }
        const unsigned old = xb_add(&bar[XB_XSUB(b.x)], 1u);
        const unsigned gen = old / nloc;
        if (old + 1u == (gen + 1u) * nloc) {
            __builtin_amdgcn_fence(__ATOMIC_RELEASE, "agent");
            asm volatile("s_waitcnt vmcnt(0)" ::: "memory");
            const unsigned og = xb_add(&bar[XB_TOP], 1u);
            const unsigned tg = og / nx;
            if (og + 1u == (tg + 1u) * nx) xb_add(&bar[XB_TOPGEN], 1u);
            else XB_SPIN(xb_ld(&bar[XB_TOPGEN]) == tg, bar);
            __builtin_amdgcn_fence(__ATOMIC_ACQUIRE, "agent");
            xb_add(&bar[XB_XGEN(b.x)], 1u);
            asm volatile("s_waitcnt vmcnt(0)" ::: "memory");
        } else {
            XB_SPIN(xb_ld(&bar[XB_XGEN(b.x)]) == gen, bar);
            __builtin_amdgcn_fence(__ATOMIC_ACQUIRE, "agent");
            asm volatile("s_waitcnt vmcnt(0)" ::: "memory");
        }
    }
    __syncthreads();
}


#define GAS __attribute__((address_space(1)))
constexpr int NWAVES = 8, NTHREADS = 512;
constexpr int RING_BYTES = 131072, LDS_BYTES = 163840, MISC_OFF = LDS_BYTES - 512;

__device__ __forceinline__ float bf2f(unsigned short b) { return __uint_as_float((unsigned)b << 16); }
__device__ __forceinline__ unsigned f2bf(float f) { unsigned u = __float_as_uint(f); return (u + 0x7fffu + ((u >> 16) & 1u)) >> 16; }
__device__ __forceinline__ unsigned pk2(float lo, float hi) { return f2bf(lo) | (f2bf(hi) << 16); }
__device__ __forceinline__ float wave_sum(float v, int lane) {
#pragma unroll
    for (int o = 1; o < 64; o <<= 1) v += shx(v, o, lane);
    return v;
}
__device__ __forceinline__ float wave_max(float v, int lane) {
#pragma unroll
    for (int o = 1; o < 64; o <<= 1) v = fmaxf(v, shx(v, o, lane));
    return v;
}

constexpr size_t al256(size_t x) { return (x + 255) & ~(size_t)255; }
constexpr size_t O_CTL = 0;
constexpr size_t O_WT_IN = O_CTL + (1 << 16);
constexpr size_t O_WT_OUT = O_WT_IN + al256((size_t)DEPTH * NINP * DM * 2);
constexpr size_t O_WT_MEM = O_WT_OUT + al256((size_t)DEPTH * DM * DM * 2);
constexpr size_t O_XB = O_WT_MEM + al256((size_t)DEPTH * 512 * DM * 2);
constexpr size_t O_QA = O_XB + al256((size_t)T * DM * 2);
constexpr size_t O_KA = O_QA + al256((size_t)T * 512 * 2);
constexpr size_t O_VA = O_KA + al256((size_t)T * 512 * 2);
constexpr size_t O_CB = O_VA + al256((size_t)T * 512 * 2);
constexpr size_t O_QBKB = O_CB + al256((size_t)T * 1024 * 2);
constexpr size_t O_VB = O_QBKB + al256((size_t)T * 256 * 2);
constexpr size_t O_QM = O_VB + al256((size_t)T * 256 * 2);
constexpr size_t O_SSQ = O_QM + al256((size_t)T * 256 * 2);
constexpr size_t O_LA = O_SSQ + al256((size_t)T * 16 * 4);
constexpr size_t O_KMP = O_LA + al256((size_t)T * 128 * 4);
constexpr size_t O_LISTS = O_KMP + al256((size_t)BATCH * 8 * NB * 2 * 64 * 4);
constexpr size_t O_GCNT = O_LISTS + al256((size_t)BATCH * 8 * 256 * 2016 * 2);
constexpr size_t O_PARTO = O_GCNT + al256(1024 * 4);
constexpr size_t O_PARTL = O_PARTO + al256((size_t)T * 8 * 3 * 64 * 2);
constexpr size_t O_MEMK = O_PARTL + al256((size_t)T * 8 * 4 * 4);
constexpr size_t O_MEMV = O_MEMK + al256((size_t)DEPTH * TM * 256 * 2);
constexpr size_t O_MEMBF = O_MEMV + al256((size_t)DEPTH * TM * 256 * 2);
constexpr size_t O_SSQM = O_MEMBF + al256((size_t)TM * DM * 2);
constexpr size_t O_U = O_SSQM + al256((size_t)TM * 16 * 4);
constexpr size_t O_SST = O_U + al256((size_t)BATCH * 4 * NCH * 2048 * 4);
constexpr size_t O_DC = O_SST + al256((size_t)BATCH * 4 * NCH * 2048 * 4);
constexpr size_t O_PMASK = O_DC + al256((size_t)BATCH * 4 * NCH * 32 * 4);
constexpr size_t WS_END = O_PMASK + al256((size_t)T * 8);
static_assert(WS_END <= (size_t)536870912, "workspace map exceeds 4 x largest tensor");

struct KArgs {
    const float *x, *mem, *g_pre, *w_in, *g_q_moba, *g_k_moba, *w_gate_up, *b_gate_up, *g_gla_out, *g_mem, *w_mem_kv, *g_q_mem, *g_k_mem, *w_out;
    float* out;
    unsigned char* ws;
    int ph_lo, ph_hi;
};
struct Args {
    const __attribute__((address_space(4))) KArgs* kp;
    __device__ __forceinline__ const float* x() const { return kp->x; }
    __device__ __forceinline__ const float* mem() const { return kp->mem; }
    __device__ __forceinline__ const float* g_pre() const { return kp->g_pre; }
    __device__ __forceinline__ const float* w_in() const { return kp->w_in; }
    __device__ __forceinline__ const float* g_q_moba() const { return kp->g_q_moba; }
    __device__ __forceinline__ const float* g_k_moba() const { return kp->g_k_moba; }
    __device__ __forceinline__ const float* w_gate_up() const { return kp->w_gate_up; }
    __device__ __forceinline__ const float* b_gate_up() const { return kp->b_gate_up; }
    __device__ __forceinline__ const float* g_gla_out() const { return kp->g_gla_out; }
    __device__ __forceinline__ const float* g_mem() const { return kp->g_mem; }
    __device__ __forceinline__ const float* w_mem_kv() const { return kp->w_mem_kv; }
    __device__ __forceinline__ const float* g_q_mem() const { return kp->g_q_mem; }
    __device__ __forceinline__ const float* g_k_mem() const { return kp->g_k_mem; }
    __device__ __forceinline__ const float* w_out() const { return kp->w_out; }
    __device__ __forceinline__ float* out() const { return kp->out; }
    __device__ __forceinline__ unsigned char* ws() const { return kp->ws; }
    __device__ __forceinline__ unsigned* ctl() const { return (unsigned*)(kp->ws + O_CTL); }
    __device__ __forceinline__ bf16* wt_in() const { return (bf16*)(kp->ws + O_WT_IN); }
    __device__ __forceinline__ bf16* wt_out() const { return (bf16*)(kp->ws + O_WT_OUT); }
    __device__ __forceinline__ bf16* wt_mem() const { return (bf16*)(kp->ws + O_WT_MEM); }
    __device__ __forceinline__ bf16* xb() const { return (bf16*)(kp->ws + O_XB); }
    __device__ __forceinline__ bf16* qa() const { return (bf16*)(kp->ws + O_QA); }
    __device__ __forceinline__ bf16* ka() const { return (bf16*)(kp->ws + O_KA); }
    __device__ __forceinline__ bf16* va() const { return (bf16*)(kp->ws + O_VA); }
    __device__ __forceinline__ bf16* cb() const { return (bf16*)(kp->ws + O_CB); }
    __device__ __forceinline__ bf16* qbkb() const { return (bf16*)(kp->ws + O_QBKB); }
    __device__ __forceinline__ bf16* vb() const { return (bf16*)(kp->ws + O_VB); }
    __device__ __forceinline__ bf16* qm() const { return (bf16*)(kp->ws + O_QM); }
    __device__ __forceinline__ float* ssq() const { return (float*)(kp->ws + O_SSQ); }
    __device__ __forceinline__ float* la() const { return (float*)(kp->ws + O_LA); }
    __device__ __forceinline__ float* kmp() const { return (float*)(kp->ws + O_KMP); }
    __device__ __forceinline__ unsigned short* lists() const { return (unsigned short*)(kp->ws + O_LISTS); }
    __device__ __forceinline__ unsigned* gcnt() const { return (unsigned*)(kp->ws + O_GCNT); }
    __device__ __forceinline__ bf16* partO() const { return (bf16*)(kp->ws + O_PARTO); }
    __device__ __forceinline__ float* partL() const { return (float*)(kp->ws + O_PARTL); }
    __device__ __forceinline__ bf16* memk() const { return (bf16*)(kp->ws + O_MEMK); }
    __device__ __forceinline__ bf16* memv() const { return (bf16*)(kp->ws + O_MEMV); }
    __device__ __forceinline__ bf16* membf() const { return (bf16*)(kp->ws + O_MEMBF); }
    __device__ __forceinline__ float* ssqm() const { return (float*)(kp->ws + O_SSQM); }
    __device__ __forceinline__ float* U() const { return (float*)(kp->ws + O_U); }
    __device__ __forceinline__ float* Sst() const { return (float*)(kp->ws + O_SST); }
    __device__ __forceinline__ float* Dc() const { return (float*)(kp->ws + O_DC); }
    __device__ __forceinline__ unsigned char* pmask() const { return (unsigned char*)(kp->ws + O_PMASK); }
};


typedef short s16x8 __attribute__((ext_vector_type(8)));
typedef short s16x4 __attribute__((ext_vector_type(4)));
typedef float f32x16 __attribute__((ext_vector_type(16)));
typedef float f32x2_t __attribute__((ext_vector_type(2)));
typedef __bf16 bf16x2_t __attribute__((ext_vector_type(2)));
constexpr int KIMG_CH = 4112;
constexpr int VIMG_DH = 16448;
constexpr int KIMG_OFF = 0, VIMG_OFF = 8 * KIMG_CH, ATT_LDS_END = VIMG_OFF + 2 * VIMG_DH;
constexpr int LIST_PER_BH = 256 * 2016;
__device__ __forceinline__ int list_off(int j) { return 256 * (63 * j - (j * (j - 1)) / 2); }
__device__ __forceinline__ int crow(int r, int hi) { return (r & 3) + 8 * (r >> 2) + 4 * hi; }
__device__ __forceinline__ unsigned cvtpk(float lo, float hi) { f32x2_t v = {lo, hi}; bf16x2_t b = __builtin_convertvector(v, bf16x2_t); return __builtin_bit_cast(unsigned, b); }
__device__ __forceinline__ s16x4 vtr(const LAS unsigned char* p) { typedef short v4i16_t __attribute__((ext_vector_type(4))); return __builtin_bit_cast(s16x4, __builtin_amdgcn_ds_read_tr16_b64_v4i16((LAS v4i16_t*)p)); }

struct KVRegs { uint4 k[4], v[4]; };
__device__ __forceinline__ void kv_issue(KVRegs& r, const bf16* kg, const bf16* vg, int stride, int tid) {
    const int c = tid & 7, k0 = tid >> 3;
#pragma unroll
    for (int i = 0; i < 4; ++i) { const size_t o = (size_t)(k0 + 64 * i) * stride + c * 8; r.k[i] = *(const uint4*)(kg + o); r.v[i] = *(const uint4*)(vg + o); }
}
__device__ __forceinline__ void kv_commit(LAS unsigned char* L, const KVRegs& r, int tid) {
    const int c = tid & 7, k0 = tid >> 3;
#pragma unroll
    for (int i = 0; i < 4; ++i) { const int key = k0 + 64 * i;
        *(LAS pg8::u32x4*)(L + KIMG_OFF + c * KIMG_CH + key * 16) = (pg8::u32x4){r.k[i].x, r.k[i].y, r.k[i].z, r.k[i].w};
        *(LAS pg8::u32x4*)(L + VIMG_OFF + (c >> 2) * VIMG_DH + key * 64 + (c & 3) * 16) = (pg8::u32x4){r.v[i].x, r.v[i].y, r.v[i].z, r.v[i].w}; }
}
__device__ __forceinline__ void load_kv_tiles(LAS unsigned char* L, const bf16* kg, const bf16* vg, int stride, int tid) { KVRegs r; kv_issue(r, kg, vg, stride, tid); kv_commit(L, r, tid); }
__device__ __forceinline__ void attn_tiles(const LAS unsigned char* L, const s16x8 (&qf)[4], f32x16& cin, float cstep, int kt0, int kt1, int mask_kt, int r32, int hi, int lane, f32x16 (&o)[2], float& lsum) {
    const LAS unsigned char* kp = L + KIMG_OFF + hi * KIMG_CH + r32 * 16;
    const LAS unsigned char* vp = L + VIMG_OFF + ((lane >> 4) & 1) * 32 + (lane & 3) * 8 + (4 * hi + ((lane & 15) >> 2)) * 64;
    for (int kt = kt0; kt < kt1; ++kt) {
        f32x16 s = cin;
#pragma unroll
        for (int d0 = 0; d0 < 4; ++d0) { const s16x8 kf = *(const LAS s16x8*)(kp + 2 * d0 * KIMG_CH + kt * 512); s = __builtin_amdgcn_mfma_f32_32x32x16_bf16(kf, qf[d0], s, 0, 0, 0); }
        if (kt == mask_kt) {
#pragma unroll
            for (int r = 0; r < 16; ++r) if (crow(r, hi) > r32) s[r] = -INFINITY;
        }
        float ps = 0.f;
#pragma unroll
        for (int r = 0; r < 16; ++r) { s[r] = __builtin_amdgcn_exp2f(s[r]); ps += s[r]; }
        lsum += ps;
        union { unsigned w[4]; s16x8 v; } p0, p1;
#pragma unroll
        for (int e = 0; e < 4; ++e) { p0.w[e] = cvtpk(s[2 * e], s[2 * e + 1]); p1.w[e] = cvtpk(s[8 + 2 * e], s[8 + 2 * e + 1]); }
#pragma unroll
        for (int dh = 0; dh < 2; ++dh) {
            const LAS unsigned char* vq = vp + dh * VIMG_DH + kt * 2048;
            const s16x4 a0 = vtr(vq), a1 = vtr(vq + 512), a2 = vtr(vq + 1024), a3 = vtr(vq + 1536);
            const s16x8 f0 = {a0[0], a0[1], a0[2], a0[3], a1[0], a1[1], a1[2], a1[3]}, f1 = {a2[0], a2[1], a2[2], a2[3], a3[0], a3[1], a3[2], a3[3]};
            o[dh] = __builtin_amdgcn_mfma_f32_32x32x16_bf16(f0, p0.v, o[dh], 0, 0, 0);
            o[dh] = __builtin_amdgcn_mfma_f32_32x32x16_bf16(f1, p1.v, o[dh], 0, 0, 0);
        }
#pragma unroll
        for (int r = 0; r < 16; ++r) cin[r] += cstep;
    }
}
__device__ __forceinline__ void load_qfrag(s16x8 (&qf)[4], const bf16* qrow, int hi) {
#pragma unroll
    for (int d0 = 0; d0 < 4; ++d0) qf[d0] = *(const s16x8*)(qrow + 16 * d0 + 8 * hi);
}
__device__ __forceinline__ float softmax_ref(const float* gq, const float* gk) {
    const int lane = lane_id_opaque();
    const float a = wave_max(fabsf(gq[lane]), lane), b = wave_max(fabsf(gk[lane]), lane);
    return 64.f * QSCALE * a * b * 1.01f;
}

__device__ __forceinline__ float zero_thr(float Mref) { return 104.f + 2.f * Mref * 0.6931471805599453f + 1.f; }

__device__ __forceinline__ size_t hm_off(int b, int h, int t) { return (((size_t)(b * 8 + h)) * SEQ + t) * 64; }
struct RouteRaw { s16x8 q[4]; float km[16]; };
__device__ __forceinline__ void route_decode(int p, int& bh, int& i) { i = 63 - (p >> 4); bh = p & 15; }
__device__ __forceinline__ void route_raw_issue(const Args& a, RouteRaw& r, int unit, int tid) {
    int bh, i; route_decode(unit, bh, i); const int b = bh >> 3, h = bh & 7;
    load_qfrag(r.q, a.qa() + hm_off(b, h, i * 256 + (tid >> 6) * 32 + (tid & 31)), (tid >> 5) & 1);
#pragma unroll
    for (int k = 0; k < 8; ++k) { const int e = tid + NTHREADS * k;
        if (e < i * 64) { const float* p = a.kmp() + (((size_t)bh * 64 + (e >> 6)) * 2) * 64 + (e & 63); r.km[2 * k] = p[0]; r.km[2 * k + 1] = p[64]; } }
}
__device__ __forceinline__ void top3_insert(float s, int j, float& v0, float& v1, float& v2, int& i0, int& i1, int& i2) {
    const bool g0 = s > v0, g1 = s > v1, g2 = s > v2;
    v2 = g1 ? v1 : (g2 ? s : v2); i2 = g1 ? i1 : (g2 ? j : i2);
    v1 = g0 ? v0 : (g1 ? s : v1); i1 = g0 ? i0 : (g1 ? j : i1);
    v0 = g0 ? s : v0; i0 = g0 ? j : i0;
}
__device__ __forceinline__ void moba_route_phase(const Args& a, LAS unsigned char* L, int wv, int bid, int G, float zthr, int dry) {
    constexpr int KMP = 64 * 16 + 16;
    LAS unsigned short* kmh = (LAS unsigned short*)L; LAS unsigned short* kml = (LAS unsigned short*)(L + 8 * KMP);
    LAS int* cnt = (LAS int*)(L + 16 * KMP);
    LAS int* basep = cnt + 64;
    const int NU = BATCH * 8 * 63;
    int rnd = 0;
    int unit = bid;
    RouteRaw R;
    if (unit < NU) route_raw_issue(a, R, unit, wv * 64 + lane_id_opaque());
    while (unit < NU) {
        const int tid = wv * 64 + lane_id_opaque(), lane = tid & 63, r32 = lane & 31, hi = lane >> 5;
        int bh, i; route_decode(unit, bh, i); const int b = bh >> 3, h = bh & 7;
#pragma unroll
        for (int k = 0; k < 8; ++k) { const int e = tid + NTHREADS * k; if (e < i * 64) { const int j = e >> 6, d = e & 63; const float v = R.km[2 * k] + R.km[2 * k + 1];
                const unsigned hb = f2bf(v); const float vh = __uint_as_float(hb << 16); const unsigned lb = f2bf(v - vh);
                const int off = (d >> 3) * (KMP / 2) + j * 8 + (d & 7); kmh[off] = (unsigned short)hb; kml[off] = (unsigned short)lb; } }
        if (tid < 64) cnt[tid] = 0;
        const int t = i * 256 + wv * 32 + r32;
        s16x8 qf[4];
#pragma unroll
        for (int c = 0; c < 4; ++c) qf[c] = R.q[c];
        ++rnd;
        const int nunit = rnd * G + ((rnd & 1) ? (G - 1 - bid) : bid);
        if (nunit < NU) route_raw_issue(a, R, nunit, tid);
        __syncthreads();
        float v0 = -INFINITY, v1 = -INFINITY, v2 = -INFINITY; int i0 = 1 << 20, i1 = 1 << 20, i2 = 1 << 20;
        const int njt = i > 32 ? 2 : 1;
        for (int jt = 0; jt < njt; ++jt) {
            f32x16 g;
#pragma unroll
            for (int r = 0; r < 16; ++r) g[r] = 0.f;
            const LAS unsigned char* kh = (const LAS unsigned char*)kmh + hi * KMP + (32 * jt + r32) * 16;
            const LAS unsigned char* kl = (const LAS unsigned char*)kml + hi * KMP + (32 * jt + r32) * 16;
#pragma unroll
            for (int ks = 0; ks < 4; ++ks) {
                g = __builtin_amdgcn_mfma_f32_32x32x16_bf16(*(const LAS s16x8*)(kh + 2 * ks * KMP), qf[ks], g, 0, 0, 0);
                g = __builtin_amdgcn_mfma_f32_32x32x16_bf16(*(const LAS s16x8*)(kl + 2 * ks * KMP), qf[ks], g, 0, 0, 0);
            }
#pragma unroll
            for (int r = 0; r < 16; ++r) { const int j = 32 * jt + crow(r, hi); const float sv = (j < i) ? g[r] : -INFINITY; top3_insert(sv, j, v0, v1, v2, i0, i1, i2); }
        }
        {
            const auto x0 = __builtin_amdgcn_permlane32_swap(__float_as_uint(v0), __float_as_uint(v0), false, false), x1 = __builtin_amdgcn_permlane32_swap(__float_as_uint(v1), __float_as_uint(v1), false, false), x2 = __builtin_amdgcn_permlane32_swap(__float_as_uint(v2), __float_as_uint(v2), false, false);
            const auto y0 = __builtin_amdgcn_permlane32_swap((unsigned)i0, (unsigned)i0, false, false), y1 = __builtin_amdgcn_permlane32_swap((unsigned)i1, (unsigned)i1, false, false), y2 = __builtin_amdgcn_permlane32_swap((unsigned)i2, (unsigned)i2, false, false);
            const float pv[3] = {__uint_as_float(hi ? x0[0] : x0[1]), __uint_as_float(hi ? x1[0] : x1[1]), __uint_as_float(hi ? x2[0] : x2[1])};
            const int pi[3] = {(int)(hi ? y0[0] : y0[1]), (int)(hi ? y1[0] : y1[1]), (int)(hi ? y2[0] : y2[1])};
#pragma unroll
            for (int c = 0; c < 3; ++c) {
                const float sv = pv[c]; const int j = pi[c];
                const bool g0 = sv > v0 || (sv == v0 && j < i0), g1 = sv > v1 || (sv == v1 && j < i1), g2 = sv > v2 || (sv == v2 && j < i2);
                v2 = g1 ? v1 : (g2 ? sv : v2); i2 = g1 ? i1 : (g2 ? j : i2);
                v1 = g0 ? v0 : (g1 ? sv : v1); i1 = g0 ? i0 : (g1 ? j : i1);
                v0 = g0 ? sv : v0; i0 = g0 ? j : i0;
            }
        }
        int rk0 = 0, rk1 = 0, rk2 = 0; const int nsel = i < 3 ? i : 3; bool k0 = false, k1 = false, k2 = false;
        if (hi == 0) {
            if (dry) asm volatile("" :: "v"(i0), "v"(i1), "v"(i2));
            const float slope = exp2f(-(float)(h + 1));
            k0 = nsel > 0 && !(slope * (float)(t - 256 * i0 - 255) > zthr);
            k1 = nsel > 1 && !(slope * (float)(t - 256 * i1 - 255) > zthr);
            k2 = nsel > 2 && !(slope * (float)(t - 256 * i2 - 255) > zthr);
            if (!dry) a.pmask()[((size_t)(b * SEQ + t)) * 8 + h] = (unsigned char)((k0 ? 1 : 0) | (k1 ? 2 : 0) | (k2 ? 4 : 0));
            if (!dry && k0) rk0 = __hip_atomic_fetch_add(cnt + i0, 1, __ATOMIC_RELAXED, __HIP_MEMORY_SCOPE_WORKGROUP);
            if (!dry && k1) rk1 = __hip_atomic_fetch_add(cnt + i1, 1, __ATOMIC_RELAXED, __HIP_MEMORY_SCOPE_WORKGROUP);
            if (!dry && k2) rk2 = __hip_atomic_fetch_add(cnt + i2, 1, __ATOMIC_RELAXED, __HIP_MEMORY_SCOPE_WORKGROUP);
        }
        __syncthreads();
        if (!dry && tid < i) { const int c = cnt[tid]; basep[tid] = c > 0 ? (int)atomicAdd(a.gcnt() + bh * 64 + tid, (unsigned)c) : 0; }
        __syncthreads();
        if (!dry && hi == 0) {
            unsigned short* lst = a.lists() + (size_t)bh * LIST_PER_BH;
            if (k0) lst[list_off(i0) + basep[i0] + rk0] = (unsigned short)(t | (0 << 14));
            if (k1) lst[list_off(i1) + basep[i1] + rk1] = (unsigned short)(t | (1 << 14));
            if (k2) lst[list_off(i2) + basep[i2] + rk2] = (unsigned short)(t | (2 << 14));
        }
        unit = nunit;
        __syncthreads();
    }
}

__device__ __forceinline__ void moba_pairs_phase(const Args& a, int l, LAS unsigned char* L, int wv, int bid, int G, int dry = 0) {
    const int tid = wv * 64 + lane_id_opaque(), lane = tid & 63, wid = wv;
    LAS int* pre = (LAS int*)(L + ATT_LDS_END);
    LAS int* cntl = pre + 1028;
    LAS int* wtot = cntl + 1024;
    {
        const int c0 = (int)a.gcnt()[2 * tid], c1 = (int)a.gcnt()[2 * tid + 1];
        cntl[2 * tid] = c0; cntl[2 * tid + 1] = c1;
        const int n0 = (c0 + 255) >> 8, n1 = (c1 + 255) >> 8;
        int s = n0 + n1;
#pragma unroll
        for (int o = 1; o < 64; o <<= 1) { const int v = shup_i(s, o, lane); if (lane >= o) s += v; }
        if (lane == 63) wtot[wid] = s;
        __syncthreads();
        int wb = 0;
        for (int w = 0; w < wid; ++w) wb += wtot[w];
        const int excl = wb + s - (n0 + n1);
        pre[2 * tid] = excl; pre[2 * tid + 1] = excl + n0;
        if (tid == NTHREADS - 1) pre[1024] = excl + n0 + n1;
        __syncthreads();
    }
    const int total = pre[1024];
    LAS int* itab = wtot + 8;
    if (tid < 64) { const int it = bid + tid * G; int lo = 0, hh = 1023;
        if (it < total) { while (lo < hh) { const int mid = (lo + hh + 1) >> 1; if (pre[mid] <= it) lo = mid; else hh = mid - 1; } }
        itab[tid] = lo; }
    __syncthreads();
    const float Mref = softmax_ref(a.g_q_moba() + l * 64, a.g_k_moba() + l * 64);
    KVRegs kvr; s16x8 qf[4], qfn[4]; int tq = 0, slot = 0, cb_ = 0, ch_ = 0, cj_ = 0; bool valid = false;
    int ntq = 0, nslot = 0, nb_ = 0, nh_ = 0, nj_ = 0; bool nvalid = false; unsigned ne = 0;
    int item = bid;
#define PAIR_META(IT, B_, H_, J_, VALID_, E_) do { \
        const int tid2 = wv * 64 + lane_id_opaque(), lane2 = tid2 & 63; \
        const int bhj = itab[((IT) - bid) / G], chunk = (IT) - pre[bhj], n = cntl[bhj], bh = bhj >> 6; \
        J_ = bhj & 63; B_ = bh >> 3; H_ = bh & 7; \
        kv_issue(kvr, a.ka() + hm_off(B_, H_, J_ * 256), a.va() + hm_off(B_, H_, J_ * 256), 64, tid2); \
        int idx = chunk * 256 + wv * 32 + (lane2 & 31); VALID_ = idx < n; if (!VALID_) idx = n - 1; \
        E_ = a.lists()[(size_t)bh * LIST_PER_BH + list_off(J_) + idx]; } while (0)
    if (item < total) {
        unsigned e0; PAIR_META(item, cb_, ch_, cj_, valid, e0);
        tq = e0 & 0x3fff; slot = e0 >> 14;
        load_qfrag(qf, a.qa() + hm_off(cb_, ch_, tq), (lane_id_opaque() >> 5));
    }
    while (item < total) {
        const int tid2 = wv * 64 + lane_id_opaque(), lane = tid2 & 63, r32 = lane & 31, hi = lane >> 5;
        const int nitem = item + G; const bool has_next = nitem < total;
        __syncthreads();
        kv_commit(L, kvr, tid2);
        if (has_next) PAIR_META(nitem, nb_, nh_, nj_, nvalid, ne);
        __syncthreads();
        const size_t tok = (size_t)cb_ * SEQ + tq;
        const float slope2 = exp2f(-(float)(ch_ + 1)) * LOG2E;
        f32x16 cin;
#pragma unroll
        for (int r = 0; r < 16; ++r) cin[r] = fmaf(-slope2, (float)(tq - 256 * cj_ - crow(r, hi)), -Mref);
        f32x16 o[2]; float lsum = 0.f;
#pragma unroll
        for (int r = 0; r < 16; ++r) { o[0][r] = 0.f; o[1][r] = 0.f; }
        attn_tiles(L, qf, cin, 32.f * slope2, 0, 4, -1, r32, hi, lane, o, lsum);
        if (has_next) { ntq = ne & 0x3fff; nslot = ne >> 14; load_qfrag(qfn, a.qa() + hm_off(nb_, nh_, ntq), hi); }
        attn_tiles(L, qf, cin, 32.f * slope2, 4, 8, -1, r32, hi, lane, o, lsum);
        lsum = red32(lsum);
        if (dry) asm volatile("" :: "v"(o[0]), "v"(o[1]), "v"(lsum));
        if (valid && !dry) {
            const size_t pidx = (tok * 8 + ch_) * 3 + slot;
            bf16* po = a.partO() + pidx * 64;
#pragma unroll
            for (int dh = 0; dh < 2; ++dh)
#pragma unroll
                for (int g2 = 0; g2 < 2; ++g2) { uint4 w;
                    w.x = cvtpk(o[dh][8 * g2], o[dh][8 * g2 + 1]); w.y = cvtpk(o[dh][8 * g2 + 2], o[dh][8 * g2 + 3]); w.z = cvtpk(o[dh][8 * g2 + 4], o[dh][8 * g2 + 5]); w.w = cvtpk(o[dh][8 * g2 + 6], o[dh][8 * g2 + 7]);
                    *(uint4*)(po + 32 * hi + 16 * dh + 8 * g2) = w; }
            if (hi == 0) a.partL()[(tok * 8 + ch_) * 4 + slot] = lsum;
        }
#pragma unroll
        for (int d0 = 0; d0 < 4; ++d0) qf[d0] = qfn[d0];
        tq = ntq; slot = nslot; cb_ = nb_; ch_ = nh_; cj_ = nj_; valid = nvalid;
        item = nitem;
    }
#undef PAIR_META
    __syncthreads();
}

__device__ __forceinline__ void row_load_pieces(const bf16* row, int hi, uint2 (&pc)[8]) {
#pragma unroll
    for (int k = 0; k < 4; ++k) {
        const uint4 w = *(const uint4*)(row + 8 * (2 * k + hi));
        const auto s0 = __builtin_amdgcn_permlane32_swap(w.x, w.z, false, false), s1 = __builtin_amdgcn_permlane32_swap(w.y, w.w, false, false);
        pc[2 * k] = make_uint2(s0[0], s1[0]); pc[2 * k + 1] = make_uint2(s0[1], s1[1]);
    }
}
__device__ __forceinline__ void row_store_pieces(bf16* row, int hi, const uint2 (&pc)[8]) {
#pragma unroll
    for (int k = 0; k < 4; ++k) {
        const auto s0 = __builtin_amdgcn_permlane32_swap(pc[2 * k].x, pc[2 * k + 1].x, false, false), s1 = __builtin_amdgcn_permlane32_swap(pc[2 * k].y, pc[2 * k + 1].y, false, false);
        *(uint4*)(row + 8 * (2 * k + hi)) = make_uint4(s0[0], s1[0], s0[1], s1[1]);
    }
}
__device__ __forceinline__ void own_tile(const Args& a, const LAS unsigned char* Lt, const s16x8 (&qf)[4], unsigned pm, int b, int h, int i, int qt, int lane, float Mref, int dry) {
    const int r32 = lane & 31, hi = lane >> 5;
    const size_t tok = (size_t)b * SEQ + i * 256 + qt * 32 + r32;
    const float slope2 = exp2f(-(float)(h + 1)) * LOG2E;
    f32x16 cin;
#pragma unroll
    for (int r = 0; r < 16; ++r) cin[r] = fmaf(-slope2, (float)(32 * qt + r32 - crow(r, hi)), -Mref);
    f32x16 o[2]; float lsum = 0.f;
#pragma unroll
    for (int r = 0; r < 16; ++r) { o[0][r] = 0.f; o[1][r] = 0.f; }
    attn_tiles(Lt, qf, cin, 32.f * slope2, 0, qt + 1, qt, r32, hi, lane, o, lsum);
    lsum = red32(lsum);
    bf16* cp = a.cb() + tok * 1024 + h * 64;
    uint4 gw[4];
#pragma unroll
    for (int k = 0; k < 4; ++k) gw[k] = *(const uint4*)(cp + 8 * (2 * k + hi));
    if (pm) { const pg8::f32x4 pl = *(const pg8::f32x4*)(a.partL() + (tok * 8 + h) * 4);
        lsum += ((pm & 1u) ? pl[0] : 0.f) + ((pm & 2u) ? pl[1] : 0.f) + ((pm & 4u) ? pl[2] : 0.f); }
    for (int s = 0; s < 3; ++s) {
        if (!((pm >> s) & 1u)) continue;
        const size_t pidx = (tok * 8 + h) * 3 + s;
        const bf16* po = a.partO() + pidx * 64;
#pragma unroll
        for (int dh = 0; dh < 2; ++dh)
#pragma unroll
            for (int g2 = 0; g2 < 2; ++g2) { const uint4 w = *(const uint4*)(po + 32 * hi + 16 * dh + 8 * g2); const unsigned ww[4] = {w.x, w.y, w.z, w.w};
#pragma unroll
                for (int e = 0; e < 4; ++e) { o[dh][8 * g2 + 2 * e] += __uint_as_float(ww[e] << 16); o[dh][8 * g2 + 2 * e + 1] += __uint_as_float(ww[e] & 0xffff0000u); } }
    }
    const float inv = __builtin_amdgcn_rcpf(lsum);
    uint2 gt[8];
#pragma unroll
    for (int k = 0; k < 4; ++k) {
        const auto s0 = __builtin_amdgcn_permlane32_swap(gw[k].x, gw[k].z, false, false), s1 = __builtin_amdgcn_permlane32_swap(gw[k].y, gw[k].w, false, false);
        gt[2 * k] = make_uint2(s0[0], s1[0]); gt[2 * k + 1] = make_uint2(s0[1], s1[1]); }
#pragma unroll
    for (int c = 0; c < 8; ++c) { const int dh = c >> 2, g4 = c & 3; uint2 w;
        w.x = cvtpk(o[dh][4 * g4] * inv * __uint_as_float(gt[c].x << 16), o[dh][4 * g4 + 1] * inv * __uint_as_float(gt[c].x & 0xffff0000u));
        w.y = cvtpk(o[dh][4 * g4 + 2] * inv * __uint_as_float(gt[c].y << 16), o[dh][4 * g4 + 3] * inv * __uint_as_float(gt[c].y & 0xffff0000u));
        gt[c] = w; }
    if (!dry) row_store_pieces(cp, hi, gt); else asm volatile("" :: "v"(gt[0].x), "v"(gt[3].y), "v"(gt[7].x));
}
__device__ __forceinline__ void moba_own_pair(const Args& a, int uA, int uB, LAS unsigned char* L, int wv, float Mref, int dry = 0) {
    const int tid = wv * 64 + lane_id_opaque(), lane = tid & 63, wid = wv, hi = lane >> 5;
    const int bhA = uA >> 6, iA = uA & 63, bA = bhA >> 3, hA = bhA & 7, bhB = uB >> 6, iB = uB & 63, bB = bhB >> 3, hB = bhB & 7;
    __syncthreads();
    load_kv_tiles(L, a.ka() + hm_off(bA, hA, iA * 256), a.va() + hm_off(bA, hA, iA * 256), 64, tid);
    const bool single = (uA == uB);
    if (!single) load_kv_tiles(L + ATT_LDS_END, a.ka() + hm_off(bB, hB, iB * 256), a.va() + hm_off(bB, hB, iB * 256), 64, tid);
    s16x8 qfA[4], qfB[4];
    load_qfrag(qfA, a.qa() + hm_off(bA, hA, iA * 256 + wid * 32 + (lane & 31)), hi);
    load_qfrag(qfB, a.qa() + hm_off(bB, hB, iB * 256 + (7 - wid) * 32 + (lane & 31)), hi);
    const unsigned pmA = iA > 0 ? (unsigned)a.pmask()[((size_t)bA * SEQ + iA * 256 + wid * 32 + (lane & 31)) * 8 + hA] : 0u;
    const unsigned pmB = iB > 0 ? (unsigned)a.pmask()[((size_t)bB * SEQ + iB * 256 + (7 - wid) * 32 + (lane & 31)) * 8 + hB] : 0u;
    __syncthreads();
    own_tile(a, L, qfA, pmA, bA, hA, iA, wid, lane, Mref, dry);
    own_tile(a, single ? L : L + ATT_LDS_END, qfB, pmB, bB, hB, iB, 7 - wid, lane, Mref, dry);
}

__device__ __forceinline__ void mem_attn_phase(const Args& a, int l, LAS unsigned char* L, int wv, int bid, int G, float Mref, int dry) {
    const int NU = BATCH * 4 * 64;
    int unit = bid;
    KVRegs kvr; s16x8 qf[4], qfn[4];
    if (unit < NU) {
        const int tid = wv * 64 + lane_id_opaque(), lane = tid & 63;
        const int bhm = unit >> 6, qt = unit & 63, b = bhm >> 2, hm = bhm & 3;
        const size_t kvoff = ((size_t)l * TM + b * MEM_LEN) * 256 + hm * 64;
        kv_issue(kvr, a.memk() + kvoff, a.memv() + kvoff, 256, tid);
        load_qfrag(qf, a.qm() + ((size_t)b * SEQ + qt * 256 + wv * 32 + (lane & 31)) * 256 + hm * 64, lane >> 5);
    }
    while (unit < NU) {
        const int tid = wv * 64 + lane_id_opaque(), lane = tid & 63, r32 = lane & 31, hi = lane >> 5;
        const int bhm = unit >> 6, qt = unit & 63, b = bhm >> 2, hm = bhm & 3;
        const int nunit = unit + G;
        __syncthreads();
        kv_commit(L, kvr, tid);
        if (nunit < NU) {
            const int nbhm = nunit >> 6, nqt = nunit & 63, nb = nbhm >> 2, nhm = nbhm & 3;
            const size_t kvoff = ((size_t)l * TM + nb * MEM_LEN) * 256 + nhm * 64;
            kv_issue(kvr, a.memk() + kvoff, a.memv() + kvoff, 256, tid);
            load_qfrag(qfn, a.qm() + ((size_t)nb * SEQ + nqt * 256 + wv * 32 + r32) * 256 + nhm * 64, hi);
        }
        const size_t tok = (size_t)b * SEQ + qt * 256 + wv * 32 + r32;
        bf16* cp = a.cb() + tok * 1024 + 768 + hm * 64;
        uint2 gt[8]; row_load_pieces(cp, hi, gt);
        __syncthreads();
        f32x16 cin;
#pragma unroll
        for (int r = 0; r < 16; ++r) cin[r] = -Mref;
        f32x16 o[2]; float lsum = 0.f;
#pragma unroll
        for (int r = 0; r < 16; ++r) { o[0][r] = 0.f; o[1][r] = 0.f; }
        attn_tiles(L, qf, cin, 0.f, 0, 8, -1, r32, hi, lane, o, lsum);
        lsum = red32(lsum);
        const float inv = __builtin_amdgcn_rcpf(lsum);
#pragma unroll
        for (int c = 0; c < 8; ++c) { const int dh = c >> 2, g4 = c & 3; const uint2 g2 = gt[c]; uint2 w;
            w.x = cvtpk(o[dh][4 * g4] * inv * __uint_as_float(g2.x << 16), o[dh][4 * g4 + 1] * inv * __uint_as_float(g2.x & 0xffff0000u));
            w.y = cvtpk(o[dh][4 * g4 + 2] * inv * __uint_as_float(g2.y << 16), o[dh][4 * g4 + 3] * inv * __uint_as_float(g2.y & 0xffff0000u));
            gt[c] = w; }
        if (!dry) row_store_pieces(cp, hi, gt); else asm volatile("" :: "v"(gt[0].x), "v"(gt[3].y), "v"(gt[7].x));
#pragma unroll
        for (int d0 = 0; d0 < 4; ++d0) qf[d0] = qfn[d0];
        unit = nunit;
    }
    __syncthreads();
}

__device__ __forceinline__ void gla_load_cumsum(const Args& a, LAS float* sb, size_t tok0, int h, int tid, int lane, int wid) {
    for (int e = tid; e < 64 * 32; e += NTHREADS) { const int t = e >> 5, d = e & 31; sb[t * 33 + d] = a.la()[(tok0 + t) * 128 + h * 32 + d]; }
    __syncthreads();
#pragma unroll
    for (int cc = 0; cc < 4; ++cc) { const int d = wid * 4 + cc; float v = sb[lane * 33 + d];
#pragma unroll
        for (int o = 1; o < 64; o <<= 1) { const float t = shup(v, o, lane); if (lane >= o) v += t; }
        sb[lane * 33 + d] = v; }
    __syncthreads();
}
struct GlaRaw1 { pg8::f32x4 la[2]; uint4 k, v[2]; };
__device__ __forceinline__ void gla_raw1_issue(const Args& a, GlaRaw1& r, int unit, int lt) {
    const int c = unit & 255, h = (unit >> 8) & 3, b = unit >> 10;
    const size_t tok0 = (size_t)b * SEQ + c * 64; const int row = lt >> 2, q4 = lt & 3;
    const float* lp = a.la() + (tok0 + row) * 128 + h * 32 + 8 * q4;
    r.la[0] = *(const pg8::f32x4*)lp; r.la[1] = *(const pg8::f32x4*)(lp + 4);
    r.k = *(const uint4*)(a.qbkb() + (tok0 + row) * 256 + 128 + h * 32 + 8 * q4);
    const bf16* vp = a.vb() + (tok0 + row) * 256 + h * 64 + 16 * q4;
    r.v[0] = *(const uint4*)vp; r.v[1] = *(const uint4*)(vp + 8);
}
__device__ __forceinline__ void gla_p1_phase(const Args& a, LAS unsigned char* L, int wv, int bid, int G) {
    constexpr int GB = 8448 + 4608 + 9216;
    const int NU = BATCH * 4 * NCH;
    const int grp = wv >> 2, lw = wv & 3;
    LAS unsigned char* gb = L + grp * GB;
    LAS float* sb = (LAS float*)gb; LAS unsigned char* kT = gb + 8448; LAS unsigned char* vT = kT + 4608;
    int unit = bid + grp * G;
    GlaRaw1 R;
    { const int lt = lw * 64 + lane_id_opaque(); if (unit < NU) gla_raw1_issue(a, R, unit, lt); }
    while (unit - grp * G < NU) {
        const int lane = lane_id_opaque(), lt = lw * 64 + lane, r16 = lane & 15, g = lane >> 4;
        const bool act = unit < NU;
        const int row = lt >> 2, q4 = lt & 3;
        if (act) { LAS float* p = sb + row * 33 + 8 * q4;
#pragma unroll
            for (int e = 0; e < 4; ++e) { p[e] = R.la[0][e]; p[4 + e] = R.la[1][e]; } }
        __syncthreads();
        if (act) {
#pragma unroll
            for (int cc = 0; cc < 8; ++cc) { const int d = lw * 8 + cc; float v = sb[lane * 33 + d];
#pragma unroll
                for (int o = 1; o < 64; o <<= 1) { const float t = shup(v, o, lane); if (lane >= o) v += t; }
                sb[lane * 33 + d] = v; }
        }
        __syncthreads();
        float dlast = 0.f;
        if (act) {
            const int d0 = 8 * q4;
            const unsigned ww[4] = {R.k.x, R.k.y, R.k.z, R.k.w};
#pragma unroll
            for (int e = 0; e < 4; ++e) {
                *(LAS unsigned short*)(kT + (d0 + 2 * e) * 144 + row * 2) = (unsigned short)f2bf(__uint_as_float(ww[e] << 16) * __expf(sb[63 * 33 + d0 + 2 * e] - sb[row * 33 + d0 + 2 * e]));
                *(LAS unsigned short*)(kT + (d0 + 2 * e + 1) * 144 + row * 2) = (unsigned short)f2bf(__uint_as_float(ww[e] & 0xffff0000u) * __expf(sb[63 * 33 + d0 + 2 * e + 1] - sb[row * 33 + d0 + 2 * e + 1]));
            }
#pragma unroll
            for (int hh = 0; hh < 2; ++hh) { const unsigned vw[4] = {R.v[hh].x, R.v[hh].y, R.v[hh].z, R.v[hh].w};
#pragma unroll
                for (int k = 0; k < 4; ++k) { const int e = 16 * q4 + 8 * hh + 2 * k;
                    *(LAS unsigned short*)(vT + e * 144 + row * 2) = (unsigned short)(vw[k] & 0xffffu); *(LAS unsigned short*)(vT + (e + 1) * 144 + row * 2) = (unsigned short)(vw[k] >> 16); } }
            if (lt < 32) dlast = __expf(sb[63 * 33 + lt]);
        }
        const int cur = unit, nunit = unit + 2 * G;
        if (nunit < NU) gla_raw1_issue(a, R, nunit, lt);
        __syncthreads();
        if (act) {
            const s16x8 v0 = *(const LAS s16x8*)(vT + (16 * lw + r16) * 144 + 16 * g), v1 = *(const LAS s16x8*)(vT + (16 * lw + r16) * 144 + 64 + 16 * g);
#pragma unroll
            for (int db = 0; db < 2; ++db) {
                pg8::f32x4 acc = __builtin_amdgcn_mfma_f32_16x16x32_bf16(*(const LAS s16x8*)(kT + (16 * db + r16) * 144 + 16 * g), v0, (pg8::f32x4){0.f, 0.f, 0.f, 0.f}, 0, 0, 0);
                acc = __builtin_amdgcn_mfma_f32_16x16x32_bf16(*(const LAS s16x8*)(kT + (16 * db + r16) * 144 + 64 + 16 * g), v1, acc, 0, 0, 0);
#pragma unroll
                for (int r = 0; r < 4; ++r) a.U()[(size_t)cur * 2048 + (16 * db + 4 * g + r) * 64 + 16 * lw + r16] = acc[r];
            }
            if (lt < 32) a.Dc()[(size_t)cur * 32 + lt] = dlast;
        }
        unit = nunit;
        __syncthreads();
    }
}
__device__ __forceinline__ void gla_scan_slice(const Args& a, int slice, LAS unsigned char* L, int wv) {
    const int tid = wv * 64 + lane_id_opaque();
    const int e = tid & 63, sg = tid >> 6, bh = slice >> 5, d = slice & 31;
    LAS float* sS = (LAS float*)L; LAS float* sP = sS + 512;
    float Uv[32], Dv[32];
    const size_t unit0 = (size_t)bh * 256 + sg * 32;
#pragma unroll
    for (int c = 0; c < 32; ++c) { Dv[c] = a.Dc()[(unit0 + c) * 32 + d]; Uv[c] = a.U()[(unit0 + c) * 2048 + d * 64 + e]; }
    float S = 0.f, P = 1.f;
#pragma unroll
    for (int c = 0; c < 32; ++c) { S = Dv[c] * S + Uv[c]; P *= Dv[c]; }
    sS[sg * 64 + e] = S; sP[sg * 64 + e] = P;
    __syncthreads();
    float S0 = 0.f;
    for (int s2 = 0; s2 < sg; ++s2) S0 = sP[s2 * 64 + e] * S0 + sS[s2 * 64 + e];
    S = S0;
#pragma unroll
    for (int c = 0; c < 32; ++c) { a.Sst()[(unit0 + c) * 2048 + d * 64 + e] = S; S = Dv[c] * S + Uv[c]; }
    __syncthreads();
}
struct GlaRaw { pg8::f32x4 la[2], st[2]; uint4 q, k, v[2]; };
__device__ __forceinline__ void gla_raw_issue(const Args& a, GlaRaw& r, int unit, int lt) {
    const int c = unit & 255, h = (unit >> 8) & 3, b = unit >> 10;
    const size_t tok0 = (size_t)b * SEQ + c * 64; const int row = lt >> 2, q4 = lt & 3;
    const float* lp = a.la() + (tok0 + row) * 128 + h * 32 + 8 * q4;
    r.la[0] = *(const pg8::f32x4*)lp; r.la[1] = *(const pg8::f32x4*)(lp + 4);
    r.q = *(const uint4*)(a.qbkb() + (tok0 + row) * 256 + h * 32 + 8 * q4);
    r.k = *(const uint4*)(a.qbkb() + (tok0 + row) * 256 + 128 + h * 32 + 8 * q4);
    const bf16* vp = a.vb() + (tok0 + row) * 256 + h * 64 + 16 * q4;
    r.v[0] = *(const uint4*)vp; r.v[1] = *(const uint4*)(vp + 8);
    const float* sp = a.Sst() + (size_t)unit * 2048 + 8 * lt;
    r.st[0] = *(const pg8::f32x4*)sp; r.st[1] = *(const pg8::f32x4*)(sp + 4);
}
__device__ __forceinline__ void gla_p3_phase(const Args& a, int l, LAS unsigned char* L, int wv, int bid, int G, int dry) {
    constexpr int GB = 18688 + 9216 + 9216 + 5120;
    const int NU = BATCH * 4 * NCH;
    const int grp = wv >> 2, lw = wv & 3;
    LAS unsigned char* gb = L + grp * GB;
    LAS float* sb = (LAS float*)gb; LAS float* so = (LAS float*)gb;
    LAS unsigned char* qb = gb + 8448; LAS unsigned char* kb = qb + 5120; LAS unsigned char* ab = gb + 18688; LAS unsigned char* vT = ab + 9216; LAS unsigned char* sT = vT + 9216;
    int unit = bid + grp * G;
    GlaRaw R;
    { const int lt = lw * 64 + lane_id_opaque(); if (unit < NU) gla_raw_issue(a, R, unit, lt); }
    while (unit - grp * G < NU) {
        const int lane = lane_id_opaque(), lt = lw * 64 + lane, r16 = lane & 15, g = lane >> 4;
        const bool act = unit < NU;
        const int uc = act ? unit : 0;
        const int c = uc & 255, h = (uc >> 8) & 3, b = uc >> 10;
        const size_t tok0 = (size_t)b * SEQ + c * 64;
        const int row = lt >> 2, q4 = lt & 3;
        uint4* gptr = (uint4*)(a.cb() + (tok0 + row) * 1024 + 512 + h * 64 + 16 * q4);
        uint4 gate[2] = {make_uint4(0, 0, 0, 0), make_uint4(0, 0, 0, 0)};
        if (act) { gate[0] = gptr[0]; gate[1] = gptr[1]; }
        if (act) { LAS float* p = sb + row * 33 + 8 * q4;
#pragma unroll
            for (int e = 0; e < 4; ++e) { p[e] = R.la[0][e]; p[4 + e] = R.la[1][e]; } }
        __syncthreads();
        if (act) {
#pragma unroll
            for (int cc = 0; cc < 8; ++cc) { const int d = lw * 8 + cc; float v = sb[lane * 33 + d];
#pragma unroll
                for (int o = 1; o < 64; o <<= 1) { const float t = shup(v, o, lane); if (lane >= o) v += t; }
                sb[lane * 33 + d] = v; }
        }
        __syncthreads();
        if (act) {
            const int d0 = 8 * q4;
            const unsigned qw[4] = {R.q.x, R.q.y, R.q.z, R.q.w}, kw[4] = {R.k.x, R.k.y, R.k.z, R.k.w};
            unsigned qo[4], ko[4];
#pragma unroll
            for (int e = 0; e < 4; ++e) {
                const float d0v = sb[row * 33 + d0 + 2 * e] - sb[31 * 33 + d0 + 2 * e], d1v = sb[row * 33 + d0 + 2 * e + 1] - sb[31 * 33 + d0 + 2 * e + 1];
                const float e0 = __expf(d0v), e1 = __expf(d1v);
                qo[e] = cvtpk(__uint_as_float(qw[e] << 16) * e0, __uint_as_float(qw[e] & 0xffff0000u) * e1);
                ko[e] = cvtpk(__uint_as_float(kw[e] << 16) * __builtin_amdgcn_rcpf(e0), __uint_as_float(kw[e] & 0xffff0000u) * __builtin_amdgcn_rcpf(e1));
            }
            *(LAS pg8::u32x4*)(qb + row * 80 + 16 * q4) = (pg8::u32x4){qo[0], qo[1], qo[2], qo[3]};
            *(LAS pg8::u32x4*)(kb + row * 80 + 16 * q4) = (pg8::u32x4){ko[0], ko[1], ko[2], ko[3]};
#pragma unroll
            for (int hh = 0; hh < 2; ++hh) { const unsigned vw[4] = {R.v[hh].x, R.v[hh].y, R.v[hh].z, R.v[hh].w};
#pragma unroll
                for (int k = 0; k < 4; ++k) { const int e = 16 * q4 + 8 * hh + 2 * k;
                    *(LAS unsigned short*)(vT + e * 144 + row * 2) = (unsigned short)(vw[k] & 0xffffu); *(LAS unsigned short*)(vT + (e + 1) * 144 + row * 2) = (unsigned short)(vw[k] >> 16); } }
            const int sd = (8 * lt) >> 6, se = (8 * lt) & 63; const float em = __expf(sb[31 * 33 + sd]);
#pragma unroll
            for (int e = 0; e < 4; ++e) { *(LAS unsigned short*)(sT + (se + e) * 80 + sd * 2) = (unsigned short)f2bf(R.st[0][e] * em); *(LAS unsigned short*)(sT + (se + 4 + e) * 80 + sd * 2) = (unsigned short)f2bf(R.st[1][e] * em); }
        }
        const int nunit = unit + 2 * G;
        if (nunit < NU) gla_raw_issue(a, R, nunit, lt);
        __syncthreads();
        if (act) {
            for (int tt = lw; tt < 10; tt += 4) {
                const int rb = tt >= 6 ? 3 : tt >= 3 ? 2 : tt >= 1 ? 1 : 0, cb = tt - (rb * (rb + 1)) / 2;
                const s16x8 af = *(const LAS s16x8*)(qb + (16 * rb + r16) * 80 + 16 * g), bf = *(const LAS s16x8*)(kb + (16 * cb + r16) * 80 + 16 * g);
                const pg8::f32x4 acc = __builtin_amdgcn_mfma_f32_16x16x32_bf16(af, bf, (pg8::f32x4){0.f, 0.f, 0.f, 0.f}, 0, 0, 0);
#pragma unroll
                for (int r = 0; r < 4; ++r) { const int i = 16 * rb + 4 * g + r, j = 16 * cb + r16; *(LAS unsigned short*)(ab + i * 144 + j * 2) = (unsigned short)f2bf((j <= i) ? acc[r] : 0.f); }
            }
            if (lw == 0) {
#pragma unroll
                for (int r = 0; r < 4; ++r) { *(LAS unsigned short*)(ab + (4 * g + r) * 144 + (16 + r16) * 2) = 0; *(LAS unsigned short*)(ab + (32 + 4 * g + r) * 144 + (48 + r16) * 2) = 0; }
            }
        }
        __syncthreads();
        pg8::f32x4 oacc[4];
        if (act) {
            const s16x8 sf = *(const LAS s16x8*)(sT + (16 * lw + r16) * 80 + 16 * g);
            const s16x8 v0 = *(const LAS s16x8*)(vT + (16 * lw + r16) * 144 + 16 * g), v1 = *(const LAS s16x8*)(vT + (16 * lw + r16) * 144 + 64 + 16 * g);
#pragma unroll
            for (int rb = 0; rb < 4; ++rb) {
                const s16x8 qf_ = *(const LAS s16x8*)(qb + (16 * rb + r16) * 80 + 16 * g);
                pg8::f32x4 acc = __builtin_amdgcn_mfma_f32_16x16x32_bf16(qf_, sf, (pg8::f32x4){0.f, 0.f, 0.f, 0.f}, 0, 0, 0);
                acc = __builtin_amdgcn_mfma_f32_16x16x32_bf16(*(const LAS s16x8*)(ab + (16 * rb + r16) * 144 + 16 * g), v0, acc, 0, 0, 0);
                if (rb >= 2) acc = __builtin_amdgcn_mfma_f32_16x16x32_bf16(*(const LAS s16x8*)(ab + (16 * rb + r16) * 144 + 64 + 16 * g), v1, acc, 0, 0, 0);
                oacc[rb] = acc;
            }
        }
        __syncthreads();
        if (act) {
#pragma unroll
            for (int rb = 0; rb < 4; ++rb)
#pragma unroll
                for (int r = 0; r < 4; ++r) so[(16 * rb + 4 * g + r) * 65 + 16 * lw + r16] = oacc[rb][r];
        }
        __syncthreads();
        if (act) {
            const LAS float* orow = so + row * 65 + 16 * q4;
            float ov[16]; float ss = 0.f;
#pragma unroll
            for (int e = 0; e < 16; ++e) { ov[e] = orow[e]; ss += ov[e] * ov[e]; }
            ss += shx(ss, 1, lane); ss += shx(ss, 2, lane);
            const float inv = pg8::rsq_f(ss * (1.f / 64.f) + EPS);
            const float* gg = a.g_gla_out() + l * 64 + 16 * q4;
            unsigned ow[8];
#pragma unroll
            for (int e = 0; e < 8; ++e) { const unsigned gw = (e < 4) ? ((e == 0) ? gate[0].x : (e == 1) ? gate[0].y : (e == 2) ? gate[0].z : gate[0].w) : ((e == 4) ? gate[1].x : (e == 5) ? gate[1].y : (e == 6) ? gate[1].z : gate[1].w);
                ow[e] = cvtpk(ov[2 * e] * inv * gg[2 * e] * __uint_as_float(gw << 16), ov[2 * e + 1] * inv * gg[2 * e + 1] * __uint_as_float(gw & 0xffff0000u)); }
            if (!dry) { gptr[0] = make_uint4(ow[0], ow[1], ow[2], ow[3]); gptr[1] = make_uint4(ow[4], ow[5], ow[6], ow[7]); } else asm volatile("" :: "v"(ow[0]), "v"(ow[3]), "v"(ow[7]));
        }
        unit = nunit;
        __syncthreads();
    }
}

__device__ __forceinline__ int src_col_in(int R) {
    const int tile = R >> 8, loc = R & 255, bj = loc >> 7, wc = (loc >> 5) & 3, j = loc & 31;
    switch (tile) {
        case 0: case 1: return C_QA + (4 * tile + wc) * 64 + 32 * bj + j;
        case 2: case 3: return C_KA + (4 * (tile - 2) + wc) * 64 + 32 * bj + j;
        case 4: case 5: return C_VA + 256 * (tile - 4) + loc;
        case 6: case 7: return C_GA + 256 * (tile - 6) + loc;
        case 8: return C_QB + loc;
        case 9: return C_VB + loc;
        case 10: return C_QM + wc * 64 + 32 * bj + j;
        case 11: return C_GB + loc;
        case 12: return C_GM + loc;
        default: return loc < 128 ? -(loc + 2) : -1;
    }
}

__device__ __forceinline__ void conv_item(const float* W, int ldw, int sc0, const float* g, bf16* WT, int R0, int k0, LAS float* scr, int lane) {
    float wv_[32];
#pragma unroll
    for (int i = 0; i < 32; ++i) { const int kk = 2 * i + (lane >> 5); wv_[i] = W[(size_t)(k0 + kk) * ldw + sc0 + (lane & 31)]; }
#pragma unroll
    for (int i = 0; i < 32; ++i) { const int kk = 2 * i + (lane >> 5); scr[kk * 33 + (lane & 31)] = wv_[i] * (g ? g[k0 + kk] : 1.f); }
    asm volatile("s_waitcnt lgkmcnt(0)" ::: "memory");
    const int c = lane & 7;
#pragma unroll
    for (int j = 0; j < 4; ++j) { const int n = (lane >> 3) + 8 * j; const LAS float* sp = scr + (8 * c) * 33 + n;
        uint4 o; o.x = pk2(sp[0 * 33], sp[1 * 33]); o.y = pk2(sp[2 * 33], sp[3 * 33]); o.z = pk2(sp[4 * 33], sp[5 * 33]); o.w = pk2(sp[6 * 33], sp[7 * 33]);
        *(uint4*)(WT + (size_t)(R0 + n) * DM + k0 + 8 * c) = o; }
    asm volatile("s_waitcnt lgkmcnt(0)" ::: "memory");
}
__device__ __forceinline__ void p0_prologue(const Args& a, LAS unsigned char* L, int bid, int G, int wv) {
    const int lane = lane_id_opaque(), gtid = bid * NTHREADS + wv * 64 + lane, nthreads = G * NTHREADS, gwave = bid * NWAVES + wv, nwaves = G * NWAVES;
    LAS float* scr = (LAS float*)(L + wv * 16384);
    constexpr int NB_IN = NINP / 32, I_IN = DEPTH * 16 * NB_IN, I_OUT = DEPTH * 16 * (DM / 32), I_MEM = DEPTH * 16 * 16;
    for (int it = gwave; it < I_IN + I_OUT + I_MEM; it += nwaves) {
        if (it < I_IN) {
            const int nb = it % NB_IN, kb = (it / NB_IN) % 16, l = it / (NB_IN * 16);
            const int sc = src_col_in(32 * nb);
            if (sc >= 0) conv_item(a.w_in() + (size_t)l * DM * NIN, NIN, sc, a.g_pre() + l * DM, a.wt_in() + (size_t)l * NINP * DM, 32 * nb, 64 * kb, scr, lane);
            else {
                const int R = 32 * nb + (lane & 31), kq = 64 * kb + 32 * (lane >> 5);
                const float* W = a.w_in() + (size_t)l * DM * NIN; const float* g = a.g_pre() + l * DM;
                const float* wg = a.w_gate_up() + (size_t)l * 16 * 128 + (R & 127);
                for (int k8 = 0; k8 < 4; ++k8) {
                    float v[8];
#pragma unroll
                    for (int kk = 0; kk < 8; ++kk) { float sacc = 0.f;
                        if (sc != -1) { const float* wr = W + (size_t)(kq + 8 * k8 + kk) * NIN + C_RB;
#pragma unroll
                            for (int r = 0; r < 16; ++r) sacc += wr[r] * wg[r * 128]; }
                        v[kk] = sacc * g[kq + 8 * k8 + kk]; }
                    uint4 o; o.x = pk2(v[0], v[1]); o.y = pk2(v[2], v[3]); o.z = pk2(v[4], v[5]); o.w = pk2(v[6], v[7]);
                    *(uint4*)(a.wt_in() + ((size_t)l * NINP + R) * DM + kq + 8 * k8) = o;
                }
            }
        } else if (it < I_IN + I_OUT) {
            const int r = it - I_IN, nb = r % 32, kb = (r / 32) % 16, l = r / 512;
            conv_item(a.w_out() + (size_t)l * DM * DM, DM, 32 * nb, nullptr, a.wt_out() + (size_t)l * DM * DM, 32 * nb, 64 * kb, scr, lane);
        } else {
            const int r = it - I_IN - I_OUT, nb = r % 16, kb = (r / 16) % 16, l = r / 256;
            const int loc = 32 * nb; int sc;
            if (loc < 256) { const int bj = loc >> 7, wc = (loc >> 5) & 3; sc = wc * 64 + 32 * bj; } else sc = loc;
            conv_item(a.w_mem_kv() + (size_t)l * DM * 512, 512, sc, a.g_mem() + l * DM, a.wt_mem() + (size_t)l * 512 * DM, loc, 64 * kb, scr, lane);
        }
    }
    for (int row = gwave; row < TM; row += nwaves) {
        const float4* xr = (const float4*)(a.mem() + (size_t)row * DM) + lane;
        float s = 0.f;
#pragma unroll
        for (int j = 0; j < 4; ++j) {
            const float4 v = xr[64 * j]; s += (v.x * v.x + v.y * v.y) + (v.z * v.z + v.w * v.w);
            uint2 o; o.x = pk2(v.x, v.y); o.y = pk2(v.z, v.w);
            *((uint2*)(a.membf() + (size_t)row * DM) + lane + 64 * j) = o;
        }
        s = wave_sum(s, lane);
        if (lane < 16) a.ssqm()[(size_t)row * 16 + lane] = (lane == 0) ? s : 0.f;
    }
    for (int row0 = gwave * 4; row0 < T; row0 += nwaves * 4) {
        float4 v[4][4];
#pragma unroll
        for (int rr = 0; rr < 4; ++rr)
#pragma unroll
            for (int j = 0; j < 4; ++j) v[rr][j] = ((const float4*)(a.x() + (size_t)(row0 + rr) * DM) + lane)[64 * j];
#pragma unroll
        for (int rr = 0; rr < 4; ++rr) {
            float sacc = 0.f;
#pragma unroll
            for (int j = 0; j < 4; ++j) {
                const float4 w = v[rr][j]; sacc += (w.x * w.x + w.y * w.y) + (w.z * w.z + w.w * w.w);
                uint2 o; o.x = pk2(w.x, w.y); o.y = pk2(w.z, w.w);
                *((uint2*)(a.xb() + (size_t)(row0 + rr) * DM) + lane + 64 * j) = o;
            }
            sacc = wave_sum(sacc, lane);
            if (lane < 16) a.ssq()[(size_t)(row0 + rr) * 16 + lane] = (lane == 0) ? sacc : 0.f;
        }
    }
}

constexpr int N_STEPS = 2 + 5 * DEPTH;
constexpr int CW_BAR = 4096;
#ifndef MK_SPLIT
#define MK_SPLIT 0
#endif
#ifndef PROBE
#define PROBE 0
#endif
__global__ void __launch_bounds__(NTHREADS, 2) mk_fwd(KArgs aa) {
    extern __shared__ __attribute__((aligned(16))) unsigned char lds[];
    const int G = gridDim.x;
    PG8_LAS unsigned char* L = (PG8_LAS unsigned char*)lds;
    const int wave_s = __builtin_amdgcn_readfirstlane(threadIdx.x >> 6);
    {
        const int tid0 = wave_s * 64 + (int)__builtin_amdgcn_mbcnt_hi(~0u, __builtin_amdgcn_mbcnt_lo(~0u, 0u));
        for (int u = tid0; u < 512 / 4; u += NTHREADS) ((LAS unsigned*)(L + MISC_OFF))[u] = 0u;
        __syncthreads();
    }
    unsigned* barw = (unsigned*)(aa.ws + O_CTL) + CW_BAR;
    XcdBarrier bar; bar.bar = barw; bar.x = 0; bar.st = nullptr;
    if (!MK_SPLIT) bar = xcd_barrier_post(barw, (volatile LAS unsigned*)(L + MISC_OFF) + 8, wave_s * 64 + (int)__builtin_amdgcn_mbcnt_hi(~0u, __builtin_amdgcn_mbcnt_lo(~0u, 0u)));
    const int ph_lo = aa.ph_lo, ph_hi = aa.ph_hi;
    for (int st = ph_lo; st < ph_hi; ++st) {
        int bid_o = blockIdx.x, wv_o = wave_s;
        asm volatile("" : "+s"(bid_o)); asm volatile("" : "+s"(wv_o));
        Args a; a.kp = (const __attribute__((address_space(4))) KArgs*)__builtin_amdgcn_kernarg_segment_ptr();
        asm volatile("" : "+s"(a.kp));
        const int wave = wv_o, bid = bid_o;
        if (st == 0) {
            p0_prologue(a, L, bid, G, wave);
            if (PROBE == 11) p0_prologue(a, L, bid, G, wave);
        } else if (st == 1) {
            pg8::Gemm g{a.membf(), a.wt_mem(), TM, DEPTH * 512, DM}; pg8::StaticOrder S; S.init(TM, DEPTH * 512, G, bid);
            pg8::EpiMem E{a.memk(), a.memv(), a.ssqm(), a.g_k_mem(), TM};
            pg8::gemm_phase<pg8::EpiMem, pg8::StaticOrder, false, true>(L, g, S, E, wave);
        } else {
            const int l = (st - 2) / 5, k = (st - 2) % 5;
            for (int rep = 0; rep < ((PROBE == k + 1) ? 2 : 1); ++rep) {
            const int dry = (PROBE == k + 1 && rep == 0 && (k == 3 || k == 4 || k == 1)) ? 1 : 0;
            if (k == 0) {
                if (bid == 0) { const int t0 = wave * 64 + lane_id_opaque(); a.gcnt()[t0] = 0u; a.gcnt()[t0 + 512] = 0u; }
                pg8::Gemm g{a.xb(), a.wt_in() + (size_t)l * NINP * DM, T, NINP, DM}; pg8::StaticOrder S; S.init(T, NINP, G, bid);
                pg8::EpiIn E{a.qa(), a.ka(), a.va(), a.cb(), a.qbkb(), a.vb(), a.qm(), a.la(), a.kmp(), a.ssq(), a.g_q_moba() + l * 64, a.g_k_moba() + l * 64, a.g_q_mem() + l * 64, a.b_gate_up() + l * 128};
                if (PROBE == 13) { pg8::EpiDry ED; pg8::gemm_phase<pg8::EpiDry, pg8::StaticOrder, true, true>(L, g, S, ED, wave); }
                pg8::gemm_phase<pg8::EpiIn, pg8::StaticOrder, true, true, true>(L, g, S, E, wave);
            } else if (k == 1) {
                const float zthr = zero_thr(softmax_ref(a.g_q_moba() + l * 64, a.g_k_moba() + l * 64));
                moba_route_phase(a, L, wave, bid, G, zthr, dry);
                gla_p1_phase(a, L, wave, bid, G);
            } else if (k == 2) {
                for (int sl = bid; sl < 256; sl += G) gla_scan_slice(a, sl, L, wave);
                if (PROBE == 9) moba_pairs_phase(a, l, L, wave, bid, G, 1);
                if (PROBE == 10) for (int sl = bid; sl < 256; sl += G) gla_scan_slice(a, sl, L, wave);
                moba_pairs_phase(a, l, L, wave, bid, G);
            } else if (k == 3) {
                const float Mref = softmax_ref(a.g_q_moba() + l * 64, a.g_k_moba() + l * 64);
                if (PROBE >= 6) {
                    if (PROBE == 6) for (int u = bid; u < BATCH * 8 * 64; u += 2 * G) moba_own_pair(a, u, (u + G < BATCH * 8 * 64) ? u + G : u, L, wave, Mref, 1);
                    const float Mm0 = softmax_ref(a.g_q_mem() + l * 64, a.g_k_mem() + l * 64);
                    if (PROBE == 7) mem_attn_phase(a, l, L, wave, bid, G, Mm0, 1);
                    if (PROBE == 8) gla_p3_phase(a, l, L, wave, bid, G, 1);
                }
                for (int u = bid; u < BATCH * 8 * 64; u += 2 * G) moba_own_pair(a, u, (u + G < BATCH * 8 * 64) ? u + G : u, L, wave, Mref, dry);
                const float Mm = softmax_ref(a.g_q_mem() + l * 64, a.g_k_mem() + l * 64);
                mem_attn_phase(a, l, L, wave, bid, G, Mm, dry);
                gla_p3_phase(a, l, L, wave, bid, G, dry);
            } else {
                pg8::Gemm g{a.cb(), a.wt_out() + (size_t)l * DM * DM, T, DM, DM}; pg8::StaticOrder S; S.init(T, DM, G, bid);
                if (l == 0) { pg8::EpiOut<1, 0> E{a.x(), a.out(), a.xb(), a.ssq()}; pg8::gemm_phase<pg8::EpiOut<1, 0>, pg8::StaticOrder, true, true, true>(L, g, S, E, wave); }
                else if (l == DEPTH - 1) { pg8::EpiOut<0, 1> E{a.x(), a.out(), a.xb(), a.ssq()}; pg8::gemm_phase<pg8::EpiOut<0, 1>, pg8::StaticOrder, true, true, true>(L, g, S, E, wave); }
                else { pg8::EpiOut<0, 0> E{a.x(), a.out(), a.xb(), a.ssq()}; pg8::gemm_phase<pg8::EpiOut<0, 0>, pg8::StaticOrder, true, true, true>(L, g, S, E, wave); }
            }
            }
        }
        if (!MK_SPLIT && st + 1 < ph_hi && st != 1) {
            XcdBarrier b2 = bar; unsigned* bp = b2.bar; unsigned bx = b2.x;
            asm volatile("" : "+s"(bp)); asm volatile("" : "+s"(bx));
            b2.bar = bp; b2.x = bx;
            xcd_barrier(b2, wave);
            if (PROBE == 12) xcd_barrier(b2, wave);
        }
    }
}

extern "C" void kernel_launch(void* const* d_in, const int* in_sizes, int n_in, void* d_out, int out_size, void* d_ws, size_t ws_size, hipStream_t stream) {
    static int grid = 0;
    if (grid == 0) {
        int dev = 0, cus = 0;
        if (hipGetDevice(&dev) != hipSuccess || hipDeviceGetAttribute(&cus, hipDeviceAttributeMultiprocessorCount, dev) != hipSuccess) { grid = -1; return; }
        if (hipFuncSetAttribute((const void*)mk_fwd, hipFuncAttributeMaxDynamicSharedMemorySize, LDS_BYTES) != hipSuccess) { fprintf(stderr, "hipFuncSetAttribute failed\n"); grid = -1; return; }
        grid = cus;
    }
    if (grid < 0) return;
    KArgs a{};
    a.x = (const float*)d_in[0]; a.mem = (const float*)d_in[1]; a.g_pre = (const float*)d_in[2]; a.w_in = (const float*)d_in[3];
    a.g_q_moba = (const float*)d_in[4]; a.g_k_moba = (const float*)d_in[5]; a.w_gate_up = (const float*)d_in[6]; a.b_gate_up = (const float*)d_in[7];
    a.g_gla_out = (const float*)d_in[8]; a.g_mem = (const float*)d_in[9]; a.w_mem_kv = (const float*)d_in[10]; a.g_q_mem = (const float*)d_in[11];
    a.g_k_mem = (const float*)d_in[12]; a.w_out = (const float*)d_in[13];
    a.out = (float*)d_out;
    a.ws = (unsigned char*)d_ws;
    (void)ws_size; (void)in_sizes; (void)n_in; (void)out_size;
    (void)hipMemsetAsync((char*)d_ws + O_CTL, 0, 1 << 16, stream);
#if MK_SPLIT
    for (int st = 0; st < N_STEPS; ++st) { a.ph_lo = st; a.ph_hi = st + 1; hipLaunchKernelGGL(mk_fwd, dim3(grid), dim3(NTHREADS), LDS_BYTES, stream, a); }
#else
    a.ph_lo = 0; a.ph_hi = N_STEPS;
    hipLaunchKernelGGL(mk_fwd, dim3(grid), dim3(NTHREADS), LDS_BYTES, stream, a);
#endif
}
```
